# Optimizing an MI355X kernel written in HIP

```python
import math
import jax, jax.numpy as jnp
from jax import lax
import numpy as np

D_MODEL = 2048
BATCH = 2
SEQ = 4096
DEPTH = 4
DEC_BATCH = 32
DEC_SEQ = 4
PAST_LEN = 16384
PAGE_SIZE = 128

MIX_W = D_MODEL // 2
N_BRANCH = 3
HEAD_DIM_A = 64
N_HEADS_A = MIX_W // HEAD_DIM_A
N_KV_A = N_HEADS_A // 4
GROUP_A = N_HEADS_A // N_KV_A
WINDOW = 128
ROT_DIM = HEAD_DIM_A // 4
ROPE_THETA = 500000.0
N_HEADS_B = 4
DV_B = MIX_W // N_HEADS_B
DK_B = DV_B // 2
GATE_RANK = 16
GATE_TAU = 16.0
DK_C = 128
DV_C = 128
N_HEADS_C = MIX_W // DV_C
CONV_C = 4
QKV_C = N_HEADS_C * (2 * DK_C + DV_C)
D_FF = 256 * ((8 * D_MODEL // 3 + 255) // 256)
FFN_CONV = 3
CHUNK = 64
LN_EPS = 1e-5
NORM_EPS = 1e-6
ALPHA = (2 * DEPTH) ** 0.25
BETA = (8 * DEPTH) ** -0.25
IN_SPLITS = (N_HEADS_A * HEAD_DIM_A, N_KV_A * HEAD_DIM_A, N_KV_A * HEAD_DIM_A,
             N_HEADS_B * DK_B, N_HEADS_B * DK_B, N_HEADS_B * DV_B, N_HEADS_B * DV_B, GATE_RANK,
             QKV_C, N_HEADS_C * DV_C, N_HEADS_C, N_HEADS_C,
             N_BRANCH * D_MODEL)
IN_COLS = sum(IN_SPLITS)

kernel_name = 'hybrid_swa_gla_gdn_convffn_step'


def split_proj(proj):
    idx = np.cumsum(IN_SPLITS)[:-1].tolist()
    return jnp.split(proj, idx, axis=-1)


def layer_norm(x, g, b):
    xf = x.astype(jnp.float32)
    mu = jnp.mean(xf, -1, keepdims=True)
    var = jnp.mean(jnp.square(xf - mu), -1, keepdims=True)
    return ((xf - mu) * lax.rsqrt(var + LN_EPS) * g + b).astype(x.dtype)


def rms_norm(x, g):
    xf = x.astype(jnp.float32)
    return xf * lax.rsqrt(jnp.mean(xf * xf, -1, keepdims=True) + NORM_EPS) * g


def l2norm(x):
    return x * lax.rsqrt(jnp.sum(x * x, -1, keepdims=True) + NORM_EPS)


def rotary(x, pos):
    half = ROT_DIM // 2
    inv = ROPE_THETA ** (-jnp.arange(half, dtype=jnp.float32) / half)
    ang = pos.astype(jnp.float32)[:, None] * inv[None, :]
    cos = jnp.cos(ang)[None, :, None, :]
    sin = jnp.sin(ang)[None, :, None, :]
    xr = x[..., :ROT_DIM].astype(jnp.float32)
    x1, x2 = xr[..., :half], xr[..., half:]
    rot = jnp.concatenate([x1 * cos - x2 * sin, x2 * cos + x1 * sin], -1)
    return jnp.concatenate([rot.astype(x.dtype), x[..., ROT_DIM:]], -1)


def sink_softmax(s, mask, sinks):
    s = jnp.where(mask, s, -jnp.inf)
    sk = sinks.astype(jnp.float32).reshape(N_KV_A, GROUP_A, 1, 1)
    m = jnp.maximum(jnp.max(s, -1, keepdims=True), sk)
    p = jnp.exp(s - m)
    return p / (jnp.sum(p, -1, keepdims=True) + jnp.exp(sk - m))


def swa_prompt(q, k, v, sinks):
    B, T = q.shape[:2]
    nb = -(-T // WINDOW)
    tp = nb * WINDOW
    padt = ((0, 0), (0, tp - T), (0, 0), (0, 0))
    q, k, v = jnp.pad(q, padt), jnp.pad(k, padt), jnp.pad(v, padt)
    qb = q.reshape(B, nb, WINDOW, N_KV_A, GROUP_A, HEAD_DIM_A)

    def band(a):
        prev = jnp.pad(a, ((0, 0), (WINDOW, 0), (0, 0), (0, 0)))[:, :tp]
        return jnp.concatenate([prev.reshape(B, nb, WINDOW, N_KV_A, HEAD_DIM_A),
                                a.reshape(B, nb, WINDOW, N_KV_A, HEAD_DIM_A)], axis=2)

    kb, vb = band(k), band(v)
    i = jnp.arange(WINDOW)[:, None]
    j = jnp.arange(2 * WINDOW)[None, :]
    blk = jnp.arange(nb)[:, None, None]
    mask = (j >= i) & (j <= i + WINDOW) & ((blk > 0) | (j >= WINDOW))
    s = jnp.einsum('bnqkgd,bnskd->bnkgqs', qb, kb,
                   preferred_element_type=jnp.float32) * HEAD_DIM_A ** -0.5
    p = sink_softmax(s, mask[:, None, None], sinks)
    o = jnp.einsum('bnkgqs,bnskd->bnqkgd', p.astype(v.dtype), vb)
    return o.reshape(B, tp, N_HEADS_A * HEAD_DIM_A)[:, :T]


def swa_decode(q, k, v, ck, cv, sinks):
    B, T = q.shape[:2]
    cw = ck.shape[1]
    kk = jnp.concatenate([ck.astype(k.dtype), k], axis=1)
    vv = jnp.concatenate([cv.astype(v.dtype), v], axis=1)
    diff = jnp.arange(T)[:, None] - (jnp.arange(cw + T)[None, :] - cw)
    mask = (diff >= 0) & (diff <= WINDOW)
    qg = q.reshape(B, T, N_KV_A, GROUP_A, HEAD_DIM_A)
    s = jnp.einsum('btkgd,bskd->bkgts', qg, kk,
                   preferred_element_type=jnp.float32) * HEAD_DIM_A ** -0.5
    p = sink_softmax(s, mask, sinks)
    o = jnp.einsum('bkgts,bskd->btkgd', p.astype(vv.dtype), vv)
    return o.reshape(B, T, N_HEADS_A * HEAD_DIM_A), kk[:, -cw:], vv[:, -cw:]


def to_chunks(a, c, n):
    pad = n * c - a.shape[1]
    a = jnp.pad(a, [(0, 0), (0, pad)] + [(0, 0)] * (a.ndim - 2))
    return a.reshape(a.shape[0], n, c, *a.shape[2:])


def gla_chunked(q, k, v, logdec, s0):
    B, T = q.shape[:2]
    c = min(CHUNK, T)
    n = -(-T // c)
    q, k, v, logdec = (to_chunks(a, c, n) for a in (q, k, v, logdec))
    b = jnp.cumsum(logdec, axis=2)
    b_last = b[:, :, -1:]
    qt = q * jnp.exp(b)
    kt = k * jnp.exp(-b)
    k_end = k * jnp.exp(b_last - b)
    causal = jnp.tril(jnp.ones((c, c), bool))
    a = jnp.where(causal, jnp.einsum('bnchd,bnshd->bnhcs', qt, kt), 0.0)
    o_intra = jnp.einsum('bnhcs,bnshv->bnchv', a, v)

    def step(s, inp):
        qt_i, ke_i, v_i, dec_i = inp
        o_i = jnp.einsum('bchd,bhdv->bchv', qt_i, s)
        s = s * dec_i[..., None] + jnp.einsum('bchd,bchv->bhdv', ke_i, v_i)
        return s, o_i

    xs = (jnp.moveaxis(qt, 1, 0), jnp.moveaxis(k_end, 1, 0), jnp.moveaxis(v, 1, 0),
          jnp.moveaxis(jnp.exp(b_last[:, :, 0]), 1, 0))
    s_fin, o_inter = lax.scan(step, s0, xs)
    o = o_intra + jnp.moveaxis(o_inter, 0, 1)
    return o.reshape(B, n * c, *o.shape[3:])[:, :T], s_fin


def gated_delta_chunked(q, k, v, g, beta, s0):
    B, T, H = q.shape[:3]
    dv = v.shape[-1]
    c = min(CHUNK, T)
    n = -(-T // c)
    q, k, v, g, beta = (to_chunks(a, c, n) for a in (q, k, v, g, beta))
    gh = jnp.moveaxis(jnp.cumsum(g, axis=2), 3, 2)
    diff = gh[..., :, None] - gh[..., None, :]
    t = jnp.arange(c)
    gam_strict = jnp.exp(jnp.where(t[:, None] > t[None, :], diff, -jnp.inf))
    gam_incl = jnp.exp(jnp.where(t[:, None] >= t[None, :], diff, -jnp.inf))
    bh = jnp.moveaxis(beta, 3, 2)
    qh, kh, vh = (jnp.moveaxis(a, 3, 2) for a in (q, k, v))
    kk = jnp.einsum('bnhcd,bnhsd->bnhcs', kh, kh)
    lmat = jnp.eye(c, dtype=kk.dtype) + bh[..., None] * kk * gam_strict
    rhs = jnp.concatenate([vh * bh[..., None], kh * (bh * jnp.exp(gh))[..., None]], axis=-1)
    sol = lax.linalg.triangular_solve(lmat, rhs, left_side=True, lower=True, unit_diagonal=True)
    u_base, w = sol[..., :dv], sol[..., dv:]
    a_qk = jnp.einsum('bnhcd,bnhsd->bnhcs', qh, kh) * gam_incl
    q_dec = qh * jnp.exp(gh)[..., None]
    g_last = gh[..., -1:]
    k_end = kh * jnp.exp(g_last - gh)[..., None]
    dec = jnp.exp(g_last[..., 0])

    def step(s, inp):
        ub, w_i, qd, aq, ke, d = inp
        u = ub - jnp.einsum('bhcd,bhdv->bhcv', w_i, s)
        o = jnp.einsum('bhcd,bhdv->bhcv', qd, s) + jnp.einsum('bhcs,bhsv->bhcv', aq, u)
        s = s * d[..., None, None] + jnp.einsum('bhcd,bhcv->bhdv', ke, u)
        return s, o

    xs = tuple(jnp.moveaxis(a, 1, 0) for a in (u_base, w, q_dec, a_qk, k_end, dec))
    s_fin, o = lax.scan(step, s0, xs)
    o = jnp.transpose(o, (1, 0, 3, 2, 4)).reshape(B, n * c, H, dv)[:, :T]
    return o, s_fin


def causal_conv(x, buf, w):
    width = w.shape[0]
    T = x.shape[1]
    xx = jnp.concatenate([buf.astype(x.dtype), x], axis=1)
    y = xx[:, 0:T] * w[0]
    for j in range(1, width):
        y = y + xx[:, j:j + T] * w[j]
    return y, xx[:, T:]


def decoder_layer(x, pos0, p, swa_kv, gla_s, dn_s, dn_buf, ff_buf):
    B, T, _ = x.shape
    f32 = jnp.float32
    aq, ak, av, bq, bk, bv, bg, blr, cqkv, cz, ca, cb, mg = split_proj(x @ p['w_in'])
    pos = pos0 + jnp.arange(T)
    q = rotary(aq.reshape(B, T, N_HEADS_A, HEAD_DIM_A), pos)
    k = rotary(ak.reshape(B, T, N_KV_A, HEAD_DIM_A), pos)
    v = av.reshape(B, T, N_KV_A, HEAD_DIM_A)
    if swa_kv is None:
        o_a = swa_prompt(q, k, v, p['sinks'])
        new_k, new_v = k[:, -WINDOW:], v[:, -WINDOW:]
    else:
        o_a, new_k, new_v = swa_decode(q, k, v, swa_kv[0], swa_kv[1], p['sinks'])
    gq = bq.reshape(B, T, N_HEADS_B, DK_B).astype(f32) * DK_B ** -0.5
    gk = bk.reshape(B, T, N_HEADS_B, DK_B).astype(f32)
    gv = bv.reshape(B, T, N_HEADS_B, DV_B).astype(f32)
    glog = jax.nn.log_sigmoid((blr @ p['w_gla_gate'] + p['b_gla_gate']).astype(f32)) / GATE_TAU
    s0_b = jnp.zeros((B, N_HEADS_B, DK_B, DV_B), f32) if gla_s is None else gla_s.astype(f32)
    o_b, s_b = gla_chunked(gq, gk, gv, glog.reshape(B, T, N_HEADS_B, DK_B), s0_b)
    o_b = rms_norm(o_b, p['gla_norm']) * jax.nn.silu(bg.reshape(B, T, N_HEADS_B, DV_B).astype(f32))
    o_b = o_b.reshape(B, T, MIX_W).astype(x.dtype)
    buf = jnp.zeros((B, CONV_C - 1, QKV_C), x.dtype) if dn_buf is None else dn_buf
    c_conv, new_dbuf = causal_conv(cqkv, buf, p['dn_conv'])
    c_conv = jax.nn.silu(c_conv.astype(f32))
    dq, dk, dvv = jnp.split(c_conv, [N_HEADS_C * DK_C, 2 * N_HEADS_C * DK_C], axis=-1)
    dq = l2norm(dq.reshape(B, T, N_HEADS_C, DK_C)) * DK_C ** -0.5
    dk = l2norm(dk.reshape(B, T, N_HEADS_C, DK_C))
    dvv = dvv.reshape(B, T, N_HEADS_C, DV_C)
    g = -jnp.exp(p['dn_a_log'].astype(f32)) * jax.nn.softplus(ca.astype(f32) + p['dn_dt_bias'].astype(f32))
    beta = jax.nn.sigmoid(cb.astype(f32))
    s0_c = jnp.zeros((B, N_HEADS_C, DK_C, DV_C), f32) if dn_s is None else dn_s.astype(f32)
    o_c, s_c = gated_delta_chunked(dq, dk, dvv, g, beta, s0_c)
    o_c = rms_norm(o_c, p['dn_norm']) * jax.nn.silu(cz.reshape(B, T, N_HEADS_C, DV_C).astype(f32))
    o_c = o_c.reshape(B, T, MIX_W).astype(x.dtype)
    branches = jnp.stack([o_a, o_b, o_c], axis=2)
    gates = jax.nn.sigmoid(mg.reshape(B, T, N_BRANCH, D_MODEL))
    mixed = jnp.sum(gates * jnp.einsum('btnc,ncd->btnd', branches, p['w_branch']), axis=2)
    h = layer_norm(ALPHA * x + mixed @ p['w_out'], p['ln1_g'], p['ln1_b'])
    u = h @ p['w_up']
    fbuf = jnp.zeros((B, FFN_CONV - 1, 2 * D_FF), x.dtype) if ff_buf is None else ff_buf
    uc, new_fbuf = causal_conv(u, fbuf, p['ffn_conv'])
    gate, up = jnp.split(uc, 2, axis=-1)
    f = (jax.nn.silu(gate) * up) @ p['w_down']
    y = layer_norm(ALPHA * h + f, p['ln2_g'], p['ln2_b'])
    return y, (new_k, new_v, s_b, s_c, new_dbuf, new_fbuf)


def setup_inputs(seed: int = 0) -> dict:
    key = jax.random.key(seed)
    ks = jax.random.split(key, 32)
    f32 = jnp.float32

    def nrm(k, shape, s):
        return jax.random.normal(k, shape, f32) * s

    cache_w = min(WINDOW, PAST_LEN)
    dt = jnp.exp(jax.random.uniform(ks[13], (DEPTH, N_HEADS_C), f32, math.log(1e-3), math.log(1e-1)))
    return {
        'x_prompt': nrm(ks[0], (BATCH, SEQ, D_MODEL), 1.0),
        'x_sample': nrm(ks[1], (DEC_BATCH, DEC_SEQ, D_MODEL), 1.0),
        'cache_swa_k': nrm(ks[2], (DEPTH, DEC_BATCH, cache_w, N_KV_A, HEAD_DIM_A), 1.0),
        'cache_swa_v': nrm(ks[3], (DEPTH, DEC_BATCH, cache_w, N_KV_A, HEAD_DIM_A), 1.0),
        'state_gla': nrm(ks[4], (DEPTH, DEC_BATCH, N_HEADS_B, DK_B, DV_B), 1.0),
        'state_delta': nrm(ks[5], (DEPTH, DEC_BATCH, N_HEADS_C, DK_C, DV_C), DK_C ** -0.5),
        'state_delta_conv': nrm(ks[6], (DEPTH, DEC_BATCH, CONV_C - 1, QKV_C), 1.0),
        'state_ffn_conv': nrm(ks[7], (DEPTH, DEC_BATCH, FFN_CONV - 1, 2 * D_FF), 1.0),
        'w_in': nrm(ks[8], (DEPTH, D_MODEL, IN_COLS), D_MODEL ** -0.5),
        'attn_sinks': nrm(ks[9], (DEPTH, N_HEADS_A), 1.0),
        'w_gla_gate': nrm(ks[10], (DEPTH, GATE_RANK, N_HEADS_B * DK_B), GATE_RANK ** -0.5),
        'b_gla_gate': nrm(ks[11], (DEPTH, N_HEADS_B * DK_B), 0.1),
        'gla_norm': 1.0 + nrm(ks[12], (DEPTH, DV_B), 0.02),
        'dn_conv': nrm(ks[14], (DEPTH, CONV_C, QKV_C), CONV_C ** -0.5),
        'dn_a_log': jnp.log(jax.random.uniform(ks[15], (DEPTH, N_HEADS_C), f32, 1.0, 16.0)),
        'dn_dt_bias': dt + jnp.log(-jnp.expm1(-dt)),
        'dn_norm': 1.0 + nrm(ks[16], (DEPTH, DV_C), 0.02),
        'w_branch': nrm(ks[17], (DEPTH, N_BRANCH, MIX_W, D_MODEL), MIX_W ** -0.5),
        'w_out': nrm(ks[18], (DEPTH, D_MODEL, D_MODEL), D_MODEL ** -0.5 * BETA),
        'ln1_g': 1.0 + nrm(ks[19], (DEPTH, D_MODEL), 0.02),
        'ln1_b': nrm(ks[20], (DEPTH, D_MODEL), 0.02),
        'w_up': nrm(ks[21], (DEPTH, D_MODEL, 2 * D_FF), D_MODEL ** -0.5),
        'ffn_conv': nrm(ks[22], (DEPTH, FFN_CONV, 2 * D_FF), FFN_CONV ** -0.5),
        'w_down': nrm(ks[23], (DEPTH, D_FF, D_MODEL), D_FF ** -0.5 * BETA),
        'ln2_g': 1.0 + nrm(ks[24], (DEPTH, D_MODEL), 0.02),
        'ln2_b': nrm(ks[25], (DEPTH, D_MODEL), 0.02),
    }


def reference(x_prompt, x_sample, cache_swa_k, cache_swa_v, state_gla, state_delta,
              state_delta_conv, state_ffn_conv, w_in, attn_sinks, w_gla_gate, b_gla_gate,
              gla_norm, dn_conv, dn_a_log, dn_dt_bias, dn_norm, w_branch, w_out,
              ln1_g, ln1_b, w_up, ffn_conv, w_down, ln2_g, ln2_b):
    y_p = x_prompt
    y_s = x_sample
    new_p = []
    new_s = []
    for l in range(DEPTH):
        p = {'w_in': w_in[l], 'sinks': attn_sinks[l], 'w_gla_gate': w_gla_gate[l],
             'b_gla_gate': b_gla_gate[l], 'gla_norm': gla_norm[l], 'dn_conv': dn_conv[l],
             'dn_a_log': dn_a_log[l], 'dn_dt_bias': dn_dt_bias[l], 'dn_norm': dn_norm[l],
             'w_branch': w_branch[l], 'w_out': w_out[l], 'ln1_g': ln1_g[l], 'ln1_b': ln1_b[l],
             'w_up': w_up[l], 'ffn_conv': ffn_conv[l], 'w_down': w_down[l],
             'ln2_g': ln2_g[l], 'ln2_b': ln2_b[l]}
        y_p, st_p = decoder_layer(y_p, 0, p, None, None, None, None, None)
        y_s, st_s = decoder_layer(y_s, PAST_LEN, p, (cache_swa_k[l], cache_swa_v[l]),
                                  state_gla[l], state_delta[l], state_delta_conv[l], state_ffn_conv[l])
        new_p.append(st_p)
        new_s.append(st_s)
    p_k, p_v, p_gla, p_delta, p_dconv, p_fconv = (jnp.stack(a) for a in zip(*new_p))
    s_k, s_v, s_gla, s_delta, s_dconv, s_fconv = (jnp.stack(a) for a in zip(*new_s))
    return (y_p, y_s, p_k, p_v, p_gla, p_delta, p_dconv, p_fconv,
            s_k, s_v, s_gla, s_delta, s_dconv, s_fconv)
```

```cpp
#include <hip/hip_runtime.h>
#include <cstdio>
#include <cstdint>
namespace pg8 {
#define PG8_LAS __attribute__((address_space(3)))
typedef unsigned short bf16_t;
typedef short bf16x8 __attribute__((ext_vector_type(8)));
typedef float f32x4 __attribute__((ext_vector_type(4)));
typedef unsigned u32x4 __attribute__((ext_vector_type(4)));
constexpr int BM = 256, BK = 64, HALF = 128, HTB = HALF * BK * 2  , STAGE_BYTES = 8 * HTB, NXCD = 8, WGM = 8;

__host__ __device__ __forceinline__ int lds_byte(int r, int c) { const int st = (r >> 4) * 2 + (c >> 5), rr = r & 15, cc = c & 31, ob = rr * 64 + cc * 2; return st * 1024 + (ob ^ (((ob >> 9) & 1) << 5)); }
__host__ __device__ __forceinline__ void stage_rc(int b, int& R, int& C) { const int st = b / 1024, sb = b % 1024, swz = sb ^ (((sb >> 9) & 1) << 5); R = (st >> 1) * 16 + swz / 64; C = (st & 1) * 32 + (swz % 64) / 2; }
__host__ __device__ __forceinline__ int perm32(int rho) { const int n = rho >> 4, i = rho & 15; return 8 * (i >> 2) + 4 * n + (i & 3); }

struct Unit { int pm, pn, z; };
struct Gemm { const bf16_t* A; const bf16_t* Bt; int M, N, K, lda, ldb, zdiv; size_t zA, zB, zA2, zB2; };

struct StaticOrder {
    int nM, nN, nwg, G, c;
    __host__ __device__ void init(int M, int N, int G_, int c_) { nM = M / BM; nN = N / BM; nwg = nM * nN; G = G_; c = c_; }
    __host__ __device__ bool next(int i, Unit& u) const {
        const long L = (long)i * G + c; if (L >= nwg) return false;
        int wgid = (int)L; { const int q = nwg / NXCD, r = nwg % NXCD, xcd = wgid % NXCD, off = wgid / NXCD; wgid = (xcd < r ? xcd * (q + 1) : r * (q + 1) + (xcd - r) * q) + off; }
        const int nig = WGM * nN, gid = wgid / nig, fm = gid * WGM, gsz = (nM - fm) < WGM ? (nM - fm) : WGM;
        u.pm = fm + ((wgid % nig) % gsz); u.pn = (wgid % nig) / gsz; u.z = 0; return true;
    }
    __device__ __forceinline__ void a_ready(const Unit&) const {}
    __device__ __forceinline__ void done(const Unit&) const {}
};

__device__ __forceinline__ unsigned cvt_pk_bf16(float lo, float hi) { unsigned r; asm volatile("v_cvt_pk_bf16_f32 %0, %1, %2" : "=v"(r) : "v"(lo), "v"(hi)); return r; }
typedef float f32x2 __attribute__((ext_vector_type(2)));

struct EpiF32 {
    static constexpr bool PERM = false, AFTER_DRAIN = false;
    float* C; int ldc, zdiv; size_t zC;
    __device__ __forceinline__ void operator()(const f32x4 (&acc)[2][2][4][2], const Unit& u, int wr, int wc, int fr, int fq) const {
        const int row0 = u.pm * BM + wr * 64 + fr, col0 = u.pn * BM + wc * 32 + 4 * fq;
#pragma unroll
        for (int ai = 0; ai < 2; ++ai)
#pragma unroll
            for (int m = 0; m < 4; ++m) { float* rowp = C + (size_t)(u.z / zdiv) * zC + (size_t)(row0 + ai * HALF + m * 16) * ldc + col0;
#pragma unroll
                for (int bj = 0; bj < 2; ++bj)
#pragma unroll
                    for (int n = 0; n < 2; ++n) *(f32x4*)(rowp + bj * HALF + n * 16) = acc[ai][bj][m][n]; }
    }
};
struct EpiResF32 {
    static constexpr bool PERM = false, AFTER_DRAIN = false;
    float* C; const float* resp; const float* stats; const float* g; const float* b; int ldc; float alpha;
    __device__ __forceinline__ void operator()(const f32x4 (&acc)[2][2][4][2], const Unit& u, int wr, int wc, int fr, int fq) const {
        const int row0 = u.pm * BM + wr * 64 + fr, col0 = u.pn * BM + wc * 32 + 4 * fq;
        f32x4 gv[2][2], bv[2][2];
#pragma unroll
        for (int bj = 0; bj < 2; ++bj)
#pragma unroll
            for (int n = 0; n < 2; ++n) { gv[bj][n] = resp ? (f32x4){1.f, 1.f, 1.f, 1.f} : *(const f32x4*)(g + col0 + bj * HALF + n * 16); bv[bj][n] = resp ? (f32x4){0.f, 0.f, 0.f, 0.f} : *(const f32x4*)(b + col0 + bj * HALF + n * 16); }
#pragma unroll
        for (int ai = 0; ai < 2; ++ai)
#pragma unroll
            for (int m = 0; m < 4; ++m) { const int row = row0 + ai * HALF + m * 16; const size_t off = (size_t)row * ldc + col0;
                float mu = 0.f, rs = 1.f;
                if (!resp) { mu = stats[2 * row]; rs = stats[2 * row + 1]; }
                const float* src = resp ? resp : C;
                f32x4 rv[2][2];
#pragma unroll
                for (int bj = 0; bj < 2; ++bj)
#pragma unroll
                    for (int n = 0; n < 2; ++n) rv[bj][n] = *(const f32x4*)(src + off + bj * HALF + n * 16);
#pragma unroll
                for (int bj = 0; bj < 2; ++bj)
#pragma unroll
                    for (int n = 0; n < 2; ++n) *(f32x4*)(C + off + bj * HALF + n * 16) = ((rv[bj][n] - mu) * rs * gv[bj][n] + bv[bj][n]) * alpha + acc[ai][bj][m][n]; }
    }
};
struct EpiSlabF32 {
    static constexpr bool PERM = false, AFTER_DRAIN = false;
    float* C; int ldc, pad; size_t zC;
    __device__ __forceinline__ void operator()(const f32x4 (&acc)[2][2][4][2], const Unit& u, int wr, int wc, int fr, int fq) const {
        const int row0 = wr * 64 + fr, col0 = u.pn * BM + wc * 32 + 4 * fq;
#pragma unroll
        for (int m = 0; m < 4; ++m) { float* rowp = C + (size_t)u.z * zC + (size_t)(row0 + m * 16) * ldc + col0;
#pragma unroll
            for (int bj = 0; bj < 2; ++bj)
#pragma unroll
                for (int n = 0; n < 2; ++n) *(f32x4*)(rowp + bj * HALF + n * 16) = acc[0][bj][m][n]; }
    }
};
struct ZOrder {
    StaticOrder so; int nz, G, c, per;
    __device__ void init(int M, int N, int nz_, int G_, int c_) { so.init(M, N, 1, 0); nz = nz_; G = G_; c = c_; per = so.nwg; }
    __device__ bool next(int i, Unit& u) const {
        const long L = (long)i * G + c; if (L >= (long)per * nz) return false;
        const int z = (int)(L / per), rem = (int)(L % per);
        StaticOrder t = so; t.c = rem; t.next(0, u); u.z = z; return true;
    }
    __device__ __forceinline__ void a_ready(const Unit&) const {}
    __device__ __forceinline__ void done(const Unit&) const {}
};
struct TileZ3Order {
    StaticOrder so; int G, c, per;
    __device__ void init(int M, int N, int G_, int c_) { so.init(M, N, 1, 0); G = G_; c = c_; per = so.nwg; }
    __device__ bool next(int i, Unit& u) const {
        const int ti = i / 3, z = i - 3 * ti; const long L = (long)ti * G + c; if (L >= per) return false;
        StaticOrder t = so; t.c = (int)L; t.next(0, u); u.z = z; return true;
    }
    __device__ __forceinline__ void a_ready(const Unit&) const {}
    __device__ __forceinline__ void done(const Unit&) const {}
};
template <class Epi, class Sched, bool ALIGN_EPI = false, bool SP2 = false>
__device__ __forceinline__ void gemm_phase(PG8_LAS unsigned char* lds, const Gemm g, const Sched& S, const Epi& E) {
    int tid_l = threadIdx.x; asm volatile("" : "+v"(tid_l));
    const int tid = tid_l, wid = __builtin_amdgcn_readfirstlane(tid >> 6), lane = tid & 63, wr = wid >> 2, wc = wid & 3, fr = lane & 15, fq = lane >> 4;
    const int K = g.K, nt = K / BK;
    unsigned voffA[2], voffB[2];
#pragma unroll
    for (int i = 0; i < 2; ++i) { int R, C; stage_rc(tid * 16 + i * 8192, R, C); const int Rb = Epi::PERM ? ((R & ~31) + perm32(R & 31)) : R;
        voffA[i] = (unsigned)(R * g.lda + C) * 2u; voffB[i] = (unsigned)(Rb * g.ldb + C) * 2u; }
    const size_t kstep = (size_t)(BK * 2);
    const size_t hstepA = (size_t)HALF * g.lda * 2, hstepB = (size_t)HALF * g.ldb * 2;
    const size_t tstepA = 2 * hstepA, tstepB = 2 * hstepB;
    const unsigned ldsw = (unsigned)wid * 1024u;
    const int aoff = lds_byte(wr * 64 + fr, fq * 8), boff = lds_byte(wc * 32 + fr, fq * 8);
#define PG8_SA(b, h) (((b) * 2 + (h)) * HTB)
#define PG8_SB(b, h) ((4 + (b) * 2 + (h)) * HTB)
#define PG8_STAGE(bufoff, gbase, voff) do { _Pragma("unroll") for (int _i = 0; _i < 2; ++_i) \
        __builtin_amdgcn_global_load_lds((const unsigned*)((const char*)(gbase) + (voff)[_i]), (PG8_LAS unsigned*)(lds + (bufoff) + ldsw + _i * 8192), 16, 0, 0); } while (0)
#define PG8_LDA(dst, b, h) do { _Pragma("unroll") for (int m = 0; m < 4; ++m) _Pragma("unroll") for (int k = 0; k < 2; ++k) dst[m][k] = *(const PG8_LAS bf16x8*)(lds + PG8_SA(b, h) + aoff + m * 2048 + k * 1024); } while (0)
#define PG8_LDB(dst, b, h) do { _Pragma("unroll") for (int n = 0; n < 2; ++n) _Pragma("unroll") for (int k = 0; k < 2; ++k) dst[n][k] = *(const PG8_LAS bf16x8*)(lds + PG8_SB(b, h) + boff + n * 2048 + k * 1024); } while (0)
#define PG8_MMA(ai, bj, At, Bt) do { __builtin_amdgcn_s_setprio(1); _Pragma("unroll") for (int m = 0; m < 4; ++m) _Pragma("unroll") for (int n = 0; n < 2; ++n) _Pragma("unroll") for (int k = 0; k < 2; ++k) \
        acc[ai][bj][m][n] = __builtin_amdgcn_mfma_f32_16x16x32_bf16(Bt[n][k], At[m][k], acc[ai][bj][m][n], 0, 0, 0); __builtin_amdgcn_s_setprio(0); } while (0)
#define PG8_WAIT_V(n) asm volatile("s_waitcnt vmcnt(" #n ")" ::: "memory")
#define PG8_WAIT_L(n) asm volatile("s_waitcnt lgkmcnt(" #n ")" ::: "memory")
#define PG8_BAR __builtin_amdgcn_s_barrier()
#define PG8_SCHED __builtin_amdgcn_sched_barrier(0)
    Unit cur, nxt; int ui = 0;
    if (!S.next(0, cur)) return;
    f32x4 acc[2][2][4][2];
#pragma unroll
    for (int a = 0; a < 2; ++a)
#pragma unroll
        for (int b = 0; b < 2; ++b)
#pragma unroll
            for (int m = 0; m < 4; ++m)
#pragma unroll
                for (int n = 0; n < 2; ++n) acc[a][b][m][n] = (f32x4){0.f, 0.f, 0.f, 0.f};
    bf16x8 At[4][2], B0[2][2], B1[2][2];
    const char* cA = (const char*)g.A + (size_t)cur.pm * tstepA + ((size_t)(cur.z / g.zdiv) * g.zA + (size_t)(cur.z % g.zdiv) * g.zA2) * 2; const char* cB = (const char*)g.Bt + (size_t)cur.pn * tstepB + ((size_t)(cur.z / g.zdiv) * g.zB + (size_t)(cur.z % g.zdiv) * g.zB2) * 2;
    S.a_ready(cur);
    if constexpr (SP2) {
        PG8_STAGE(PG8_SB(0, 0), cB, voffB); PG8_STAGE(PG8_SB(0, 1), cB + hstepB, voffB); PG8_STAGE(PG8_SA(0, 0), cA, voffA); PG8_STAGE(PG8_SA(0, 1), cA + hstepA, voffA);
        if (wr == 1) PG8_BAR;
        PG8_WAIT_V(2); PG8_BAR;
        PG8_STAGE(PG8_SB(1, 0), cB + kstep, voffB); PG8_STAGE(PG8_SA(1, 0), cA + kstep, voffA); PG8_STAGE(PG8_SB(1, 1), cB + hstepB + kstep, voffB);
        PG8_WAIT_V(6); PG8_BAR;
    } else {
        PG8_STAGE(PG8_SB(0, 0), cB, voffB); PG8_STAGE(PG8_SA(0, 0), cA, voffA); PG8_STAGE(PG8_SB(0, 1), cB + hstepB, voffB); PG8_STAGE(PG8_SA(0, 1), cA + hstepA, voffA);
        if (wr == 1) PG8_BAR;
        PG8_WAIT_V(4); PG8_BAR;
        PG8_STAGE(PG8_SB(1, 0), cB + kstep, voffB); PG8_STAGE(PG8_SA(1, 0), cA + kstep, voffA); PG8_STAGE(PG8_SB(1, 1), cB + hstepB + kstep, voffB);
        PG8_WAIT_V(6); PG8_BAR;
    }
    for (;;) {
        const bool has_next = S.next(ui + 1, nxt);
        const char* nA = has_next ? (const char*)g.A + (size_t)nxt.pm * tstepA + ((size_t)(nxt.z / g.zdiv) * g.zA + (size_t)(nxt.z % g.zdiv) * g.zA2) * 2 : cA; const char* nB = has_next ? (const char*)g.Bt + (size_t)nxt.pn * tstepB + ((size_t)(nxt.z / g.zdiv) * g.zB + (size_t)(nxt.z % g.zdiv) * g.zB2) * 2 : cB;
        for (int t = 0; t < nt; t += 2) {
            const bool last = (t == nt - 2);
            const char* a1 = cA + (size_t)(t + 1) * kstep;
            const char* a2 = last ? nA : cA + (size_t)(t + 2) * kstep; const char* b2 = last ? nB : cB + (size_t)(t + 2) * kstep;
            const char* a3 = a2 + kstep; const char* b3 = b2 + kstep;
            if (last && has_next) S.a_ready(nxt);
            if constexpr (SP2) {
            PG8_LDB(B0, 0, 0); PG8_LDB(B1, 0, 1); PG8_SCHED; PG8_LDA(At, 0, 0); PG8_STAGE(PG8_SA(1, 1), a1 + hstepA, voffA);
            PG8_WAIT_V(8); PG8_WAIT_L(0); PG8_BAR; PG8_MMA(0, 0, At, B0); PG8_MMA(0, 1, At, B1); PG8_BAR; PG8_SCHED;
            PG8_LDA(At, 0, 1); PG8_STAGE(PG8_SB(0, 0), b2, voffB); PG8_STAGE(PG8_SB(0, 1), b2 + hstepB, voffB); PG8_STAGE(PG8_SA(0, 0), a2, voffA);
            PG8_WAIT_V(8); PG8_WAIT_L(0); PG8_BAR; PG8_MMA(1, 0, At, B0); PG8_MMA(1, 1, At, B1); PG8_BAR; PG8_SCHED;
            PG8_LDB(B0, 1, 0); PG8_LDB(B1, 1, 1); PG8_SCHED; PG8_LDA(At, 1, 0); PG8_STAGE(PG8_SA(0, 1), a2 + hstepA, voffA);
            PG8_WAIT_V(8); PG8_WAIT_L(0); PG8_BAR; PG8_MMA(0, 0, At, B0); PG8_MMA(0, 1, At, B1); PG8_BAR; PG8_SCHED;
            PG8_LDA(At, 1, 1); PG8_STAGE(PG8_SB(1, 0), b3, voffB); PG8_STAGE(PG8_SB(1, 1), b3 + hstepB, voffB); PG8_STAGE(PG8_SA(1, 0), a3, voffA);
            PG8_WAIT_V(8); PG8_WAIT_L(0); PG8_BAR; PG8_MMA(1, 0, At, B0); PG8_MMA(1, 1, At, B1); PG8_BAR; PG8_SCHED;
            } else {
            PG8_LDB(B0, 0, 0); PG8_SCHED; PG8_LDA(At, 0, 0); PG8_STAGE(PG8_SA(1, 1), a1 + hstepA, voffA);
            PG8_WAIT_L(8); PG8_BAR; PG8_WAIT_L(0); PG8_MMA(0, 0, At, B0); PG8_BAR; PG8_SCHED;
            PG8_LDB(B1, 0, 1); PG8_STAGE(PG8_SB(0, 0), b2, voffB);
            PG8_BAR; PG8_WAIT_L(0); PG8_MMA(0, 1, At, B1); PG8_BAR;
            PG8_LDA(At, 0, 1); PG8_STAGE(PG8_SA(0, 0), a2, voffA);
            PG8_BAR; PG8_WAIT_L(0); PG8_MMA(1, 0, At, B0); PG8_BAR; PG8_SCHED;
            PG8_STAGE(PG8_SB(0, 1), b2 + hstepB, voffB);
            PG8_WAIT_V(6); PG8_BAR; PG8_MMA(1, 1, At, B1); PG8_BAR;
            PG8_LDB(B0, 1, 0); PG8_SCHED; PG8_LDA(At, 1, 0); PG8_STAGE(PG8_SA(0, 1), a2 + hstepA, voffA);
            PG8_WAIT_L(8); PG8_BAR; PG8_WAIT_L(0); PG8_MMA(0, 0, At, B0); PG8_BAR; PG8_SCHED;
            PG8_LDB(B1, 1, 1); PG8_STAGE(PG8_SB(1, 0), b3, voffB);
            PG8_BAR; PG8_WAIT_L(0); PG8_MMA(0, 1, At, B1); PG8_BAR;
            PG8_LDA(At, 1, 1); PG8_STAGE(PG8_SA(1, 0), a3, voffA);
            PG8_BAR; PG8_WAIT_L(0); PG8_MMA(1, 0, At, B0); PG8_BAR; PG8_SCHED;
            PG8_STAGE(PG8_SB(1, 1), b3 + hstepB, voffB);
            PG8_WAIT_V(6); PG8_BAR; PG8_MMA(1, 1, At, B1); PG8_BAR;
            }
        }
        if constexpr (ALIGN_EPI) { if (wr == 0) PG8_BAR; }
        if constexpr (!Epi::AFTER_DRAIN) { E(acc, cur, wr, wc, fr, fq); S.done(cur); }
        if (!has_next) break;
#pragma unroll
        for (int a = 0; a < 2; ++a)
#pragma unroll
            for (int b = 0; b < 2; ++b)
#pragma unroll
                for (int m = 0; m < 4; ++m)
#pragma unroll
                    for (int n = 0; n < 2; ++n) acc[a][b][m][n] = (f32x4){0.f, 0.f, 0.f, 0.f};
        cur = nxt; cA = nA; cB = nB; ++ui;
        if constexpr (ALIGN_EPI) { if (wr == 1) PG8_BAR; }
    }
    PG8_WAIT_V(0);
    if constexpr (!ALIGN_EPI) { if (wr == 0) PG8_BAR; }
    PG8_BAR;
    if constexpr (Epi::AFTER_DRAIN) { E.fused(acc, cur, wr, wc, fr, fq, lds, wid, lane); S.done(cur); }
#undef PG8_SA
#undef PG8_SB
#undef PG8_STAGE
#undef PG8_LDA
#undef PG8_LDB
#undef PG8_MMA
#undef PG8_WAIT_V
#undef PG8_WAIT_L
#undef PG8_BAR
#undef PG8_SCHED
}
}

constexpr int D = 2048, NPROMPT = 8192, TP = 4096, NDEC = 128, TD = 4, MROWS = NPROMPT + NDEC, DEPTH = 4;
constexpr int PAST = 16384;
constexpr int INC = 14880, PP = 15104  , MPAD = 8448  ;
constexpr int C_AQ = 0, C_AK = 1024, C_AV = 1280, C_BQ = 1536, C_BK = 2048, C_BV = 2560, C_BG = 3584, C_BLR = 4608,
              C_CQKV = 4624, C_CZ = 7696, C_CA = 8720, C_CB = 8728, C_MG = 8736;
constexpr int DFF = 5632, DFF2 = 11264;
constexpr float ALPHA = 1.681792830507429f;
constexpr size_t O_YP = 0, O_YS = 16777216, O_PK = 17039360, O_PV = 17301504, O_PGLA = 17563648, O_PDELTA = 18612224,
                 O_PDCONV = 19660800, O_PFCONV = 19734528, O_SK = 19914752, O_SV = 24109056, O_SGLA = 28303360,
                 O_SDELTA = 45080576, O_SDCONV = 61857792, O_SFCONV = 63037440, O_TOTAL = 65921024;

typedef unsigned short bf16;
typedef short bf16x8 __attribute__((ext_vector_type(8)));
typedef float f32x16 __attribute__((ext_vector_type(16)));
typedef unsigned u32x4v __attribute__((ext_vector_type(4)));
typedef unsigned u32x2v __attribute__((ext_vector_type(2)));
typedef float f32x4v __attribute__((ext_vector_type(4)));
struct P {
    const float* in[26];
    float* out;
    float *X, *H, *QR, *KR, *AG, *DQKV, *G, *BETA, *OBRAW, *OCRAW, *T3, *Z;
    bf16* PROJ;
    float* ROT;
    float *SMALL, *VD;
    bf16 *Xb, *Hb, *OAb, *OBb, *OCb, *MIXb, *Fb;
    bf16* U16;
    float *ST1, *ST2;
    float *T3d, *Zd1, *Zd2;
    bf16 *Win, *Wbr, *Wout, *Wup, *Wdn;
    bf16 *QB16, *KB16, *VT16;
    bf16 *GQT, *GKT, *GVT, *GA; float* GDEC;
    float* DUB; bf16 *DNW, *DQD, *DAQK, *DKE; float* DDEC;
};
__device__ __forceinline__ unsigned f2bf(float f) { unsigned u = __builtin_bit_cast(unsigned, f); return (u + 0x7fffu + ((u >> 16) & 1u)) >> 16; }
typedef __bf16 bf16x2_t __attribute__((ext_vector_type(2)));
typedef float f32x2_t __attribute__((ext_vector_type(2)));
__device__ __forceinline__ unsigned pk2(float lo, float hi) { f32x2_t v = {lo, hi}; bf16x2_t b = __builtin_convertvector(v, bf16x2_t); return __builtin_bit_cast(unsigned, b); }

__device__ __forceinline__ float ldbf(const bf16* q) { return __builtin_bit_cast(float, (unsigned)(*q) << 16); }
__device__ __forceinline__ f32x4v ldbf4(const bf16* q) { const u32x2v w = *(const u32x2v*)q; f32x4v r; r.x = __builtin_bit_cast(float, w.x << 16); r.y = __builtin_bit_cast(float, w.x & 0xffff0000u); r.z = __builtin_bit_cast(float, w.y << 16); r.w = __builtin_bit_cast(float, w.y & 0xffff0000u); return r; }
__device__ __forceinline__ float2 ldbf2(const bf16* q) { const unsigned w = *(const unsigned*)q; return make_float2(__builtin_bit_cast(float, w << 16), __builtin_bit_cast(float, w & 0xffff0000u)); }
__device__ __forceinline__ int row_seq(int r) { return r < NPROMPT ? (r >> 12) : 2 + ((r - NPROMPT) >> 2); }
__device__ __forceinline__ int row_t(int r) { return r < NPROMPT ? (r & 4095) : ((r - NPROMPT) & 3); }
__device__ __forceinline__ int seq_row0(int s) { return s < 2 ? s * TP : NPROMPT + (s - 2) * TD; }
__device__ __forceinline__ int seq_len(int s) { return s < 2 ? TP : TD; }
#define DPP_F(v, ctrl) __builtin_bit_cast(float, __builtin_amdgcn_update_dpp(0, __builtin_bit_cast(int, (v)), (ctrl), 0xF, 0xF, true))
__device__ __forceinline__ float row16_sum(float v) {
    v += DPP_F(v, 0xB1);
    v += DPP_F(v, 0x4E);
    v += DPP_F(v, 0x141);
    v += DPP_F(v, 0x140);
    return v;
}
__device__ __forceinline__ float wave_sum(float v) {
    v = row16_sum(v);
    const float a = __builtin_bit_cast(float, __builtin_amdgcn_readlane(__builtin_bit_cast(int, v), 0)), b = __builtin_bit_cast(float, __builtin_amdgcn_readlane(__builtin_bit_cast(int, v), 16));
    const float c = __builtin_bit_cast(float, __builtin_amdgcn_readlane(__builtin_bit_cast(int, v), 32)), d = __builtin_bit_cast(float, __builtin_amdgcn_readlane(__builtin_bit_cast(int, v), 48));
    return (a + b) + (c + d);
}
__device__ __forceinline__ float wave_max(float v) {
#pragma unroll
    for (int o = 1; o < 64; o <<= 1) v = fmaxf(v, __shfl_xor(v, o));
    return v;
}
__device__ __forceinline__ float sigmoidf_(float x) { return __builtin_amdgcn_rcpf(1.f + __expf(-x)); }
__device__ __forceinline__ float siluf_(float x) { return x * __builtin_amdgcn_rcpf(1.f + __expf(-x)); }
__device__ __forceinline__ float softplusf_(float x) { return fmaxf(x, 0.f) + __logf(1.f + __expf(-fabsf(x))); }


struct EpiU {
    static constexpr bool PERM = true, AFTER_DRAIN = false;
    bf16* U16; float* out; int l, pad;
    __device__ __forceinline__ void operator()(const pg8::f32x4 (&acc)[2][2][4][2], const pg8::Unit& u, int wr, int wc, int fr, int fq) const {
        const int row0 = u.pm * 256 + wr * 64 + fr, col0 = u.pn * 256 + wc * 32 + 8 * fq;
#pragma unroll
        for (int ai = 0; ai < 2; ++ai)
#pragma unroll
            for (int m = 0; m < 4; ++m) {
                bf16* rowp = U16 + (size_t)(row0 + ai * 128 + m * 16) * DFF2 + col0;
#pragma unroll
                for (int bj = 0; bj < 2; ++bj) {
                    const pg8::f32x4 v0 = acc[ai][bj][m][0], v1 = acc[ai][bj][m][1];
                    pg8::u32x4 w; w.x = pk2(v0[0], v0[1]); w.y = pk2(v0[2], v0[3]); w.z = pk2(v1[0], v1[1]); w.w = pk2(v1[2], v1[3]);
                    *(pg8::u32x4*)(rowp + bj * 128) = w;
                }
            }
        if (u.pm == 15 || u.pm == 31 || u.pm == 32) {
#pragma unroll
            for (int ai = 0; ai < 2; ++ai)
#pragma unroll
                for (int m = 0; m < 4; ++m) {
                    const int r = row0 + ai * 128 + m * 16;
                    float* op = nullptr;
                    if (r < NPROMPT) { const int t = r & 4095; if (t >= TP - 2) op = out + O_PFCONV + (((size_t)l * 2 + (r >> 12)) * 2 + (t - (TP - 2))) * DFF2 + col0; }
                    else if (r < MROWS) { const int t = (r - NPROMPT) & 3; if (t >= 2) op = out + O_SFCONV + (((size_t)l * 32 + ((r - NPROMPT) >> 2)) * 2 + (t - 2)) * DFF2 + col0; }
                    if (op) {
#pragma unroll
                        for (int bj = 0; bj < 2; ++bj) { *(pg8::f32x4*)(op + bj * 128) = acc[ai][bj][m][0]; *(pg8::f32x4*)(op + bj * 128 + 4) = acc[ai][bj][m][1]; }
                    }
                }
        }
    }
};

struct EpiIn {
    static constexpr bool PERM = true, AFTER_DRAIN = false;
    bf16* O; float* small; const float* rot; bf16* qb; bf16* kb; float* qr; float* kr; float* vd; float* out; int l, pad;
    __device__ __forceinline__ void attn_tiles(const pg8::f32x4 (&acc)[2][2][4][2], const pg8::Unit& u, int wr, int wc, int fr, int fq) const {
        const int row0 = u.pm * 256 + wr * 64 + fr, colt = wc * 32 + 8 * fq;
        const bool rotl = (u.pn <= 4) && ((wc & 1) == 0);
#pragma unroll
        for (int ai = 0; ai < 2; ++ai)
#pragma unroll
            for (int m = 0; m < 4; ++m) {
                const int r = row0 + ai * 128 + m * 16;
                const bool prompt = r < NPROMPT, dec = !prompt && r < MROWS;
                const int t = prompt ? (r & 4095) : ((r - NPROMPT) & 3), sq = prompt ? (r >> 12) : ((r - NPROMPT) >> 2);
                pg8::f32x4 cs[2], sn[2];
                if (rotl) { const float* rp = rot + (size_t)(prompt ? t : (dec ? 4096 + t : 0)) * 16;
                    const pg8::f32x4 a0 = *(const pg8::f32x4*)rp, a1 = *(const pg8::f32x4*)(rp + 4), a2 = *(const pg8::f32x4*)(rp + 8), a3 = *(const pg8::f32x4*)(rp + 12);
                    cs[0] = (pg8::f32x4){a0[0], a0[2], a1[0], a1[2]}; sn[0] = (pg8::f32x4){a0[1], a0[3], a1[1], a1[3]};
                    cs[1] = (pg8::f32x4){a2[0], a2[2], a3[0], a3[2]}; sn[1] = (pg8::f32x4){a2[1], a2[3], a3[1], a3[3]}; }
#pragma unroll
                for (int bj = 0; bj < 2; ++bj) {
                    pg8::f32x4 v[2] = {acc[ai][bj][m][0], acc[ai][bj][m][1]};
                    if (rotl) {
#pragma unroll
                        for (int n = 0; n < 2; ++n) {
                            pg8::f32x4 pt;
#pragma unroll
                            for (int e = 0; e < 4; ++e) pt[e] = __shfl_xor(v[n][e], 16);
                            if (fq == 0) v[n] = v[n] * cs[n] - pt * sn[n];
                            else if (fq == 1) v[n] = v[n] * cs[n] + pt * sn[n];
                        }
                    }
                    const int c = colt + bj * 128;
                    if (u.pn <= 3) {
                        const int cq = u.pn * 256 + c;
                        if (prompt) { pg8::u32x4 w; w.x = pk2(v[0][0], v[0][1]); w.y = pk2(v[0][2], v[0][3]); w.z = pk2(v[1][0], v[1][1]); w.w = pk2(v[1][2], v[1][3]); *(pg8::u32x4*)(qb + (size_t)r * 1024 + cq) = w; }
                        else if (dec) { *(pg8::f32x4*)(qr + (size_t)r * 1024 + cq) = v[0]; *(pg8::f32x4*)(qr + (size_t)r * 1024 + cq + 4) = v[1]; }
                    } else {
                        const bool isk = u.pn == 4;
                        if (prompt) {
                            pg8::u32x4 w; w.x = pk2(v[0][0], v[0][1]); w.y = pk2(v[0][2], v[0][3]); w.z = pk2(v[1][0], v[1][1]); w.w = pk2(v[1][2], v[1][3]);
                            if (isk) *(pg8::u32x4*)(kb + (size_t)r * 256 + c) = w; else *(pg8::u32x4*)(O + (size_t)r * PP + C_AV + c) = w;
                            if (t >= TP - 128) { float* op = out + (isk ? O_PK : O_PV) + (((size_t)l * 2 + sq) * 128 + (t - (TP - 128))) * 256 + c; *(pg8::f32x4*)op = v[0]; *(pg8::f32x4*)(op + 4) = v[1]; }
                        } else if (dec) {
                            float* dp = (isk ? kr + (size_t)r * 256 : vd + (size_t)(r - NPROMPT) * 256) + c; *(pg8::f32x4*)dp = v[0]; *(pg8::f32x4*)(dp + 4) = v[1];
                            float* op = out + (isk ? O_SK : O_SV) + (((size_t)l * 32 + sq) * 128 + 124 + t) * 256 + c; *(pg8::f32x4*)op = v[0]; *(pg8::f32x4*)(op + 4) = v[1];
                        }
                    }
                }
            }
    }
    __device__ __forceinline__ void operator()(const pg8::f32x4 (&acc)[2][2][4][2], const pg8::Unit& u, int wr, int wc, int fr, int fq) const {
        if (u.pn <= 5) { attn_tiles(acc, u, wr, wc, fr, fq); return; }
        const int row0 = u.pm * 256 + wr * 64 + fr, col0 = u.pn * 256 + wc * 32 + 8 * fq;
        const bool sm = wc == 0 && ((u.pn == 18 && fq < 2) || (u.pn == 34 && fq >= 2));
#pragma unroll
        for (int ai = 0; ai < 2; ++ai)
#pragma unroll
            for (int m = 0; m < 4; ++m) {
                const int r = row0 + ai * 128 + m * 16;
                bf16* rowp = O + (size_t)r * PP + col0;
#pragma unroll
                for (int bj = 0; bj < 2; ++bj) {
                    const pg8::f32x4 v0 = acc[ai][bj][m][0], v1 = acc[ai][bj][m][1];
                    pg8::u32x4 w; w.x = pk2(v0[0], v0[1]); w.y = pk2(v0[2], v0[3]); w.z = pk2(v1[0], v1[1]); w.w = pk2(v1[2], v1[3]);
                    *(pg8::u32x4*)(rowp + bj * 128) = w;
                }
                if (sm) { *(pg8::f32x4*)(small + (size_t)r * 32 + 8 * fq) = acc[ai][0][m][0]; *(pg8::f32x4*)(small + (size_t)r * 32 + 8 * fq + 4) = acc[ai][0][m][1]; }
            }
    }
};
struct EpiMix {
    static constexpr bool PERM = true, AFTER_DRAIN = false;
    const bf16* mg; float* accb; bf16* out;
    __device__ __forceinline__ void operator()(const pg8::f32x4 (&acc)[2][2][4][2], const pg8::Unit& u, int wr, int wc, int fr, int fq) const {
        const int row0 = u.pm * 256 + wr * 64 + fr, col0 = u.pn * 256 + wc * 32 + 8 * fq;
#pragma unroll
        for (int ai = 0; ai < 2; ++ai)
#pragma unroll
            for (int m = 0; m < 4; ++m) {
                const size_t r = (size_t)(row0 + ai * 128 + m * 16);
#pragma unroll
                for (int bj = 0; bj < 2; ++bj) {
                    const int col = col0 + bj * 128;
                    const u32x4v gw = *(const u32x4v*)(mg + r * PP + (size_t)u.z * D + col);
                    float gt[8];
                    gt[0] = __builtin_bit_cast(float, gw.x << 16); gt[1] = __builtin_bit_cast(float, gw.x & 0xffff0000u); gt[2] = __builtin_bit_cast(float, gw.y << 16); gt[3] = __builtin_bit_cast(float, gw.y & 0xffff0000u);
                    gt[4] = __builtin_bit_cast(float, gw.z << 16); gt[5] = __builtin_bit_cast(float, gw.z & 0xffff0000u); gt[6] = __builtin_bit_cast(float, gw.w << 16); gt[7] = __builtin_bit_cast(float, gw.w & 0xffff0000u);
                    pg8::f32x4 v0 = acc[ai][bj][m][0], v1 = acc[ai][bj][m][1];
#pragma unroll
                    for (int e = 0; e < 4; ++e) { v0[e] *= sigmoidf_(gt[e]); v1[e] *= sigmoidf_(gt[4 + e]); }
                    float* ap = accb + r * D + col;
                    if (u.z > 0) { v0 += *(const pg8::f32x4*)ap; v1 += *(const pg8::f32x4*)(ap + 4); }
                    if (u.z < 2) { *(pg8::f32x4*)ap = v0; *(pg8::f32x4*)(ap + 4) = v1; }
                    else { pg8::u32x4 w; w.x = pk2(v0[0], v0[1]); w.y = pk2(v0[2], v0[3]); w.z = pk2(v1[0], v1[1]); w.w = pk2(v1[2], v1[3]); *(pg8::u32x4*)(out + r * D + col) = w; }
                }
            }
    }
};
#define LAS __attribute__((address_space(3)))
#define XB_TMO      128
#define XB_XCNT(j)  (256  + 64 * (j))
#define XB_XSUB(j)  (1280 + 64 * (j))
#define XB_XGEN(j)  (2304 + 64 * (j))
#define XB_TOP      3328
#define XB_TOPGEN   3392
#define XCD_BAR_WORDS 3456
#define XB_SPIN_CAP (1u << 18)

__device__ __forceinline__ unsigned xb_ld(unsigned* p)              { return __hip_atomic_load(p, __ATOMIC_RELAXED, __HIP_MEMORY_SCOPE_AGENT); }
__device__ __forceinline__ unsigned xb_add(unsigned* p, unsigned v) { return __hip_atomic_fetch_add(p, v, __ATOMIC_RELAXED, __HIP_MEMORY_SCOPE_AGENT); }
__device__ __forceinline__ unsigned xb_xcc_id() { return (unsigned)__builtin_amdgcn_s_getreg((3 << 11) | 20) & 0xFu; }
#define XB_SPIN(cond, bar) do { unsigned _sp = 0; while (cond) { __builtin_amdgcn_s_sleep(1); \
    if ((++_sp & 255u) == 0u) { if (xb_ld(&(bar)[XB_TMO])) break; if (_sp > XB_SPIN_CAP) { atomicAdd(&(bar)[XB_TMO], 1u); break; } } } } while (0)

struct XcdBarrier {
    unsigned* bar; unsigned x;
    volatile LAS unsigned* st;
};

__device__ __forceinline__ XcdBarrier xcd_barrier_post(unsigned* bar, volatile LAS unsigned* st) {
    XcdBarrier b; b.bar = bar; b.x = xb_xcc_id(); b.st = st;
    if (threadIdx.x == 0) (void)xb_add(&bar[XB_XCNT(b.x)], 1u);
    return b;
}
__device__ __forceinline__ void xcd_barrier_complete(unsigned* bar, unsigned x, unsigned& nloc, unsigned& nx) {
    const unsigned G = gridDim.x * gridDim.y * gridDim.z;
    unsigned sum, cnt, mine, sp = 0u;
    for (;;) {
        sum = 0u; cnt = 0u; mine = 0u;
#pragma unroll
        for (unsigned j = 0; j < 16; ++j) { const unsigned c = xb_ld(&bar[XB_XCNT(j)]); sum += c; cnt += (c > 0u) ? 1u : 0u; mine = (j == x) ? c : mine; }
        if (sum == G) break;
        __builtin_amdgcn_s_sleep(1);
        if ((++sp & 255u) == 0u) { if (xb_ld(&bar[XB_TMO])) break; if (sp > XB_SPIN_CAP) { atomicAdd(&bar[XB_TMO], 1u); break; } }
    }
    nloc = mine > 0u ? mine : 1u; nx = cnt > 0u ? cnt : 1u;
}

__device__ __forceinline__ void xcd_barrier(const XcdBarrier& b) {
    asm volatile("s_waitcnt vmcnt(0)" ::: "memory");
    __syncthreads();
    if (threadIdx.x == 0) {
        unsigned* bar = b.bar;
        __builtin_amdgcn_s_waitcnt(0);
        unsigned nloc = b.st[0], nx = b.st[1];
        if (nloc == 0u) { xcd_barrier_complete(bar, b.x, nloc, nx); b.st[0] = nloc; b.st[1] = nx; }
        const unsigned old = xb_add(&bar[XB_XSUB(b.x)], 1u);
        const unsigned gen = old / nloc;
        if (old + 1u == (gen + 1u) * nloc) {
            __builtin_amdgcn_fence(__ATOMIC_RELEASE, "agent");
            asm volatile("s_waitcnt vmcnt(0)" ::: "memory");
            const unsigned og = xb_add(&bar[XB_TOP], 1u);
            const unsigned tg = og / nx;
            if (og + 1u == (tg + 1u) * nx) xb_add(&bar[XB_TOPGEN], 1u);
            else XB_SPIN(xb_ld(&bar[XB_TOPGEN]) == tg, bar);
            __builtin_amdgcn_fence(__ATOMIC_ACQUIRE, "agent");
            xb_add(&bar[XB_XGEN(b.x)], 1u);
            asm volatile("s_waitcnt vmcnt(0)" ::: "memory");
        } else {
            XB_SPIN(xb_ld(&bar[XB_XGEN(b.x)]) == gen, bar);
            __builtin_amdgcn_fence(__ATOMIC_ACQUIRE, "agent");
            asm volatile("s_waitcnt vmcnt(0)" ::: "memory");
        }
    }
    __syncthreads();
}

__device__ __forceinline__ void wT_load(const float* W, int K, int N, int n0, int k0, LAS float* tile, int t256) {
    const int tr = t256 >> 6, tc = t256 & 63;
#pragma unroll
    for (int i = 0; i < 16; ++i) { const int kk = tr + 4 * i; tile[kk * 65 + tc] = (n0 + tc < N) ? W[(size_t)(k0 + kk) * N + n0 + tc] : 0.f; }
}
__device__ __forceinline__ void wT_store(bf16* Bt, int K, int n0, int k0, const LAS float* tile, int t256) {
#pragma unroll
    for (int j = 0; j < 2; ++j) {
        const int id = t256 + 256 * j, nl = id >> 3, kc = id & 7;
        uint4 o;
        o.x = pk2(tile[(kc * 8 + 0) * 65 + nl], tile[(kc * 8 + 1) * 65 + nl]); o.y = pk2(tile[(kc * 8 + 2) * 65 + nl], tile[(kc * 8 + 3) * 65 + nl]);
        o.z = pk2(tile[(kc * 8 + 4) * 65 + nl], tile[(kc * 8 + 5) * 65 + nl]); o.w = pk2(tile[(kc * 8 + 6) * 65 + nl], tile[(kc * 8 + 7) * 65 + nl]);
        *(uint4*)(Bt + (size_t)(n0 + nl) * K + k0 + kc * 8) = o;
    }
}
constexpr int WT_IN = (15104 / 64) * (2048 / 64), WT_BR = 3 * (2048 / 64) * (1024 / 64), WT_OUT = (2048 / 64) * (2048 / 64), WT_UP = (11264 / 64) * (2048 / 64), WT_DN = (2048 / 64) * (5632 / 64);
constexpr int WT_LAYER = WT_IN + WT_BR + WT_OUT + WT_UP + WT_DN, WT_TOTAL = 4 * WT_LAYER;
struct WTile { const float* W; bf16* Bt; int K, N, n0, k0; };
__device__ __forceinline__ WTile wT_tile(const P& p, int id) {
    WTile w; const int l = id / WT_LAYER; int r = id % WT_LAYER;
    if (r < WT_IN) { w.W = p.in[8] + (size_t)l * 2048 * 14880; w.Bt = p.Win + (size_t)l * 15104 * 2048; w.K = 2048; w.N = 14880; w.n0 = (r / 32) * 64; w.k0 = (r % 32) * 64; return w; }
    r -= WT_IN;
    if (r < WT_BR) { const int b = r / 512, q = r % 512; w.W = p.in[17] + ((size_t)l * 3 + b) * 1024 * 2048; w.Bt = p.Wbr + ((size_t)l * 3 + b) * 2048 * 1024; w.K = 1024; w.N = 2048; w.n0 = (q / 16) * 64; w.k0 = (q % 16) * 64; return w; }
    r -= WT_BR;
    if (r < WT_OUT) { w.W = p.in[18] + (size_t)l * 2048 * 2048; w.Bt = p.Wout + (size_t)l * 2048 * 2048; w.K = 2048; w.N = 2048; w.n0 = (r / 32) * 64; w.k0 = (r % 32) * 64; return w; }
    r -= WT_OUT;
    if (r < WT_UP) { w.W = p.in[21] + (size_t)l * 2048 * 11264; w.Bt = p.Wup + (size_t)l * 11264 * 2048; w.K = 2048; w.N = 11264; w.n0 = (r / 32) * 64; w.k0 = (r % 32) * 64; return w; }
    r -= WT_UP;
    w.W = p.in[23] + (size_t)l * 5632 * 2048; w.Bt = p.Wdn + (size_t)l * 2048 * 5632; w.K = 5632; w.N = 2048; w.n0 = (r / 88) * 64; w.k0 = (r % 88) * 64; return w;
}
__device__ __forceinline__ void wT_wave_task(const P& p, int id, int lane) {
    const WTile w = wT_tile(p, id);
    const int n = w.n0 + lane; const bool ok = n < w.N;
    const float* q = w.W + (size_t)w.k0 * w.N + (ok ? n : 0);
    float v[64];
#pragma unroll
    for (int kk = 0; kk < 64; ++kk) { v[kk] = *q; q += w.N; }
    bf16* o = w.Bt + (size_t)n * w.K + w.k0;
#pragma unroll
    for (int j = 0; j < 8; ++j) { u32x4v x; x.x = pk2(v[8 * j], v[8 * j + 1]); x.y = pk2(v[8 * j + 2], v[8 * j + 3]); x.z = pk2(v[8 * j + 4], v[8 * j + 5]); x.w = pk2(v[8 * j + 6], v[8 * j + 7]);
        if (!ok) x = (u32x4v){0u, 0u, 0u, 0u};
        *(u32x4v*)(o + 8 * j) = x; }
}
__device__ __forceinline__ void xinit_phase(const P& p, size_t i0, size_t stride) {
    const size_t n = (size_t)MROWS * D / 4;
    for (size_t i = i0; i < n; i += stride) {
        const size_t e = i * 4;
        const float4 v = e < (size_t)NPROMPT * D ? *(const float4*)(p.in[0] + e) : *(const float4*)(p.in[1] + (e - (size_t)NPROMPT * D));
        *(float4*)(p.X + e) = v;
        *(uint2*)(p.Xb + e) = make_uint2(pk2(v.x, v.y), pk2(v.z, v.w));
    }
}

__device__ __forceinline__ float sin_rev(float x) {
    x -= floorf(x);
    float y = x > 0.5f ? x - 1.0f : x;
    y = y > 0.25f ? 0.5f - y : (y < -0.25f ? -0.5f - y : y);
    const float a = y * 6.283185307179586f, a2 = a * a;
    float p = -2.5052108385441718e-08f;
    p = fmaf(p, a2, 2.7557319223985893e-06f);
    p = fmaf(p, a2, -1.984126984126984e-04f);
    p = fmaf(p, a2, 8.333333333333333e-03f);
    p = fmaf(p, a2, -1.6666666666666666e-01f);
    return fmaf(a * a2, p, a);
}
__device__ __forceinline__ double rot_inv_rev(int i) {
    const double t[8] = {0.15915494309189535, 0.03086376340470123, 0.005985185712713705, 0.001160663641240061,
                         0.00022507907903927653, 4.364795279280289e-05, 8.464330808241401e-06, 1.6414262627950345e-06};
    double r = t[0];
#pragma unroll
    for (int k = 1; k < 8; ++k) r = (i == k) ? t[k] : r;
    return r;
}
__device__ __forceinline__ void prep_task(const P& p, int l, int r, int part, int lane) {
    const bf16* pr = p.PROJ + (size_t)r * PP;
    const int s = row_seq(r), t = row_t(r);
    const float* cw = p.in[13] + (size_t)l * 4 * 3072;
    const int r0 = seq_row0(s);
    {
        const int hh = part - 1;
        float v2[2];
#pragma unroll
        for (int i = 0; i < 2; ++i) {
            const int c = hh * 128 + lane + 64 * i;
            float y = 0.f;
#pragma unroll
            for (int j = 0; j < 4; ++j) {
                const int tt = t - 3 + j;
                float xv;
                if (tt >= 0) xv = ldbf(p.PROJ + (size_t)(r0 + tt) * PP + C_CQKV + c);
                else xv = s < 2 ? 0.f : p.in[6][(((size_t)l * 32 + (s - 2)) * 3 + (3 + tt)) * 3072 + c];
                y = fmaf(cw[j * 3072 + c], xv, y);
            }
            v2[i] = siluf_(y);
        }
        if (hh < 16) {
            const float ss = wave_sum(v2[0] * v2[0] + v2[1] * v2[1]);
            float sc = __builtin_amdgcn_rsqf(ss + 1e-6f);
            if (hh < 8) sc *= 0.08838834764831845f;
            v2[0] *= sc; v2[1] *= sc;
        }
        p.DQKV[(size_t)r * 3072 + hh * 128 + lane] = v2[0];
        p.DQKV[(size_t)r * 3072 + hh * 128 + lane + 64] = v2[1];
    }
}

constexpr int PREP_ROWS = 5;
__device__ __forceinline__ void prep_rows_task(const P& p, int l, int rb, int lane) {
    float blr[PREP_ROWS][16];
#pragma unroll
    for (int rr = 0; rr < PREP_ROWS; ++rr)
#pragma unroll
        for (int j = 0; j < 16; ++j) blr[rr][j] = p.SMALL[(size_t)(rb + rr) * 32 + j];
    const float* Wg = p.in[10] + (size_t)l * 16 * 512; const float* bg = p.in[11] + (size_t)l * 512;
#pragma unroll 1
    for (int c = lane; c < 512; c += 64) {
        float wg[16]; const float b = bg[c];
#pragma unroll
        for (int j = 0; j < 16; ++j) wg[j] = Wg[j * 512 + c];
#pragma unroll
        for (int rr = 0; rr < PREP_ROWS; ++rr) {
            float z = b;
#pragma unroll
            for (int j = 0; j < 16; ++j) z = fmaf(blr[rr][j], wg[j], z);
            const float ls = fminf(z, 0.f) - __logf(1.f + __expf(-fabsf(z)));
            p.AG[(size_t)(rb + rr) * 512 + c] = ls * (1.f / 16.f);
        }
    }
    if (lane < 8 * PREP_ROWS) {
        const int rr = lane >> 3, hd = lane & 7, r = rb + rr;
        const float a_log = p.in[14][l * 8 + hd], dtb = p.in[15][l * 8 + hd];
        p.G[(size_t)r * 8 + hd] = -__expf(a_log) * softplusf_(p.SMALL[(size_t)r * 32 + 16 + hd] + dtb);
        p.BETA[(size_t)r * 8 + hd] = sigmoidf_(p.SMALL[(size_t)r * 32 + 24 + hd]);
    }
#pragma unroll 1
    for (int rr = 0; rr < PREP_ROWS; ++rr) {
        const int r = rb + rr, s = row_seq(r), t = row_t(r);
        int oi = -1; size_t ob = 0;
        if (s < 2) { if (t >= TP - 3) { oi = t - (TP - 3); ob = O_PDCONV + ((size_t)l * 2 + s) * 3 * 3072; } }
        else if (t >= 1) { oi = t - 1; ob = O_SDCONV + ((size_t)l * 32 + (s - 2)) * 3 * 3072; }
        if (oi >= 0) {
            const bf16* pr = p.PROJ + (size_t)r * PP;
#pragma unroll 1
            for (int c = lane * 4; c < 3072; c += 256) *(f32x4v*)(p.out + ob + (size_t)oi * 3072 + c) = ldbf4(pr + C_CQKV + c);
        }
    }
}
constexpr int CONV_ROWS = 16;
__device__ __forceinline__ void prep_conv_task(const P& p, int l, int task, int lane) {
    const int rg = task / 12, sl = task - rg * 12, c = sl * 256 + lane * 4, ra = rg * CONV_ROWS, t0 = ra & 4095;
    const float* cw = p.in[13] + (size_t)l * 4 * 3072;
    f32x4v x[CONV_ROWS + 3], w[4];
#pragma unroll
    for (int i = 0; i < CONV_ROWS + 3; ++i) {
        if (i < 3 && t0 == 0) x[i] = (f32x4v){0.f, 0.f, 0.f, 0.f};
        else x[i] = ldbf4(p.PROJ + (size_t)(ra - 3 + i) * PP + C_CQKV + c);
    }
#pragma unroll
    for (int j = 0; j < 4; ++j) w[j] = *(const f32x4v*)(cw + j * 3072 + c);
#pragma unroll
    for (int i = 0; i < CONV_ROWS; ++i) {
        f32x4v y = w[0] * x[i] + w[1] * x[i + 1] + w[2] * x[i + 2] + w[3] * x[i + 3];
        y.x = siluf_(y.x); y.y = siluf_(y.y); y.z = siluf_(y.z); y.w = siluf_(y.w);
        if (sl < 8) {
            float ss = y.x * y.x + y.y * y.y + y.z * y.z + y.w * y.w;
            ss = row16_sum(ss); ss += __shfl_xor(ss, 16);
            float sc = __builtin_amdgcn_rsqf(ss + 1e-6f);
            if (sl < 4) sc *= 0.08838834764831845f;
            y = y * sc;
        }
        *(f32x4v*)(p.DQKV + (size_t)(ra + i) * 3072 + c) = y;
    }
}
__device__ __forceinline__ bool kv_ptrs(const P& p, int l, int s, int t, int g, int j, const float*& kp, const float*& vp) {
    kp = nullptr; vp = nullptr;
    if (j > 128) return false;
    if (s < 2) {
        const int tk = t - 128 + j;
        if (tk < 0) return false;
        const size_t rr = (size_t)(s * TP + tk);
        kp = p.KR + rr * 256 + g * 64; vp = nullptr; return true;
    }
    const int jj = t + j;
    if (jj < 128) { const size_t o = ((((size_t)l * 32 + (s - 2)) * 128 + jj) * 4 + g) * 64; kp = p.in[2] + o; vp = p.in[3] + o; }
    else { const size_t rr = (size_t)(NPROMPT + (s - 2) * TD + (jj - 128)); kp = p.KR + rr * 256 + g * 64; vp = p.VD + (rr - NPROMPT) * 256 + g * 64; }
    return true;
}
__device__ __forceinline__ void attn_task(const P& p, int l, int r, int g, int lane) {
    const int s = row_seq(r), t = row_t(r);
    const float *k0, *k1, *k2, *vdummy;
    const bool ok0 = kv_ptrs(p, l, s, t, g, lane, k0, vdummy);
    const bool ok1 = kv_ptrs(p, l, s, t, g, lane + 64, k1, vdummy);
    const bool ok2 = kv_ptrs(p, l, s, t, g, lane + 128, k2, vdummy);
    float sc0[4] = {0, 0, 0, 0}, sc1[4] = {0, 0, 0, 0}, sc2[4] = {0, 0, 0, 0};
    const float* qp = p.QR + (size_t)r * 1024 + g * 256;
    for (int d4 = 0; d4 < 16; ++d4) {
        const float4 z4 = make_float4(0, 0, 0, 0);
        const float4 a = ok0 ? *(const float4*)(k0 + d4 * 4) : z4;
        const float4 b = ok1 ? *(const float4*)(k1 + d4 * 4) : z4;
        const float4 c = ok2 ? *(const float4*)(k2 + d4 * 4) : z4;
#pragma unroll
        for (int h = 0; h < 4; ++h) {
            const float4 qv = *(const float4*)(qp + h * 64 + d4 * 4);
            sc0[h] += qv.x * a.x + qv.y * a.y + qv.z * a.z + qv.w * a.w;
            sc1[h] += qv.x * b.x + qv.y * b.y + qv.z * b.z + qv.w * b.w;
            sc2[h] += qv.x * c.x + qv.y * c.y + qv.z * c.z + qv.w * c.w;
        }
    }
    float p0[4], p1[4], p2[4], den[4];
#pragma unroll
    for (int h = 0; h < 4; ++h) {
        const float sink = p.in[9][l * 16 + g * 4 + h];
        float m = sink;
        sc0[h] *= 0.125f; sc1[h] *= 0.125f; sc2[h] *= 0.125f;
        if (ok0) m = fmaxf(m, sc0[h]);
        if (ok1) m = fmaxf(m, sc1[h]);
        if (ok2) m = fmaxf(m, sc2[h]);
        m = wave_max(m);
        p0[h] = ok0 ? __expf(sc0[h] - m) : 0.f; p1[h] = ok1 ? __expf(sc1[h] - m) : 0.f; p2[h] = ok2 ? __expf(sc2[h] - m) : 0.f;
        den[h] = wave_sum(p0[h] + p1[h] + p2[h]) + __expf(sink - m);
    }
    float o[4] = {0.f, 0.f, 0.f, 0.f};
    {
        const float* cvb = p.in[3] + ((((size_t)l * 32 + (s - 2)) * 128) * 4 + g) * 64 + lane;
        const float* vdb = p.VD + (size_t)((s - 2) * TD) * 256 + g * 64 + lane;
        const int ncache = 128 - t;
#pragma unroll 1
        for (int j0 = 0; j0 < 128; j0 += 8) {
            float vv[8];
#pragma unroll
            for (int e = 0; e < 8; ++e) { const int j = j0 + e; vv[e] = j < ncache ? cvb[(size_t)(t + j) * 256] : vdb[(size_t)(t + j - 128) * 256]; }
#pragma unroll
            for (int e = 0; e < 8; ++e) { const int j = j0 + e, jl = j & 63;
#pragma unroll
                for (int h = 0; h < 4; ++h) { const float pj = j0 < 64 ? __shfl(p0[h], jl) : __shfl(p1[h], jl); o[h] = fmaf(pj, vv[e], o[h]); } }
        }
        { const float vv = vdb[(size_t)t * 256];
#pragma unroll
          for (int h = 0; h < 4; ++h) o[h] = fmaf(__shfl(p2[h], 0), vv, o[h]); }
    }
#pragma unroll
    for (int h = 0; h < 4; ++h) p.OAb[(size_t)r * 1024 + (g * 4 + h) * 64 + lane] = (bf16)f2bf(o[h] / den[h]);
    if (s >= 2 && t == 0) {
        const size_t b0 = ((((size_t)l * 32 + (s - 2)) * 128) * 4 + g) * 64 + lane;
#pragma unroll 1
        for (int i0 = 0; i0 < 124; i0 += 4) {
            float kk[4], vv[4];
#pragma unroll
            for (int e = 0; e < 4; ++e) { kk[e] = p.in[2][b0 + (size_t)(i0 + e + 4) * 256]; vv[e] = p.in[3][b0 + (size_t)(i0 + e + 4) * 256]; }
#pragma unroll
            for (int e = 0; e < 4; ++e) { p.out[O_SK + b0 + (size_t)(i0 + e) * 256] = kk[e]; p.out[O_SV + b0 + (size_t)(i0 + e) * 256] = vv[e]; }
        }
    }
}
__device__ __forceinline__ void gla_task(const P& p, int l, int s, int h, int sl, int lane) {
    const int dkg = lane >> 3, c = lane & 7, col = sl * 8 + c;
    const float* st = p.in[4] + ((((size_t)l * 32 + (s - 2)) * 4 + h) * 128) * 256;
    float S[16];
#pragma unroll
    for (int i = 0; i < 16; ++i) S[i] = st[(size_t)(dkg * 16 + i) * 256 + col];
    const size_t r0 = (size_t)seq_row0(s);
    f32x4v a[TD][4], k[TD][4], q[TD][4]; float v[TD], o[TD];
#pragma unroll
    for (int t = 0; t < TD; ++t) {
        const bf16* pr = p.PROJ + (r0 + t) * PP;
        v[t] = ldbf(pr + C_BV + h * 256 + col);
#pragma unroll
        for (int i4 = 0; i4 < 4; ++i4) {
            a[t][i4] = *(const f32x4v*)(p.AG + (r0 + t) * 512 + h * 128 + dkg * 16 + 4 * i4);
            k[t][i4] = ldbf4(pr + C_BK + h * 128 + dkg * 16 + 4 * i4); q[t][i4] = ldbf4(pr + C_BQ + h * 128 + dkg * 16 + 4 * i4);
        }
    }
#pragma unroll
    for (int t = 0; t < TD; ++t) {
        float ot = 0.f;
#pragma unroll
        for (int i4 = 0; i4 < 4; ++i4) {
            S[4 * i4 + 0] = fmaf(S[4 * i4 + 0], __expf(a[t][i4].x), k[t][i4].x * v[t]); ot = fmaf(q[t][i4].x, S[4 * i4 + 0], ot);
            S[4 * i4 + 1] = fmaf(S[4 * i4 + 1], __expf(a[t][i4].y), k[t][i4].y * v[t]); ot = fmaf(q[t][i4].y, S[4 * i4 + 1], ot);
            S[4 * i4 + 2] = fmaf(S[4 * i4 + 2], __expf(a[t][i4].z), k[t][i4].z * v[t]); ot = fmaf(q[t][i4].z, S[4 * i4 + 2], ot);
            S[4 * i4 + 3] = fmaf(S[4 * i4 + 3], __expf(a[t][i4].w), k[t][i4].w * v[t]); ot = fmaf(q[t][i4].w, S[4 * i4 + 3], ot);
        }
        ot += DPP_F(ot, 0x128);     ot += __shfl_xor(ot, 16); ot += __shfl_xor(ot, 32);
        o[t] = ot * 0.08838834764831845f;
    }
    if (dkg == 0) {
#pragma unroll
        for (int t = 0; t < TD; ++t) p.OBRAW[(r0 + t) * 1024 + h * 256 + col] = o[t];
    }
    float* so = p.out + O_SGLA + ((((size_t)l * 32 + (s - 2)) * 4 + h) * 128) * 256;
#pragma unroll
    for (int i = 0; i < 16; ++i) so[(size_t)(dkg * 16 + i) * 256 + col] = S[i];
}
__device__ __forceinline__ void delta_task(const P& p, int l, int s, int h, int sl, int lane) {
    const int dkg = lane >> 3, c = lane & 7, col = sl * 8 + c;
    const float* st = p.in[5] + ((((size_t)l * 32 + (s - 2)) * 8 + h) * 128) * 128;
    float S[16];
#pragma unroll
    for (int i = 0; i < 16; ++i) S[i] = st[(size_t)(dkg * 16 + i) * 128 + col];
    const size_t r0 = (size_t)seq_row0(s);
    f32x4v k[TD][4], q[TD][4]; float v[TD], g[TD], be[TD], o[TD];
#pragma unroll
    for (int t = 0; t < TD; ++t) {
        const float* dq = p.DQKV + (r0 + t) * 3072 + h * 128 + dkg * 16;
        v[t] = dq[2048 - dkg * 16 + col]; g[t] = p.G[(r0 + t) * 8 + h]; be[t] = p.BETA[(r0 + t) * 8 + h];
#pragma unroll
        for (int i4 = 0; i4 < 4; ++i4) { q[t][i4] = *(const f32x4v*)(dq + 4 * i4); k[t][i4] = *(const f32x4v*)(dq + 1024 + 4 * i4); }
    }
#pragma unroll
    for (int t = 0; t < TD; ++t) {
        const float a = __expf(g[t]);
        float kS = 0.f, qS = 0.f, qk = 0.f;
#pragma unroll
        for (int i4 = 0; i4 < 4; ++i4)
#pragma unroll
            for (int e = 0; e < 4; ++e) { kS = fmaf(k[t][i4][e], S[4 * i4 + e], kS); qS = fmaf(q[t][i4][e], S[4 * i4 + e], qS); qk = fmaf(q[t][i4][e], k[t][i4][e], qk); }
        kS += DPP_F(kS, 0x128); kS += __shfl_xor(kS, 16); kS += __shfl_xor(kS, 32);
        qS += DPP_F(qS, 0x128); qS += __shfl_xor(qS, 16); qS += __shfl_xor(qS, 32);
        qk += DPP_F(qk, 0x128); qk += __shfl_xor(qk, 16); qk += __shfl_xor(qk, 32);
        const float u = be[t] * (v[t] - a * kS);
#pragma unroll
        for (int i4 = 0; i4 < 4; ++i4)
#pragma unroll
            for (int e = 0; e < 4; ++e) S[4 * i4 + e] = fmaf(a, S[4 * i4 + e], k[t][i4][e] * u);
        o[t] = a * qS + qk * u;
    }
    if (dkg == 0) {
#pragma unroll
        for (int t = 0; t < TD; ++t) p.OCRAW[(r0 + t) * 1024 + h * 128 + col] = o[t];
    }
    float* so = p.out + O_SDELTA + ((((size_t)l * 32 + (s - 2)) * 8 + h) * 128) * 128;
#pragma unroll
    for (int i = 0; i < 16; ++i) so[(size_t)(dkg * 16 + i) * 128 + col] = S[i];
}
__device__ __forceinline__ void scan_task(const P& p, int l, int task, int lane) {
    if (task < 256) { gla_task(p, l, task >> 7, (task >> 5) & 3, task & 31, lane); return; }
    task -= 256;
    if (task < 256) { delta_task(p, l, task >> 7, (task >> 4) & 7, task & 15, lane); return; }
    task -= 256;
    if (task < 4096) { gla_task(p, l, 2 + (task >> 7), (task >> 5) & 3, task & 31, lane); return; }
    task -= 4096;
    delta_task(p, l, 2 + (task >> 7), (task >> 4) & 7, task & 15, lane);
}
constexpr int N_SCAN_TASKS = 512 + 8192;

constexpr int CH = 64, NCH = TP / CH;
__device__ __forceinline__ f32x16 mma32(bf16x8 a, bf16x8 b, f32x16 c) { return __builtin_amdgcn_mfma_f32_32x32x16_bf16(a, b, c, 0, 0, 0); }
__device__ __forceinline__ int acc_row(int reg, int hh) { return (reg & 3) + 8 * (reg >> 2) + 4 * hh; }
__device__ __forceinline__ f32x16 zero16() { f32x16 z;
#pragma unroll
    for (int i = 0; i < 16; ++i) z[i] = 0.f;
    return z; }
__device__ __forceinline__ float bf2f(unsigned b) { return __builtin_bit_cast(float, b << 16); }
#define LDS_WAIT() asm volatile("s_waitcnt lgkmcnt(0)" ::: "memory")


__device__ __forceinline__ void attn_prompt_task(const P& p, int l, int s, int qb, int h, LAS unsigned char* ldsw, int lane) {
    LAS bf16* PT = (LAS bf16*)ldsw;
    const int r = lane & 31, hh = lane >> 5, g = h >> 2, q0 = 32 * qb;
    bf16x8 qf[4];
#pragma unroll
    for (int ks = 0; ks < 4; ++ks) qf[ks] = *(const bf16x8*)(p.QB16 + (size_t)(s * TP + q0 + r) * 1024 + h * 64 + 16 * ks + 8 * hh);
    f32x16 st[5];
#pragma unroll
    for (int kt = 0; kt < 5; ++kt) {
        int pk = q0 - 128 + 32 * kt + r; pk = pk < 0 ? 0 : pk;
        st[kt] = zero16();
#pragma unroll
        for (int ks = 0; ks < 4; ++ks) { const bf16x8 kf = *(const bf16x8*)(p.KB16 + (size_t)(s * TP + pk) * 256 + g * 64 + 16 * ks + 8 * hh); st[kt] = mma32(kf, qf[ks], st[kt]); }
    }
    const float sink = p.in[9][l * 16 + h];
    float m = sink;
#pragma unroll
    for (int kt = 0; kt < 5; ++kt)
#pragma unroll
        for (int reg = 0; reg < 16; ++reg) {
            const int kk = 32 * kt + acc_row(reg, hh);
            const bool valid = (kk >= r) && (kk <= r + 128) && (q0 - 128 + kk >= 0);
            const float v = valid ? st[kt][reg] * 0.125f : -3.0e38f;
            st[kt][reg] = v; m = fmaxf(m, v);
        }
    m = fmaxf(m, __shfl_xor(m, 32));
    float sum = 0.f;
#pragma unroll
    for (int kt = 0; kt < 5; ++kt)
#pragma unroll
        for (int reg = 0; reg < 16; ++reg) { const float e = st[kt][reg] > -1.0e38f ? __expf(st[kt][reg] - m) : 0.f; st[kt][reg] = e; sum += e; }
    sum += __shfl_xor(sum, 32);
    const float inv = 1.f / (sum + __expf(sink - m));
    f32x16 o[2]; o[0] = zero16(); o[1] = zero16();
#pragma unroll
    for (int kt = 0; kt < 5; ++kt) {
#pragma unroll
        for (int gq = 0; gq < 4; ++gq) { u32x2v w; w.x = pk2(st[kt][4 * gq], st[kt][4 * gq + 1]); w.y = pk2(st[kt][4 * gq + 2], st[kt][4 * gq + 3]); *(LAS u32x2v*)(PT + r * 40 + 8 * gq + 4 * hh) = w; }
        LDS_WAIT();
#pragma unroll
        for (int ks = 0; ks < 2; ++ks) {
            const bf16x8 pf = *(const LAS bf16x8*)(PT + r * 40 + 16 * ks + 8 * hh);
            int p0 = q0 - 128 + 32 * kt + 16 * ks + 8 * hh; p0 = p0 < 0 ? 0 : p0;
#pragma unroll
            for (int dt = 0; dt < 2; ++dt) { const bf16x8 vf = *(const bf16x8*)(p.VT16 + ((size_t)(s * 4 + g) * 64 + 32 * dt + r) * TP + p0); o[dt] = mma32(vf, pf, o[dt]); }
        }
        LDS_WAIT();
    }
#pragma unroll
    for (int dt = 0; dt < 2; ++dt)
#pragma unroll
        for (int gq = 0; gq < 4; ++gq) { u32x2v w; w.x = pk2(o[dt][4 * gq] * inv, o[dt][4 * gq + 1] * inv); w.y = pk2(o[dt][4 * gq + 2] * inv, o[dt][4 * gq + 3] * inv);
            *(u32x2v*)(p.OAb + (size_t)(s * TP + q0 + r) * 1024 + h * 64 + 32 * dt + 8 * gq + 4 * hh) = w; }
}
__device__ __forceinline__ void vt_task(const P& p, int task, LAS unsigned char* ldsw, int lane) {
    const int s = task >> 8, n = (task >> 2) & 63, g = task & 3, r0 = s * TP + n * CH;
    LAS bf16* tile = (LAS bf16*)ldsw;
    { bf16 vv[64];
#pragma unroll
      for (int t = 0; t < 64; ++t) vv[t] = p.PROJ[(size_t)(r0 + t) * PP + C_AV + g * 64 + lane];
#pragma unroll
      for (int t = 0; t < 64; ++t) tile[t * 66 + lane] = vv[t]; }
    LDS_WAIT();
#pragma unroll
    for (int tg = 0; tg < 8; ++tg) { u32x4v w;
        w.x = (unsigned)tile[(8 * tg + 0) * 66 + lane] | ((unsigned)tile[(8 * tg + 1) * 66 + lane] << 16); w.y = (unsigned)tile[(8 * tg + 2) * 66 + lane] | ((unsigned)tile[(8 * tg + 3) * 66 + lane] << 16);
        w.z = (unsigned)tile[(8 * tg + 4) * 66 + lane] | ((unsigned)tile[(8 * tg + 5) * 66 + lane] << 16); w.w = (unsigned)tile[(8 * tg + 6) * 66 + lane] | ((unsigned)tile[(8 * tg + 7) * 66 + lane] << 16);
        *(u32x4v*)(p.VT16 + ((size_t)(s * 4 + g) * 64 + lane) * TP + n * CH + 8 * tg) = w; }
    LDS_WAIT();
}

__device__ __forceinline__ void gla_prepass(const P& p, int ch, LAS unsigned char* lds, int tid) {
    const int s = ch >> 8, n = (ch >> 2) & 63, h = ch & 3, r0 = s * TP + n * CH;
    LAS bf16* QTs = (LAS bf16*)lds;
    LAS bf16* KTs = (LAS bf16*)(lds + 17408);
    LAS bf16* VTs = (LAS bf16*)(lds + 34816);
    LAS bf16* As = (LAS bf16*)(lds + 71680);
    LAS float* PART = (LAS float*)(lds + 80896);
    const int lane = tid & 63, wave = tid >> 6;
    {
        const int dk = tid & 127, part = tid >> 7;
        float gl[16]; bf16 qr[16], kr[16], vr[32]; float sum = 0.f;
#pragma unroll
        for (int i = 0; i < 16; ++i) gl[i] = p.AG[(size_t)(r0 + part * 16 + i) * 512 + h * 128 + dk];
#pragma unroll
        for (int i = 0; i < 16; ++i) { const bf16* pr = p.PROJ + (size_t)(r0 + part * 16 + i) * PP; qr[i] = pr[C_BQ + h * 128 + dk]; kr[i] = pr[C_BK + h * 128 + dk]; }
#pragma unroll
        for (int i = 0; i < 32; ++i) { const int e = tid + 512 * i, t = e >> 8, dv = e & 255; vr[i] = p.PROJ[(size_t)(r0 + t) * PP + C_BV + h * 256 + dv]; }
#pragma unroll
        for (int i = 0; i < 16; ++i) sum += gl[i];
        PART[part * 128 + dk] = sum;
        __syncthreads();
        float pre = 0.f, tot = 0.f;
#pragma unroll
        for (int pp = 0; pp < 4; ++pp) { const float v = PART[pp * 128 + dk]; tot += v; pre += pp < part ? v : 0.f; }
        float b = pre;
#pragma unroll
        for (int i = 0; i < 16; ++i) {
            const int t = part * 16 + i; b += gl[i];
            const float q = bf2f(qr[i]), k = bf2f(kr[i]);
            QTs[t * 136 + dk] = (bf16)f2bf(q * 0.08838834764831845f * __expf(b));
            KTs[t * 136 + dk] = (bf16)f2bf(k * __expf(-b));
        }
        if (part == 0) p.GDEC[(size_t)ch * 128 + dk] = __expf(tot);
#pragma unroll
        for (int i = 0; i < 32; ++i) { const int e = tid + 512 * i, t = e >> 8, dv = e & 255; VTs[dv * 72 + t] = vr[i]; }
    }
    __syncthreads();
#pragma unroll
    for (int i = 0; i < 2; ++i) { const int c = tid + 512 * i, t = c >> 4, c8 = (c & 15) * 8; *(u32x4v*)(p.GQT + ((size_t)ch * 64 + t) * 128 + c8) = *(const LAS u32x4v*)(QTs + t * 136 + c8); }
#pragma unroll
    for (int i = 0; i < 2; ++i) { const int c = tid + 512 * i, dk = c & 127, tg = c >> 7; uint4 w;
        w.x = (unsigned)KTs[(8 * tg + 0) * 136 + dk] | ((unsigned)KTs[(8 * tg + 1) * 136 + dk] << 16); w.y = (unsigned)KTs[(8 * tg + 2) * 136 + dk] | ((unsigned)KTs[(8 * tg + 3) * 136 + dk] << 16);
        w.z = (unsigned)KTs[(8 * tg + 4) * 136 + dk] | ((unsigned)KTs[(8 * tg + 5) * 136 + dk] << 16); w.w = (unsigned)KTs[(8 * tg + 6) * 136 + dk] | ((unsigned)KTs[(8 * tg + 7) * 136 + dk] << 16);
        *(uint4*)(p.GKT + ((size_t)ch * 128 + dk) * 64 + 8 * tg) = w; }
#pragma unroll
    for (int i = 0; i < 4; ++i) { const int c = tid + 512 * i, dv = c >> 3, tg = c & 7; *(u32x4v*)(p.GVT + ((size_t)ch * 256 + dv) * 64 + 8 * tg) = *(const LAS u32x4v*)(VTs + dv * 72 + 8 * tg); }
    if (wave < 4) {
        const int ti = wave >> 1, tj = wave & 1, r = lane & 31, hh = lane >> 5;
        f32x16 acc = zero16();
        if (!(ti == 0 && tj == 1)) {
#pragma unroll
            for (int ks = 0; ks < 8; ++ks) {
                const bf16x8 a = *(const LAS bf16x8*)(QTs + (32 * ti + r) * 136 + 16 * ks + 8 * hh);
                const bf16x8 b = *(const LAS bf16x8*)(KTs + (32 * tj + r) * 136 + 16 * ks + 8 * hh);
                acc = mma32(a, b, acc);
            }
        }
#pragma unroll
        for (int reg = 0; reg < 16; ++reg) { const int tr = 32 * ti + acc_row(reg, hh), sc = 32 * tj + r; As[tr * 72 + sc] = (bf16)f2bf(tr >= sc ? acc[reg] : 0.f); }
    }
    __syncthreads();
    { const int t = tid >> 3, c8 = (tid & 7) * 8; *(u32x4v*)(p.GA + ((size_t)ch * 64 + t) * 64 + c8) = *(const LAS u32x4v*)(As + t * 72 + c8); }
    __syncthreads();
}

#define DMA16(gptr, lptr) __builtin_amdgcn_global_load_lds((const unsigned*)(gptr), (LAS unsigned*)(lptr), 16, 0, 0)
#define VM_WAIT_N(n) asm volatile("s_waitcnt vmcnt(" #n ")" ::: "memory")
#define FRAG16(buf, f, lane) (*(const LAS bf16x8*)((buf) + (f) * 1024 + (lane) * 16))
#define FRAGF4(buf, f, lane) (*(const LAS f32x4v*)((buf) + (f) * 1024 + (lane) * 16))
#ifndef SCAN_LOADERS
#define SCAN_LOADERS 1
#endif
constexpr int SCAN_FLAGS_OFF = 13312;
template <bool SLEEP = false> __device__ __forceinline__ bool lds_wait_ge(volatile LAS unsigned* w, unsigned need, volatile LAS unsigned* abortw) {
    unsigned sp = 0; bool ok = true;
    while (*w < need) { if (SLEEP) __builtin_amdgcn_s_sleep(1); if ((++sp & 1023u) == 0u) { if (*abortw != 0u) { ok = false; break; } if (sp > (1u << 22)) { *abortw = 1u; ok = false; break; } } }
    __builtin_amdgcn_fence(__ATOMIC_ACQUIRE, "workgroup");
    asm volatile("" ::: "memory");
    return ok;
}
__device__ __forceinline__ void gla_issue_A_half(const P& p, int ch, int sl, LAS unsigned char* bufA, int r, int hh, int ti) {
    if (ti == 0) {
#pragma unroll
        for (int ks = 0; ks < 4; ++ks) DMA16(p.GVT + ((size_t)ch * 256 + 32 * sl + r) * 64 + 16 * ks + 8 * hh, bufA + ks * 1024);
    }
#pragma unroll
    for (int ks = 0; ks < 8; ++ks) DMA16(p.GQT + ((size_t)ch * 64 + 32 * ti + r) * 128 + 16 * ks + 8 * hh, bufA + (4 + ti * 8 + ks) * 1024);
#pragma unroll
    for (int ks = 0; ks < 4; ++ks) DMA16(p.GA + ((size_t)ch * 64 + 32 * ti + r) * 64 + 16 * ks + 8 * hh, bufA + (20 + ti * 4 + ks) * 1024);
}
__device__ __forceinline__ void delta_issue_A_half(const P& p, int ch, int sl, LAS unsigned char* bufA, int r, int hh, int ti) {
#pragma unroll
    for (int ks = 0; ks < 8; ++ks) {
        DMA16(p.DNW + ((size_t)ch * 64 + 32 * ti + r) * 128 + 16 * ks + 8 * hh, bufA + (ti * 8 + ks) * 1024);
        DMA16(p.DQD + ((size_t)ch * 64 + 32 * ti + r) * 128 + 16 * ks + 8 * hh, bufA + (16 + ti * 8 + ks) * 1024);
    }
#pragma unroll
    for (int g = 0; g < 4; ++g) DMA16(p.DUB + ((size_t)ch * 128 + 32 * sl + r) * 64 + 32 * ti + 8 * g + 4 * hh, bufA + (32 + ti * 4 + g) * 1024);
}
__device__ __forceinline__ void gla_issue_A(const P& p, int ch, int sl, LAS unsigned char* bufA, int r, int hh) {
#pragma unroll
    for (int ks = 0; ks < 4; ++ks) DMA16(p.GVT + ((size_t)ch * 256 + 32 * sl + r) * 64 + 16 * ks + 8 * hh, bufA + ks * 1024);
#pragma unroll
    for (int ti = 0; ti < 2; ++ti)
#pragma unroll
        for (int ks = 0; ks < 8; ++ks) DMA16(p.GQT + ((size_t)ch * 64 + 32 * ti + r) * 128 + 16 * ks + 8 * hh, bufA + (4 + ti * 8 + ks) * 1024);
#pragma unroll
    for (int ti = 0; ti < 2; ++ti)
#pragma unroll
        for (int ks = 0; ks < 4; ++ks) DMA16(p.GA + ((size_t)ch * 64 + 32 * ti + r) * 64 + 16 * ks + 8 * hh, bufA + (20 + ti * 4 + ks) * 1024);
}
__device__ __forceinline__ void gla_issue_B(const P& p, int ch, LAS unsigned char* bufB, int r, int hh) {
#pragma unroll
    for (int d = 0; d < 4; ++d)
#pragma unroll
        for (int ks = 0; ks < 4; ++ks) DMA16(p.GKT + ((size_t)ch * 128 + 32 * d + r) * 64 + 16 * ks + 8 * hh, bufB + (d * 4 + ks) * 1024);
#pragma unroll
    for (int d = 0; d < 4; ++d)
#pragma unroll
        for (int g = 0; g < 4; ++g) DMA16(p.GDEC + (size_t)ch * 128 + 32 * d + 8 * g + 4 * hh, bufB + (16 + d * 4 + g) * 1024);
}
__device__ __forceinline__ void gla_scan_task(const P& p, int l, int s, int h, int sl, LAS unsigned char* ldsw, int lane) {
    LAS bf16* ST = (LAS bf16*)ldsw;
    LAS unsigned char* bufA = ldsw + 16384; LAS unsigned char* bufB = ldsw + 16384 + 28 * 1024;
    const int r = lane & 31, hh = lane >> 5;
    f32x16 S[4];
#pragma unroll
    for (int d = 0; d < 4; ++d) S[d] = zero16();
    volatile LAS unsigned* FL = (volatile LAS unsigned*)(ldsw + SCAN_FLAGS_OFF);
    if (!SCAN_LOADERS) { const int ch0 = (s * 64 + 0) * 4 + h; gla_issue_A(p, ch0, sl, bufA, r, hh); gla_issue_B(p, ch0, bufB, r, hh); }
#pragma unroll 1
    for (int n = 0; n < NCH; ++n) {
        const int r0 = s * TP + n * CH;
        const int chn = (s * 64 + (n + 1 < NCH ? n + 1 : n)) * 4 + h;
#pragma unroll
        for (int d = 0; d < 4; ++d)
#pragma unroll
            for (int g = 0; g < 4; ++g) { u32x2v w; w.x = pk2(S[d][4 * g], S[d][4 * g + 1]); w.y = pk2(S[d][4 * g + 2], S[d][4 * g + 3]); *(LAS u32x2v*)(ST + r * 136 + 32 * d + 8 * g + 4 * hh) = w; }
        if (SCAN_LOADERS) { LDS_WAIT(); lds_wait_ge(FL + 0, (unsigned)n + 1u, FL + 5); lds_wait_ge(FL + 1, (unsigned)n + 1u, FL + 5); }
        else { VM_WAIT_N(32); LDS_WAIT(); }
        bf16x8 vb[4];
#pragma unroll
        for (int ks = 0; ks < 4; ++ks) vb[ks] = FRAG16(bufA, ks, lane);
#pragma unroll
        for (int ti = 0; ti < 2; ++ti) {
            f32x16 o = zero16();
#pragma unroll
            for (int ks = 0; ks < 8; ++ks) { const bf16x8 b = *(const LAS bf16x8*)(ST + r * 136 + 16 * ks + 8 * hh); o = mma32(FRAG16(bufA, 4 + ti * 8 + ks, lane), b, o); }
#pragma unroll
            for (int ks = 0; ks < 4; ++ks) o = mma32(FRAG16(bufA, 20 + ti * 4 + ks, lane), vb[ks], o);
#pragma unroll
            for (int reg = 0; reg < 16; ++reg) p.OBRAW[(size_t)(r0 + 32 * ti + acc_row(reg, hh)) * 1024 + h * 256 + 32 * sl + r] = o[reg];
        }
        LDS_WAIT();
        if (SCAN_LOADERS) { if (lane == 0) FL[3] = (unsigned)n + 1u; lds_wait_ge(FL + 2, (unsigned)n + 1u, FL + 5); }
        else { gla_issue_A(p, chn, sl, bufA, r, hh); VM_WAIT_N(28); }
#pragma unroll
        for (int d = 0; d < 4; ++d) {
#pragma unroll
            for (int ks = 0; ks < 4; ++ks) S[d] = mma32(FRAG16(bufB, d * 4 + ks, lane), vb[ks], S[d]);
#pragma unroll
            for (int g = 0; g < 4; ++g) { const f32x4v dc = FRAGF4(bufB, 16 + d * 4 + g, lane); S[d][4 * g] *= dc.x; S[d][4 * g + 1] *= dc.y; S[d][4 * g + 2] *= dc.z; S[d][4 * g + 3] *= dc.w; }
        }
        LDS_WAIT();
        if (SCAN_LOADERS) { if (lane == 0) FL[4] = (unsigned)n + 1u; } else gla_issue_B(p, chn, bufB, r, hh);
    }
    VM_WAIT_N(0);
    float* so = p.out + O_PGLA + ((((size_t)l * 2 + s) * 4 + h) * 128) * 256;
#pragma unroll
    for (int d = 0; d < 4; ++d)
#pragma unroll
        for (int reg = 0; reg < 16; ++reg) so[(size_t)(32 * d + acc_row(reg, hh)) * 256 + 32 * sl + r] = S[d][reg];
}

__device__ __forceinline__ void delta_prepass(const P& p, int ch, bool active, LAS unsigned char* ldsh, int t256) {
    const int s = ch >> 9, n = (ch >> 3) & 63, h = ch & 7, r0 = s * TP + n * CH;
    LAS bf16* Kh = (LAS bf16*)ldsh;
    LAS bf16* Kl = (LAS bf16*)(ldsh + 17408);
    LAS float* Lm = (LAS float*)(ldsh + 34816);
    LAS float* GH = (LAS float*)(ldsh + 51200);
    LAS float* BE = GH + 64;
    const int lane = t256 & 63, w4 = t256 >> 6, r = lane & 31, hh = lane >> 5;
    const int ti = w4 >> 1, tj = w4 & 1;
    const int j = t256;
    const bool isw = j >= 128;
    float x[64];
    if (active) {
        const float* src = p.DQKV + (size_t)r0 * 3072 + (isw ? 1024 + h * 128 + (j - 128) : 2048 + h * 128 + j);
#pragma unroll
        for (int c = 0; c < 64; ++c) x[c] = src[(size_t)c * 3072];
        if (w4 == 0) {
            float g = p.G[(size_t)(r0 + lane) * 8 + h];
#pragma unroll
            for (int o = 1; o < 64; o <<= 1) { const float y = __shfl_up(g, o); g += lane >= o ? y : 0.f; }
            GH[lane] = g; BE[lane] = p.BETA[(size_t)(r0 + lane) * 8 + h];
            if (lane >= 60) p.DDEC[(size_t)ch * 4 + (lane - 60)] = __expf(__shfl(g, 63));
        }
#pragma unroll
        for (int i = 0; i < 8; ++i) { const int e = t256 + 256 * i, t = e >> 5, dk = (e & 31) * 4;
            const f32x4v kf = *(const f32x4v*)(p.DQKV + (size_t)(r0 + t) * 3072 + 1024 + h * 128 + dk);
            const unsigned h0 = f2bf(kf.x), h1 = f2bf(kf.y), h2 = f2bf(kf.z), h3 = f2bf(kf.w);
            u32x2v wh, wl; wh.x = h0 | (h1 << 16); wh.y = h2 | (h3 << 16);
            wl.x = f2bf(kf.x - bf2f(h0)) | (f2bf(kf.y - bf2f(h1)) << 16); wl.y = f2bf(kf.z - bf2f(h2)) | (f2bf(kf.w - bf2f(h3)) << 16);
            *(LAS u32x2v*)(Kh + t * 136 + dk) = wh; *(LAS u32x2v*)(Kl + t * 136 + dk) = wl; }
    }
    __syncthreads();
    if (active) {
        f32x16 acc = zero16();
        if (!(ti == 0 && tj == 1)) {
#pragma unroll
            for (int ks = 0; ks < 8; ++ks) {
                const bf16x8 ah = *(const LAS bf16x8*)(Kh + (32 * ti + r) * 136 + 16 * ks + 8 * hh), al = *(const LAS bf16x8*)(Kl + (32 * ti + r) * 136 + 16 * ks + 8 * hh);
                const bf16x8 bh = *(const LAS bf16x8*)(Kh + (32 * tj + r) * 136 + 16 * ks + 8 * hh), bl = *(const LAS bf16x8*)(Kl + (32 * tj + r) * 136 + 16 * ks + 8 * hh);
                acc = mma32(ah, bh, acc); acc = mma32(ah, bl, acc); acc = mma32(al, bh, acc);
            }
        }
#pragma unroll
        for (int reg = 0; reg < 16; ++reg) { const int c = 32 * ti + acc_row(reg, hh), sc = 32 * tj + r;
            Lm[c * 64 + sc] = c > sc ? BE[c] * acc[reg] * __expf(GH[c] - GH[sc]) : 0.f; }
    }
    __syncthreads();
    if (active) {
#pragma unroll
        for (int i = 0; i < 8; ++i) { const int e = t256 + 256 * i, t = e >> 5, dk = (e & 31) * 4;
            const f32x4v qv = *(const f32x4v*)(p.DQKV + (size_t)(r0 + t) * 3072 + h * 128 + dk); const float eg = __expf(GH[t]);
            u32x2v wq, wd; wq.x = f2bf(qv.x) | (f2bf(qv.y) << 16); wq.y = f2bf(qv.z) | (f2bf(qv.w) << 16);
            wd.x = f2bf(qv.x * eg) | (f2bf(qv.y * eg) << 16); wd.y = f2bf(qv.z * eg) | (f2bf(qv.w * eg) << 16);
            *(LAS u32x2v*)(Kl + t * 136 + dk) = wq; *(u32x2v*)(p.DQD + ((size_t)ch * 64 + t) * 128 + dk) = wd; }
#pragma unroll
        for (int c = 0; c < 64; ++c) { float m = BE[c]; if (isw) m *= __expf(GH[c]); x[c] *= m; }
#pragma unroll
        for (int c = 1; c < 64; ++c) {
            asm volatile("" ::: "memory");
            float acc = x[c];
#pragma unroll
            for (int s4 = 0; s4 < (c + 3) / 4; ++s4) { const f32x4v L4 = *(const LAS f32x4v*)(Lm + c * 64 + 4 * s4);
                acc = fmaf(-L4.x, x[4 * s4], acc);
                if (4 * s4 + 1 < c) acc = fmaf(-L4.y, x[4 * s4 + 1], acc);
                if (4 * s4 + 2 < c) acc = fmaf(-L4.z, x[4 * s4 + 2], acc);
                if (4 * s4 + 3 < c) acc = fmaf(-L4.w, x[4 * s4 + 3], acc); }
            x[c] = acc;
        }
        if (j < 128) {
#pragma unroll
            for (int c4 = 0; c4 < 16; ++c4) { f32x4v w; w.x = x[4 * c4]; w.y = x[4 * c4 + 1]; w.z = x[4 * c4 + 2]; w.w = x[4 * c4 + 3]; *(f32x4v*)(p.DUB + ((size_t)ch * 128 + j) * 64 + 4 * c4) = w; }
        } else {
#pragma unroll
            for (int c = 0; c < 64; ++c) p.DNW[((size_t)ch * 64 + c) * 128 + (j - 128)] = (bf16)f2bf(-x[c]);
        }
    }
    __syncthreads();
    if (active) {
        f32x16 acc = zero16();
        if (!(ti == 0 && tj == 1)) {
#pragma unroll
            for (int ks = 0; ks < 8; ++ks) {
                const bf16x8 a = *(const LAS bf16x8*)(Kl + (32 * ti + r) * 136 + 16 * ks + 8 * hh);
                const bf16x8 b = *(const LAS bf16x8*)(Kh + (32 * tj + r) * 136 + 16 * ks + 8 * hh);
                acc = mma32(a, b, acc);
            }
        }
#pragma unroll
        for (int reg = 0; reg < 16; ++reg) { const int c = 32 * ti + acc_row(reg, hh), sc = 32 * tj + r;
            p.DAQK[((size_t)ch * 64 + c) * 64 + sc] = (bf16)f2bf(c >= sc ? acc[reg] * __expf(GH[c] - GH[sc]) : 0.f); }
        const float glast = GH[63];
#pragma unroll
        for (int i = 0; i < 4; ++i) { const int c = t256 + 256 * i, dk = c & 127, tg = c >> 7; float v[8];
#pragma unroll
            for (int e = 0; e < 8; ++e) v[e] = p.DQKV[(size_t)(r0 + 8 * tg + e) * 3072 + 1024 + h * 128 + dk] * __expf(glast - GH[8 * tg + e]);
            uint4 w; w.x = pk2(v[0], v[1]); w.y = pk2(v[2], v[3]); w.z = pk2(v[4], v[5]); w.w = pk2(v[6], v[7]);
            *(uint4*)(p.DKE + ((size_t)ch * 128 + dk) * 64 + 8 * tg) = w; }
    }
    __syncthreads();
}

__device__ __forceinline__ void delta_issue_A(const P& p, int ch, int sl, LAS unsigned char* bufA, int r, int hh) {
#pragma unroll
    for (int ti = 0; ti < 2; ++ti)
#pragma unroll
        for (int ks = 0; ks < 8; ++ks) {
            DMA16(p.DNW + ((size_t)ch * 64 + 32 * ti + r) * 128 + 16 * ks + 8 * hh, bufA + (ti * 8 + ks) * 1024);
            DMA16(p.DQD + ((size_t)ch * 64 + 32 * ti + r) * 128 + 16 * ks + 8 * hh, bufA + (16 + ti * 8 + ks) * 1024);
        }
#pragma unroll
    for (int ti = 0; ti < 2; ++ti)
#pragma unroll
        for (int g = 0; g < 4; ++g) DMA16(p.DUB + ((size_t)ch * 128 + 32 * sl + r) * 64 + 32 * ti + 8 * g + 4 * hh, bufA + (32 + ti * 4 + g) * 1024);
}
__device__ __forceinline__ void delta_issue_B(const P& p, int ch, LAS unsigned char* bufB, int r, int hh) {
#pragma unroll
    for (int ti = 0; ti < 2; ++ti)
#pragma unroll
        for (int ks = 0; ks < 4; ++ks) DMA16(p.DAQK + ((size_t)ch * 64 + 32 * ti + r) * 64 + 16 * ks + 8 * hh, bufB + (ti * 4 + ks) * 1024);
#pragma unroll
    for (int d = 0; d < 4; ++d)
#pragma unroll
        for (int ks = 0; ks < 4; ++ks) DMA16(p.DKE + ((size_t)ch * 128 + 32 * d + r) * 64 + 16 * ks + 8 * hh, bufB + (8 + d * 4 + ks) * 1024);
}
__device__ __forceinline__ void delta_scan_task(const P& p, int l, int s, int h, int sl, LAS unsigned char* ldsw, int lane) {
    LAS bf16* ST = (LAS bf16*)ldsw; LAS bf16* UT = (LAS bf16*)(ldsw + 8704);
    LAS unsigned char* bufA = ldsw + 16384; LAS unsigned char* bufB = ldsw + 16384 + 40 * 1024;
    const int r = lane & 31, hh = lane >> 5;
    f32x16 S[4];
#pragma unroll
    for (int d = 0; d < 4; ++d) S[d] = zero16();
    const float dec_all = p.DDEC[(size_t)((s * 64 + lane) * 8 + h) * 4];
    volatile LAS unsigned* FL = (volatile LAS unsigned*)(ldsw + SCAN_FLAGS_OFF);
    if (!SCAN_LOADERS) { const int ch0 = (s * 64 + 0) * 8 + h; delta_issue_A(p, ch0, sl, bufA, r, hh); delta_issue_B(p, ch0, bufB, r, hh); }
#pragma unroll 1
    for (int n = 0; n < NCH; ++n) {
        const int r0 = s * TP + n * CH;
        const int chn = (s * 64 + (n + 1 < NCH ? n + 1 : n)) * 8 + h;
#pragma unroll
        for (int d = 0; d < 4; ++d)
#pragma unroll
            for (int g = 0; g < 4; ++g) { u32x2v w; w.x = pk2(S[d][4 * g], S[d][4 * g + 1]); w.y = pk2(S[d][4 * g + 2], S[d][4 * g + 3]); *(LAS u32x2v*)(ST + r * 136 + 32 * d + 8 * g + 4 * hh) = w; }
        const float dec = __builtin_bit_cast(float, __builtin_amdgcn_readlane(__builtin_bit_cast(int, dec_all), n));
        if (SCAN_LOADERS) { LDS_WAIT(); lds_wait_ge(FL + 0, (unsigned)n + 1u, FL + 5); lds_wait_ge(FL + 1, (unsigned)n + 1u, FL + 5); }
        else { VM_WAIT_N(24); LDS_WAIT(); }
        f32x16 u[2], o[2];
#pragma unroll
        for (int ti = 0; ti < 2; ++ti) {
#pragma unroll
            for (int g = 0; g < 4; ++g) { const f32x4v ub4 = FRAGF4(bufA, 32 + ti * 4 + g, lane); u[ti][4 * g] = ub4.x; u[ti][4 * g + 1] = ub4.y; u[ti][4 * g + 2] = ub4.z; u[ti][4 * g + 3] = ub4.w; }
            o[ti] = zero16();
#pragma unroll
            for (int ks = 0; ks < 8; ++ks) {
                const bf16x8 b = *(const LAS bf16x8*)(ST + r * 136 + 16 * ks + 8 * hh);
                u[ti] = mma32(FRAG16(bufA, ti * 8 + ks, lane), b, u[ti]); o[ti] = mma32(FRAG16(bufA, 16 + ti * 8 + ks, lane), b, o[ti]);
            }
        }
#pragma unroll
        for (int ti = 0; ti < 2; ++ti)
#pragma unroll
            for (int g = 0; g < 4; ++g) { u32x2v w; w.x = pk2(u[ti][4 * g], u[ti][4 * g + 1]); w.y = pk2(u[ti][4 * g + 2], u[ti][4 * g + 3]); *(LAS u32x2v*)(UT + r * 72 + 32 * ti + 8 * g + 4 * hh) = w; }
        LDS_WAIT();
        if (SCAN_LOADERS) { if (lane == 0) FL[3] = (unsigned)n + 1u; lds_wait_ge(FL + 2, (unsigned)n + 1u, FL + 5); }
        else { delta_issue_A(p, chn, sl, bufA, r, hh); VM_WAIT_N(40); }
        bf16x8 ub[4];
#pragma unroll
        for (int ks = 0; ks < 4; ++ks) ub[ks] = *(const LAS bf16x8*)(UT + r * 72 + 16 * ks + 8 * hh);
#pragma unroll
        for (int ti = 0; ti < 2; ++ti) {
#pragma unroll
            for (int ks = 0; ks < 4; ++ks) o[ti] = mma32(FRAG16(bufB, ti * 4 + ks, lane), ub[ks], o[ti]);
#pragma unroll
            for (int reg = 0; reg < 16; ++reg) p.OCRAW[(size_t)(r0 + 32 * ti + acc_row(reg, hh)) * 1024 + h * 128 + 32 * sl + r] = o[ti][reg];
        }
#pragma unroll
        for (int d = 0; d < 4; ++d) {
#pragma unroll
            for (int reg = 0; reg < 16; ++reg) S[d][reg] *= dec;
#pragma unroll
            for (int ks = 0; ks < 4; ++ks) S[d] = mma32(FRAG16(bufB, 8 + d * 4 + ks, lane), ub[ks], S[d]);
        }
        LDS_WAIT();
        if (SCAN_LOADERS) { if (lane == 0) FL[4] = (unsigned)n + 1u; } else delta_issue_B(p, chn, bufB, r, hh);
    }
    VM_WAIT_N(0);
    float* so = p.out + O_PDELTA + ((((size_t)l * 2 + s) * 8 + h) * 128) * 128;
#pragma unroll
    for (int d = 0; d < 4; ++d)
#pragma unroll
        for (int reg = 0; reg < 16; ++reg) so[(size_t)(32 * d + acc_row(reg, hh)) * 128 + 32 * sl + r] = S[d][reg];
}

__device__ __forceinline__ void scan_loader(const P& p, int id, int role, LAS unsigned char* ldsw, int lane) {
    volatile LAS unsigned* FL = (volatile LAS unsigned*)(ldsw + SCAN_FLAGS_OFF);
    const int r = lane & 31, hh = lane >> 5;
    const bool gla = id < 64; const int q = gla ? id : id - 64;
    const int s = q >> 5, h = gla ? (q >> 3) & 3 : (q >> 2) & 7, sl = gla ? q & 7 : q & 3;
    LAS unsigned char* bufA = ldsw + 16384; LAS unsigned char* bufB = ldsw + 16384 + (gla ? 28 : 40) * 1024;
#pragma unroll 1
    for (int n = 0; n < NCH; ++n) {
        const int ch = gla ? (s * 64 + n) * 4 + h : (s * 64 + n) * 8 + h;
        if (!lds_wait_ge<true>(FL + (role < 2 ? 3 : 4), (unsigned)n, FL + 5)) break;
        if (role < 2) { if (gla) gla_issue_A_half(p, ch, sl, bufA, r, hh, role); else delta_issue_A_half(p, ch, sl, bufA, r, hh, role); }
        else { if (gla) gla_issue_B(p, ch, bufB, r, hh); else delta_issue_B(p, ch, bufB, r, hh); }
        VM_WAIT_N(0);
        if (lane == 0) FL[role] = (unsigned)n + 1u;
    }
    VM_WAIT_N(0);
}

__device__ __forceinline__ void norm_task(const P& p, int l, int r, int part, int lane) {
    const bf16* pr = p.PROJ + (size_t)r * PP;
    if (part == 0) {
        const float* gn = p.in[12] + (size_t)l * 256;
        f32x4v x[4], z[4]; const f32x4v g = *(const f32x4v*)(gn + lane * 4);
#pragma unroll
        for (int h = 0; h < 4; ++h) { x[h] = *(const f32x4v*)(p.OBRAW + (size_t)r * 1024 + h * 256 + lane * 4); z[h] = ldbf4(pr + C_BG + h * 256 + lane * 4); }
#pragma unroll
        for (int h = 0; h < 4; ++h) {
            const float ss = wave_sum(x[h].x * x[h].x + x[h].y * x[h].y + x[h].z * x[h].z + x[h].w * x[h].w);
            const float rs = __builtin_amdgcn_rsqf(ss * (1.f / 256.f) + 1e-6f);
            *(u32x2v*)(p.OBb + (size_t)r * 1024 + h * 256 + lane * 4) = (u32x2v){pk2(x[h].x * rs * g.x * siluf_(z[h].x), x[h].y * rs * g.y * siluf_(z[h].y)), pk2(x[h].z * rs * g.z * siluf_(z[h].z), x[h].w * rs * g.w * siluf_(z[h].w))};
        }
    } else {
        const float* dn = p.in[16] + (size_t)l * 128;
        float2 x[8], z[8]; const float2 g = *(const float2*)(dn + lane * 2);
#pragma unroll
        for (int h = 0; h < 8; ++h) { x[h] = *(const float2*)(p.OCRAW + (size_t)r * 1024 + h * 128 + lane * 2); z[h] = ldbf2(pr + C_CZ + h * 128 + lane * 2); }
#pragma unroll
        for (int h = 0; h < 8; ++h) {
            const float ss = wave_sum(x[h].x * x[h].x + x[h].y * x[h].y);
            const float rs = __builtin_amdgcn_rsqf(ss * (1.f / 128.f) + 1e-6f);
            *(unsigned*)(p.OCb + (size_t)r * 1024 + h * 128 + lane * 2) = pk2(x[h].x * rs * g.x * siluf_(z[h].x), x[h].y * rs * g.y * siluf_(z[h].y));
        }
    }
}

__device__ __forceinline__ void mix_phase(const P& p, int l, size_t i0, size_t stride) {
    const size_t n = (size_t)NDEC * D / 4;
    for (size_t i = i0; i < n; i += stride) {
        const size_t r = NPROMPT + i / (D / 4); const int c = (int)(i % (D / 4)) * 4;
        float4 acc = make_float4(0, 0, 0, 0);
#pragma unroll
        for (int b = 0; b < 3; ++b) {
            const f32x4v g = ldbf4(p.PROJ + r * PP + C_MG + b * D + c);
            float4 y;
            if (r < NPROMPT) y = *(const float4*)(p.T3 + ((size_t)b * MPAD + r) * D + c);
            else { y = make_float4(0, 0, 0, 0);
#pragma unroll
                for (int ks = 0; ks < 4; ++ks) { const float4 q = *(const float4*)(p.T3d + ((size_t)(b * 4 + ks) * NDEC + (r - NPROMPT)) * D + c); y.x += q.x; y.y += q.y; y.z += q.z; y.w += q.w; } }
            acc.x += sigmoidf_(g.x) * y.x; acc.y += sigmoidf_(g.y) * y.y; acc.z += sigmoidf_(g.z) * y.z; acc.w += sigmoidf_(g.w) * y.w;
        }
        *(uint2*)(p.MIXb + r * D + c) = make_uint2(pk2(acc.x, acc.y), pk2(acc.z, acc.w));
    }
}

template <int NS> __device__ __forceinline__ void ln_dec_block(const float* res, const float* zs, const float* g, const float* b, float* out, float* out2, bf16* outb, bool active,
                                                               LAS float* red, int tid) {
    const int c = tid * 4, wave = tid >> 6;
    f32x4v v = (f32x4v){0.f, 0.f, 0.f, 0.f};
    if (active) {
        f32x4v q[NS];
#pragma unroll
        for (int sb = 0; sb < NS; ++sb) q[sb] = *(const f32x4v*)(zs + (size_t)sb * NDEC * D + c);
        const f32x4v a = *(const f32x4v*)(res + c);
        v = q[0];
#pragma unroll
        for (int sb = 1; sb < NS; ++sb) v += q[sb];
        v += a * ALPHA;
    }
    float s = wave_sum((v.x + v.y) + (v.z + v.w));
    if ((tid & 63) == 0) red[wave] = s;
    __syncthreads();
    float mu = 0.f;
#pragma unroll
    for (int w = 0; w < 8; ++w) mu += red[w];
    mu *= (1.f / D);
    v = v - mu;
    float qq = wave_sum((v.x * v.x + v.y * v.y) + (v.z * v.z + v.w * v.w));
    if ((tid & 63) == 0) red[8 + wave] = qq;
    __syncthreads();
    float var = 0.f;
#pragma unroll
    for (int w = 0; w < 8; ++w) var += red[8 + w];
    const float rs = __builtin_amdgcn_rsqf(var * (1.f / D) + 1e-5f);
    if (active) {
        const f32x4v gg = *(const f32x4v*)(g + c), bb = *(const f32x4v*)(b + c);
        const f32x4v o = v * rs * gg + bb;
        *(f32x4v*)(out + c) = o;
        if (out2) *(f32x4v*)(out2 + c) = o;
        *(u32x2v*)(outb + c) = (u32x2v){pk2(o.x, o.y), pk2(o.z, o.w)};
    }
}
__device__ __forceinline__ void ln_rows2(const float* z, const float* g, const float* b, float* stats, float* out2, bf16* outb, int lane) {
    float v[2][32]; float s[2] = {0.f, 0.f};
#pragma unroll
    for (int rr = 0; rr < 2; ++rr)
#pragma unroll
        for (int j = 0; j < 8; ++j) { const float4 c = *(const float4*)(z + (size_t)rr * D + j * 256 + lane * 4); v[rr][4 * j] = c.x; v[rr][4 * j + 1] = c.y; v[rr][4 * j + 2] = c.z; v[rr][4 * j + 3] = c.w; }
#pragma unroll
    for (int rr = 0; rr < 2; ++rr)
#pragma unroll
        for (int j = 0; j < 32; ++j) s[rr] += v[rr][j];
    float mu[2], q[2] = {0.f, 0.f}, rs[2];
    s[0] = wave_sum(s[0]); s[1] = wave_sum(s[1]);
    mu[0] = s[0] * (1.f / D); mu[1] = s[1] * (1.f / D);
#pragma unroll
    for (int rr = 0; rr < 2; ++rr)
#pragma unroll
        for (int j = 0; j < 32; ++j) { v[rr][j] -= mu[rr]; q[rr] += v[rr][j] * v[rr][j]; }
    q[0] = wave_sum(q[0]); q[1] = wave_sum(q[1]);
    rs[0] = __builtin_amdgcn_rsqf(q[0] * (1.f / D) + 1e-5f); rs[1] = __builtin_amdgcn_rsqf(q[1] * (1.f / D) + 1e-5f);
    if (lane == 0) { stats[0] = mu[0]; stats[1] = rs[0]; stats[2] = mu[1]; stats[3] = rs[1]; }
#pragma unroll
    for (int j = 0; j < 8; ++j) {
        const float4 gg = *(const float4*)(g + j * 256 + lane * 4), bb = *(const float4*)(b + j * 256 + lane * 4);
#pragma unroll
        for (int rr = 0; rr < 2; ++rr) {
            float4 o; o.x = v[rr][4 * j] * rs[rr] * gg.x + bb.x; o.y = v[rr][4 * j + 1] * rs[rr] * gg.y + bb.y; o.z = v[rr][4 * j + 2] * rs[rr] * gg.z + bb.z; o.w = v[rr][4 * j + 3] * rs[rr] * gg.w + bb.w;
            if (out2) *(float4*)(out2 + (size_t)rr * D + j * 256 + lane * 4) = o;
            *(uint2*)(outb + (size_t)rr * D + j * 256 + lane * 4) = make_uint2(pk2(o.x, o.y), pk2(o.z, o.w));
        }
    }
}
__device__ __forceinline__ void ln_row(const float* res, const float* z, int nslab, const float* g, const float* b, float* out, float* out2, bf16* outb, int lane) {
    float v[32]; float s = 0.f;
#pragma unroll
    for (int j = 0; j < 8; ++j) {
        const float4 a = res ? *(const float4*)(res + j * 256 + lane * 4) : make_float4(0, 0, 0, 0); float4 c = *(const float4*)(z + j * 256 + lane * 4);
#pragma unroll 1
        for (int sb = 1; sb < nslab; ++sb) { const float4 q = *(const float4*)(z + (size_t)sb * NDEC * D + j * 256 + lane * 4); c.x += q.x; c.y += q.y; c.z += q.z; c.w += q.w; }
        v[4 * j] = ALPHA * a.x + c.x; v[4 * j + 1] = ALPHA * a.y + c.y; v[4 * j + 2] = ALPHA * a.z + c.z; v[4 * j + 3] = ALPHA * a.w + c.w;
        s += (v[4 * j] + v[4 * j + 1]) + (v[4 * j + 2] + v[4 * j + 3]);
    }
    const float mu = wave_sum(s) * (1.f / D);
    float q = 0.f;
#pragma unroll
    for (int j = 0; j < 32; ++j) { v[j] -= mu; q += v[j] * v[j]; }
    const float rs = __builtin_amdgcn_rsqf(wave_sum(q) * (1.f / D) + 1e-5f);
#pragma unroll
    for (int j = 0; j < 8; ++j) {
        const float4 gg = *(const float4*)(g + j * 256 + lane * 4), bb = *(const float4*)(b + j * 256 + lane * 4);
        float4 o; o.x = v[4 * j] * rs * gg.x + bb.x; o.y = v[4 * j + 1] * rs * gg.y + bb.y; o.z = v[4 * j + 2] * rs * gg.z + bb.z; o.w = v[4 * j + 3] * rs * gg.w + bb.w;
        *(float4*)(out + j * 256 + lane * 4) = o;
        if (out2) *(float4*)(out2 + j * 256 + lane * 4) = o;
        *(uint2*)(outb + j * 256 + lane * 4) = make_uint2(pk2(o.x, o.y), pk2(o.z, o.w));
    }
}
__device__ __forceinline__ void bf8_to_f(const u32x4v w, float (&f)[8]) {
    f[0] = bf2f(w.x & 0xffffu); f[1] = __builtin_bit_cast(float, w.x & 0xffff0000u); f[2] = bf2f(w.y & 0xffffu); f[3] = __builtin_bit_cast(float, w.y & 0xffff0000u);
    f[4] = bf2f(w.z & 0xffffu); f[5] = __builtin_bit_cast(float, w.z & 0xffff0000u); f[6] = bf2f(w.w & 0xffffu); f[7] = __builtin_bit_cast(float, w.w & 0xffff0000u);
}
constexpr int FFN_PTASKS = (NPROMPT / 8) * 11, FFN_DTASKS = NDEC * 11, FFN_TASKS = FFN_PTASKS + FFN_DTASKS;
__device__ __forceinline__ void ffnconv_task(const P& p, int l, int task, int lane) {
    const float* cw = p.in[22] + (size_t)l * 3 * DFF2;
    if (task < FFN_PTASKS) {
        const int rg = task / 11, sl = task - rg * 11, c = sl * 512 + lane * 8;
        const int ra = rg * 8, t0 = ra & 4095;
        u32x4v x[2][10];
#pragma unroll
        for (int half = 0; half < 2; ++half)
#pragma unroll
            for (int i = 0; i < 10; ++i) {
                if (i < 2 && t0 == 0) x[half][i] = (u32x4v){0u, 0u, 0u, 0u};
                else x[half][i] = *(const u32x4v*)(p.U16 + (size_t)(ra - 2 + i) * DFF2 + c + half * DFF);
            }
        float w[2][3][8];
#pragma unroll
        for (int half = 0; half < 2; ++half)
#pragma unroll
            for (int j = 0; j < 3; ++j) {
                const f32x4v a = *(const f32x4v*)(cw + j * DFF2 + c + half * DFF), b = *(const f32x4v*)(cw + j * DFF2 + c + half * DFF + 4);
                w[half][j][0] = a.x; w[half][j][1] = a.y; w[half][j][2] = a.z; w[half][j][3] = a.w; w[half][j][4] = b.x; w[half][j][5] = b.y; w[half][j][6] = b.z; w[half][j][7] = b.w;
            }
#pragma unroll
        for (int i = 0; i < 8; ++i) {
            float y[2][8];
#pragma unroll
            for (int half = 0; half < 2; ++half) {
                float a[8], b[8], cc[8];
                bf8_to_f(x[half][i], a); bf8_to_f(x[half][i + 1], b); bf8_to_f(x[half][i + 2], cc);
#pragma unroll
                for (int e = 0; e < 8; ++e) y[half][e] = w[half][0][e] * a[e] + w[half][1][e] * b[e] + w[half][2][e] * cc[e];
            }
            u32x4v o;
            o.x = pk2(siluf_(y[0][0]) * y[1][0], siluf_(y[0][1]) * y[1][1]); o.y = pk2(siluf_(y[0][2]) * y[1][2], siluf_(y[0][3]) * y[1][3]);
            o.z = pk2(siluf_(y[0][4]) * y[1][4], siluf_(y[0][5]) * y[1][5]); o.w = pk2(siluf_(y[0][6]) * y[1][6], siluf_(y[0][7]) * y[1][7]);
            *(u32x4v*)(p.Fb + (size_t)(ra + i) * DFF + c) = o;
        }
        return;
    }
    const int dt = task - FFN_PTASKS, rr = dt / 11, sl = dt - rr * 11, c = sl * 512 + lane * 8;
    const int r = NPROMPT + rr, sq = rr >> 2, t = rr & 3;
    float y[2][8];
#pragma unroll
    for (int half = 0; half < 2; ++half) {
#pragma unroll
        for (int e = 0; e < 8; ++e) y[half][e] = 0.f;
#pragma unroll
        for (int j = 0; j < 3; ++j) {
            const int tt = t - 2 + j; float xv[8];
            if (tt >= 0) bf8_to_f(*(const u32x4v*)(p.U16 + (size_t)(NPROMPT + sq * 4 + tt) * DFF2 + c + half * DFF), xv);
            else { const float* sp = p.in[7] + (((size_t)l * 32 + sq) * 2 + (2 + tt)) * DFF2 + c + half * DFF; const f32x4v a = *(const f32x4v*)sp, b = *(const f32x4v*)(sp + 4);
                xv[0] = a.x; xv[1] = a.y; xv[2] = a.z; xv[3] = a.w; xv[4] = b.x; xv[5] = b.y; xv[6] = b.z; xv[7] = b.w; }
            const f32x4v wa = *(const f32x4v*)(cw + j * DFF2 + c + half * DFF), wb = *(const f32x4v*)(cw + j * DFF2 + c + half * DFF + 4);
            y[half][0] += wa.x * xv[0]; y[half][1] += wa.y * xv[1]; y[half][2] += wa.z * xv[2]; y[half][3] += wa.w * xv[3];
            y[half][4] += wb.x * xv[4]; y[half][5] += wb.y * xv[5]; y[half][6] += wb.z * xv[6]; y[half][7] += wb.w * xv[7];
        }
    }
    u32x4v o;
    o.x = pk2(siluf_(y[0][0]) * y[1][0], siluf_(y[0][1]) * y[1][1]); o.y = pk2(siluf_(y[0][2]) * y[1][2], siluf_(y[0][3]) * y[1][3]);
    o.z = pk2(siluf_(y[0][4]) * y[1][4], siluf_(y[0][5]) * y[1][5]); o.w = pk2(siluf_(y[0][6]) * y[1][6], siluf_(y[0][7]) * y[1][7]);
    *(u32x4v*)(p.Fb + (size_t)r * DFF + c) = o;
}

#ifndef PROBE_MASK
#define PROBE_MASK 0
#endif
#define REP(k) for (int rep_ = 0; rep_ < 1 + ((PROBE_MASK >> (k)) & 1); ++rep_)
constexpr int PH_PER_LAYER = 13, N_PHASES = 1 + PH_PER_LAYER * DEPTH;
constexpr int LDS_MISC = pg8::STAGE_BYTES, LDS_BYTES = pg8::STAGE_BYTES + 1024;
struct Args { P p; unsigned* bar; int ph_lo, ph_hi; };
__global__ void __launch_bounds__(512, 2) mega(Args a) {
    extern __shared__ __attribute__((aligned(16))) unsigned char lds_raw[];
    LAS unsigned char* lds = (LAS unsigned char*)lds_raw;
    const P& p = a.p;
    const int tid = threadIdx.x;
    const int G = gridDim.x, bx = blockIdx.x;
    volatile LAS unsigned* misc = (volatile LAS unsigned*)(lds + LDS_MISC);
    if (tid < 64) misc[tid] = 0u;
    __syncthreads();
    const int lo = a.ph_lo, hi = a.ph_hi;
    const bool one_launch = (hi - lo) > 1;
    XcdBarrier bar; bar.bar = a.bar; bar.x = 0; bar.st = misc + 8;
    if (one_launch) bar = xcd_barrier_post(a.bar, misc + 8);
#define IN(k) (lo <= (k) && (k) < hi)
#define SEAM(k) do { if (IN(k) && IN((k) + 1)) { xcd_barrier(bar); if ((PROBE_MASK >> 17) & 1) xcd_barrier(bar); } } while (0)
    const int ngw = G * 8; const size_t ngt = (size_t)G * 512;
#define PHASE_IDS() int tid_p = threadIdx.x; asm volatile("" : "+v"(tid_p)); const int lane = tid_p & 63, wave = __builtin_amdgcn_readfirstlane(tid_p >> 6), gw = bx * 8 + wave; const size_t gt = (size_t)bx * 512 + tid_p; (void)lane; (void)wave; (void)gw; (void)gt

    if (IN(0)) REP(18) {
        PHASE_IDS();
        LAS float* tile = (LAS float*)(lds + (tid_p >> 8) * 32768);
        const int half = tid_p >> 8, t256 = tid_p & 255;
        for (int it = 0; it < (WT_LAYER + 2 * G - 1) / (2 * G); ++it) {
            const int id = (it * G + bx) * 2 + half;
            WTile w = wT_tile(p, id < WT_LAYER ? id : 0);
            if (id < WT_LAYER) wT_load(w.W, w.K, w.N, w.n0, w.k0, tile, t256);
            __syncthreads();
            if (id < WT_LAYER) wT_store(w.Bt, w.K, w.n0, w.k0, tile, t256);
            __syncthreads();
        }
        xinit_phase(p, gt, ngt);
        for (size_t i = gt; i < (size_t)4100 * 8; i += ngt) {
            const int pi = (int)(i >> 3), fi = (int)(i & 7), pos = pi < 4096 ? pi : PAST + (pi - 4096);
            const double rev = (double)pos * rot_inv_rev(fi); const float fr = (float)(rev - floor(rev));
            p.ROT[2 * i] = sin_rev(fr + 0.25f); p.ROT[2 * i + 1] = sin_rev(fr);
        }
    }
    SEAM(0);
    for (int l = 0; l < DEPTH; ++l) {
        const int pb = 1 + PH_PER_LAYER * l;
        if (IN(pb + 0)) REP(0) {
            pg8::Gemm g{p.Xb, p.Win + (size_t)l * PP * D, MPAD, PP, D, D, D, 1, 0, 0, 0, 0}; EpiIn E{p.PROJ, p.SMALL, p.ROT, p.QB16, p.KB16, p.QR, p.KR, p.VD, p.out, l, 0};
            pg8::StaticOrder S; S.init(MPAD, PP, G, bx);
            pg8::gemm_phase<EpiIn, pg8::StaticOrder, true, true>(lds, g, S, E);
        }
        SEAM(pb + 0);
        if (IN(pb + 1)) REP(1) {
            PHASE_IDS();
            REP(19) for (int task = gw; task < MROWS / PREP_ROWS; task += ngw) prep_rows_task(p, l, task * PREP_ROWS, lane);
            REP(20) for (int task = gw; task < (NPROMPT / CONV_ROWS) * 12; task += ngw) prep_conv_task(p, l, task, lane);
            for (int task = gw; task < NDEC * 24; task += ngw) prep_task(p, l, NPROMPT + task / 24, 1 + task % 24, lane);
        }
        SEAM(pb + 1);
        if (IN(pb + 2)) REP(2) {
            PHASE_IDS();
            for (int it = 0; it < (512 + G - 1) / G; ++it) { const int ch = it * G + bx; if (ch < 512) gla_prepass(p, ch, lds, tid_p); }
            for (int it = 0; it < (1024 + 2 * G - 1) / (2 * G); ++it) { const int ch = (it * G + bx) * 2 + (tid_p >> 8); delta_prepass(p, ch < 1024 ? ch : 0, ch < 1024, lds + (tid_p >> 8) * 65536, tid_p & 255); }
            for (int task = gw; task < 512; task += ngw) vt_task(p, task, lds + wave * 8448, lane);
        }
        SEAM(pb + 2);
        if (IN(pb + 3)) REP(3) {
            PHASE_IDS();
            if (tid_p < 16) ((volatile LAS unsigned*)(lds + SCAN_FLAGS_OFF))[tid_p] = 0u;
            __syncthreads();
            const int nsb = G < 128 ? G : 128;
            const int nrole = SCAN_LOADERS ? 4 : 1;
            const bool scan_block = bx < nsb;
            if (scan_block && wave < nrole) {
                REP(13) for (int id = bx; id < 128; id += G) {
                    if (tid_p < 16) {}
                    if (wave == 0) {
                        if (id < 64) gla_scan_task(p, l, id >> 5, (id >> 3) & 3, id & 7, lds, lane);
                        else delta_scan_task(p, l, (id - 64) >> 5, ((id - 64) >> 2) & 7, (id - 64) & 3, lds, lane);
                    } else scan_loader(p, id, wave - 1, lds, lane);
                }
            } else {
                const int wpb = 8 - nrole;
                const int widx = scan_block ? bx * wpb + (wave - nrole) : nsb * wpb + (bx - nsb) * 8 + wave, nwork = nsb * wpb + (G - nsb) * 8;
                REP(14) for (int task = widx; task < 8192; task += nwork) scan_task(p, l, 512 + task, lane);
                REP(15) for (int task = widx; task < NDEC * 4; task += nwork) attn_task(p, l, NPROMPT + (task >> 2), task & 3, lane);
                REP(16) for (int task = widx; task < 4096; task += nwork) attn_prompt_task(p, l, task >> 11, (task >> 4) & 127, task & 15, lds + 106496 + wave * 2560, lane);
                if (l + 1 < DEPTH && widx >= NDEC * 4) for (int task = widx - NDEC * 4; task < WT_LAYER; task += nwork - NDEC * 4) wT_wave_task(p, (l + 1) * WT_LAYER + task, lane);
            }
        }
        SEAM(pb + 3);
        if (IN(pb + 4)) REP(4) { PHASE_IDS(); for (int task = gw; task < MROWS * 2; task += ngw) norm_task(p, l, task >> 1, task & 1, lane); }
        SEAM(pb + 4);
        if (IN(pb + 5)) REP(5) {
            {
                pg8::Gemm g{p.OAb, p.Wbr + (size_t)l * 3 * D * 1024, NPROMPT, D, 1024, 1024, 1024, 1, (size_t)MPAD * 1024, (size_t)D * 1024, 0, 0}; EpiMix E{p.PROJ + C_MG, p.T3, p.MIXb};
                pg8::TileZ3Order S; S.init(NPROMPT, D, G, bx);
                pg8::gemm_phase<EpiMix, pg8::TileZ3Order, true, true>(lds, g, S, E);
            }
            {
                pg8::Gemm g{p.OAb + (size_t)NPROMPT * 1024, p.Wbr + (size_t)l * 3 * D * 1024, 256, D, 256, 1024, 1024, 4, (size_t)MPAD * 1024, (size_t)D * 1024, 256, 256}; pg8::EpiSlabF32 E{p.T3d, D, 0, (size_t)NDEC * D};
                pg8::ZOrder S; S.init(256, D, 12, G, bx);
                pg8::gemm_phase<pg8::EpiSlabF32, pg8::ZOrder, true, true>(lds, g, S, E);
            }
        }
        SEAM(pb + 5);
        if (IN(pb + 6)) REP(6) { PHASE_IDS(); mix_phase(p, l, gt, ngt); }
        SEAM(pb + 6);
        if (IN(pb + 7)) REP(7) {
            {
                pg8::Gemm g{p.MIXb, p.Wout + (size_t)l * D * D, NPROMPT, D, D, D, D, 1, 0, 0, 0, 0}; pg8::EpiResF32 E{p.Z, l == 0 ? p.X : nullptr, p.ST2, l == 0 ? nullptr : p.in[24] + (size_t)(l - 1) * D, l == 0 ? nullptr : p.in[25] + (size_t)(l - 1) * D, D, ALPHA};
                pg8::StaticOrder S; S.init(NPROMPT, D, G, bx);
                pg8::gemm_phase<pg8::EpiResF32, pg8::StaticOrder, true, true>(lds, g, S, E);
            }
            {
                pg8::Gemm g{p.MIXb + (size_t)NPROMPT * D, p.Wout + (size_t)l * D * D, 256, D, 256, D, D, 8, 0, 0, 256, 256}; pg8::EpiSlabF32 E{p.Zd1, D, 0, (size_t)NDEC * D};
                pg8::ZOrder S; S.init(256, D, 8, G, bx);
                pg8::gemm_phase<pg8::EpiSlabF32, pg8::ZOrder, true, true>(lds, g, S, E);
            }
        }
        SEAM(pb + 7);
        if (IN(pb + 8)) REP(8) {
            PHASE_IDS();
            for (int pr2 = gw; pr2 < NPROMPT / 2; pr2 += ngw) { const size_t r = (size_t)pr2 * 2; ln_rows2(p.Z + r * D, p.in[19] + (size_t)l * D, p.in[20] + (size_t)l * D, p.ST1 + r * 2, nullptr, p.Hb + r * D, lane); }
            for (int it = 0; it < (NDEC + G - 1) / G; ++it) { const int dr = it * G + bx; const bool act = dr < NDEC; const size_t r = NPROMPT + (act ? dr : 0);
                ln_dec_block<8>(p.X + r * D, p.Zd1 + (r - NPROMPT) * D, p.in[19] + (size_t)l * D, p.in[20] + (size_t)l * D, p.H + r * D, nullptr, p.Hb + r * D, act, (LAS float*)(lds + 64 * it), tid_p); }
        }
        SEAM(pb + 8);
        if (IN(pb + 9)) REP(9) {
            pg8::Gemm g{p.Hb, p.Wup + (size_t)l * DFF2 * D, MPAD, DFF2, D, D, D, 1, 0, 0, 0, 0}; EpiU E{p.U16, p.out, l, 0};
            pg8::StaticOrder S; S.init(MPAD, DFF2, G, bx);
            pg8::gemm_phase<EpiU, pg8::StaticOrder, true, true>(lds, g, S, E);
        }
        SEAM(pb + 9);
        if (IN(pb + 10)) REP(10) { PHASE_IDS(); for (int task = gw; task < FFN_TASKS; task += ngw) ffnconv_task(p, l, task, lane); }
        SEAM(pb + 10);
        if (IN(pb + 11)) REP(11) {
            {
                pg8::Gemm g{p.Fb, p.Wdn + (size_t)l * D * DFF, NPROMPT, D, DFF, DFF, DFF, 1, 0, 0, 0, 0}; pg8::EpiResF32 E{p.Z, nullptr, p.ST1, p.in[19] + (size_t)l * D, p.in[20] + (size_t)l * D, D, ALPHA};
                pg8::StaticOrder S; S.init(NPROMPT, D, G, bx);
                pg8::gemm_phase<pg8::EpiResF32, pg8::StaticOrder, true, true>(lds, g, S, E);
            }
            {
                pg8::Gemm g{p.Fb + (size_t)NPROMPT * DFF, p.Wdn + (size_t)l * D * DFF, 256, D, 256, DFF, DFF, 22, 0, 0, 256, 256}; pg8::EpiSlabF32 E{p.Zd2, D, 0, (size_t)NDEC * D};
                pg8::ZOrder S; S.init(256, D, 22, G, bx);
                pg8::gemm_phase<pg8::EpiSlabF32, pg8::ZOrder, true, true>(lds, g, S, E);
            }
        }
        SEAM(pb + 11);
        if (IN(pb + 12)) REP(12) {
            PHASE_IDS();
            for (int pr2 = gw; pr2 < NPROMPT / 2; pr2 += ngw) { const size_t r = (size_t)pr2 * 2;
                ln_rows2(p.Z + r * D, p.in[24] + (size_t)l * D, p.in[25] + (size_t)l * D, p.ST2 + r * 2, l == DEPTH - 1 ? p.out + O_YP + r * D : nullptr, p.Xb + r * D, lane); }
            for (int it = 0; it < (NDEC + G - 1) / G; ++it) { const int dr = it * G + bx; const bool act = dr < NDEC; const size_t r = NPROMPT + (act ? dr : 0);
                ln_dec_block<22>(p.H + r * D, p.Zd2 + (r - NPROMPT) * D, p.in[24] + (size_t)l * D, p.in[25] + (size_t)l * D, p.X + r * D, l == DEPTH - 1 ? p.out + O_YS + (r - NPROMPT) * D : nullptr, p.Xb + r * D, act, (LAS float*)(lds + 64 * it), tid_p); }
        }
        SEAM(pb + 12);
    }
#undef IN
#undef SEAM
}

#ifndef MK_ONE_LAUNCH
#define MK_ONE_LAUNCH 1
#endif
extern "C" void kernel_launch(void* const* d_in, const int* in_sizes, int n_in, void* d_out, int out_size, void* d_ws, size_t ws_size, hipStream_t stream) {
    static int grid = 0;
    if (n_in != 26 || (size_t)out_size != O_TOTAL) { fprintf(stderr, "kernel_launch: unexpected n_in %d / out_size %d\n", n_in, out_size); return; }
    if (grid == 0) {
        int dev = 0, cus = 0, per_cu = 0;
        if (hipGetDevice(&dev) != hipSuccess || hipDeviceGetAttribute(&cus, hipDeviceAttributeMultiprocessorCount, dev) != hipSuccess) { grid = -1; return; }
        if (hipFuncSetAttribute((const void*)mega, hipFuncAttributeMaxDynamicSharedMemorySize, LDS_BYTES) != hipSuccess) { fprintf(stderr, "kernel_launch: hipFuncSetAttribute failed\n"); grid = -1; return; }
        if (hipOccupancyMaxActiveBlocksPerMultiprocessor(&per_cu, (const void*)mega, 512, LDS_BYTES) != hipSuccess || per_cu < 1) { fprintf(stderr, "kernel_launch: occupancy query says %d blocks per CU\n", per_cu); grid = -1; return; }
        (void)hipGetLastError();
        grid = cus;
    }
    if (grid < 0) return;
    Args a{};
    P& p = a.p;
    for (int i = 0; i < 26; ++i) p.in[i] = (const float*)d_in[i];
    p.out = (float*)d_out;
    size_t off = 0; char* ws = (char*)d_ws;
    auto carve = [&](size_t bytes) { void* q = (void*)(ws + off); off += ((bytes + 255) / 256) * 256; return q; };
    a.bar = (unsigned*)carve((size_t)XCD_BAR_WORDS * 4);
    p.Win = (bf16*)carve((size_t)DEPTH * PP * D * 2); p.Wbr = (bf16*)carve((size_t)DEPTH * 3 * D * 1024 * 2); p.Wout = (bf16*)carve((size_t)DEPTH * D * D * 2);
    p.Wup = (bf16*)carve((size_t)DEPTH * DFF2 * D * 2); p.Wdn = (bf16*)carve((size_t)DEPTH * D * DFF * 2);
    p.X = (float*)carve((size_t)MPAD * D * 4); p.H = (float*)carve((size_t)MPAD * D * 4); p.Z = (float*)carve((size_t)MPAD * D * 4);
    p.Xb = (bf16*)carve((size_t)MPAD * D * 2); p.Hb = (bf16*)carve((size_t)MPAD * D * 2); p.MIXb = (bf16*)carve((size_t)MPAD * D * 2);
    p.OAb = (bf16*)carve((size_t)MPAD * 1024 * 2); p.OBb = (bf16*)carve((size_t)MPAD * 1024 * 2); p.OCb = (bf16*)carve((size_t)MPAD * 1024 * 2);
    p.G = (float*)carve((size_t)MPAD * 8 * 4); p.BETA = (float*)carve((size_t)MPAD * 8 * 4);
    p.ST1 = (float*)carve((size_t)NPROMPT * 2 * 4); p.ST2 = (float*)carve((size_t)NPROMPT * 2 * 4);
    p.T3d = (float*)carve((size_t)42 * NDEC * D * 4); p.Zd1 = p.T3d + (size_t)12 * NDEC * D; p.Zd2 = p.T3d + (size_t)20 * NDEC * D;
    p.PROJ = (bf16*)carve((size_t)MPAD * PP * 2); p.U16 = (bf16*)carve((size_t)MPAD * DFF2 * 2);
    p.ROT = (float*)carve((size_t)4100 * 16 * 4);
    p.SMALL = (float*)carve((size_t)MPAD * 32 * 4); p.VD = (float*)carve((size_t)NDEC * 256 * 4);
    const size_t r2 = off;
    p.QR = (float*)carve((size_t)MPAD * 1024 * 4); p.KR = (float*)carve((size_t)MPAD * 256 * 4); p.AG = (float*)carve((size_t)MPAD * 512 * 4);
    p.DQKV = (float*)carve((size_t)MPAD * 3072 * 4); p.OBRAW = (float*)carve((size_t)MPAD * 1024 * 4); p.OCRAW = (float*)carve((size_t)MPAD * 1024 * 4);
    p.QB16 = (bf16*)carve((size_t)NPROMPT * 1024 * 2); p.KB16 = (bf16*)carve((size_t)NPROMPT * 256 * 2); p.VT16 = (bf16*)carve((size_t)2 * 4 * 64 * TP * 2);
    p.GQT = (bf16*)carve((size_t)512 * 64 * 128 * 2); p.GKT = (bf16*)carve((size_t)512 * 128 * 64 * 2); p.GVT = (bf16*)carve((size_t)512 * 256 * 64 * 2);
    p.GA = (bf16*)carve((size_t)512 * 64 * 64 * 2); p.GDEC = (float*)carve((size_t)512 * 128 * 4);
    p.DUB = (float*)carve((size_t)1024 * 64 * 128 * 4); p.DNW = (bf16*)carve((size_t)1024 * 64 * 128 * 2); p.DQD = (bf16*)carve((size_t)1024 * 64 * 128 * 2);
    p.DAQK = (bf16*)carve((size_t)1024 * 64 * 64 * 2); p.DKE = (bf16*)carve((size_t)1024 * 128 * 64 * 2); p.DDEC = (float*)carve((size_t)1024 * 4 * 4);
    const size_t r2_end = off; off = r2;
    p.T3 = (float*)carve((size_t)3 * MPAD * D * 4); p.Fb = (bf16*)p.T3;
    if (off < r2_end) off = r2_end;
    if (off > ws_size) { fprintf(stderr, "kernel_launch: workspace too small: need %zu have %zu\n", off, ws_size); return; }
    if (hipMemsetAsync(a.bar, 0, (size_t)XCD_BAR_WORDS * 4, stream) != hipSuccess) return;
#if MK_ONE_LAUNCH
    a.ph_lo = 0; a.ph_hi = N_PHASES;
    hipLaunchKernelGGL(mega, dim3(grid), dim3(512), LDS_BYTES, stream, a);
#else
    for (int ph = 0; ph < N_PHASES; ++ph) { a.ph_lo = ph; a.ph_hi = ph + 1; hipLaunchKernelGGL(mega, dim3(grid), dim3(512), LDS_BYTES, stream, a); }
#endif
}
```

```cpp
#include <hip/hip_runtime.h>
#include <cstdio>
#include <cstdint>
namespace pg8 {
#define PG8_LAS __attribute__((address_space(3)))
typedef unsigned short bf16_t;
typedef short bf16x8 __attribute__((ext_vector_type(8)));
typedef float f32x4 __attribute__((ext_vector_type(4)));
typedef unsigned u32x4 __attribute__((ext_vector_type(4)));
constexpr int BM = 256, BK = 64, HALF = 128, HTB = HALF * BK * 2  , STAGE_BYTES = 8 * HTB, NXCD = 8, WGM = 8;

__host__ __device__ __forceinline__ int lds_byte(int r, int c) { const int st = (r >> 4) * 2 + (c >> 5), rr = r & 15, cc = c & 31, ob = rr * 64 + cc * 2; return st * 1024 + (ob ^ (((ob >> 9) & 1) << 5)); }
__host__ __device__ __forceinline__ void stage_rc(int b, int& R, int& C) { const int st = b / 1024, sb = b % 1024, swz = sb ^ (((sb >> 9) & 1) << 5); R = (st >> 1) * 16 + swz / 64; C = (st & 1) * 32 + (swz % 64) / 2; }
__host__ __device__ __forceinline__ int perm32(int rho) { const int n = rho >> 4, i = rho & 15; return 8 * (i >> 2) + 4 * n + (i & 3); }

struct Unit { int pm, pn, z; };
struct Gemm { const bf16_t* A; const bf16_t* Bt; int M, N, K, lda, ldb, zdiv; size_t zA, zB, zA2, zB2; };

struct StaticOrder {
    int nM, nN, nwg, G, c;
    __host__ __device__ void init(int M, int N, int G_, int c_) { nM = M / BM; nN = N / BM; nwg = nM * nN; G = G_; c = c_; }
    __host__ __device__ bool next(int i, Unit& u) const {
        const long L = (long)i * G + c; if (L >= nwg) return false;
        int wgid = (int)L; { const int q = nwg / NXCD, r = nwg % NXCD, xcd = wgid % NXCD, off = wgid / NXCD; wgid = (xcd < r ? xcd * (q + 1) : r * (q + 1) + (xcd - r) * q) + off; }
        const int nig = WGM * nN, gid = wgid / nig, fm = gid * WGM, gsz = (nM - fm) < WGM ? (nM - fm) : WGM;
        u.pm = fm + ((wgid % nig) % gsz); u.pn = (wgid % nig) / gsz; u.z = 0; return true;
    }
    __device__ __forceinline__ void a_ready(const Unit&) const {}
    __device__ __forceinline__ void done(const Unit&) const {}
};

__device__ __forceinline__ unsigned cvt_pk_bf16(float lo, float hi) { unsigned r; asm volatile("v_cvt_pk_bf16_f32 %0, %1, %2" : "=v"(r) : "v"(lo), "v"(hi)); return r; }
typedef float f32x2 __attribute__((ext_vector_type(2)));

struct EpiF32 {
    static constexpr bool PERM = false, AFTER_DRAIN = false;
    float* C; int ldc, zdiv; size_t zC;
    __device__ __forceinline__ void operator()(const f32x4 (&acc)[2][2][4][2], const Unit& u, int wr, int wc, int fr, int fq) const {
        const int row0 = u.pm * BM + wr * 64 + fr, col0 = u.pn * BM + wc * 32 + 4 * fq;
#pragma unroll
        for (int ai = 0; ai < 2; ++ai)
#pragma unroll
            for (int m = 0; m < 4; ++m) { float* rowp = C + (size_t)(u.z / zdiv) * zC + (size_t)(row0 + ai * HALF + m * 16) * ldc + col0;
#pragma unroll
                for (int bj = 0; bj < 2; ++bj)
#pragma unroll
                    for (int n = 0; n < 2; ++n) *(f32x4*)(rowp + bj * HALF + n * 16) = acc[ai][bj][m][n]; }
    }
};
struct EpiResF32 {
    static constexpr bool PERM = false, AFTER_DRAIN = false;
    float* C; const float* resp; const float* stats; const float* g; const float* b; int ldc; float alpha;
    __device__ __forceinline__ void operator()(const f32x4 (&acc)[2][2][4][2], const Unit& u, int wr, int wc, int fr, int fq) const {
        const int row0 = u.pm * BM + wr * 64 + fr, col0 = u.pn * BM + wc * 32 + 4 * fq;
        f32x4 gv[2][2], bv[2][2];
#pragma unroll
        for (int bj = 0; bj < 2; ++bj)
#pragma unroll
            for (int n = 0; n < 2; ++n) { gv[bj][n] = resp ? (f32x4){1.f, 1.f, 1.f, 1.f} : *(const f32x4*)(g + col0 + bj * HALF + n * 16); bv[bj][n] = resp ? (f32x4){0.f, 0.f, 0.f, 0.f} : *(const f32x4*)(b + col0 + bj * HALF + n * 16); }
#pragma unroll
        for (int ai = 0; ai < 2; ++ai)
#pragma unroll
            for (int m = 0; m < 4; ++m) { const int row = row0 + ai * HALF + m * 16; const size_t off = (size_t)row * ldc + col0;
                float mu = 0.f, rs = 1.f;
                if (!resp) { mu = stats[2 * row]; rs = stats[2 * row + 1]; }
                const float* src = resp ? resp : C;
                f32x4 rv[2][2];
#pragma unroll
                for (int bj = 0; bj < 2; ++bj)
#pragma unroll
                    for (int n = 0; n < 2; ++n) rv[bj][n] = *(const f32x4*)(src + off + bj * HALF + n * 16);
#pragma unroll
                for (int bj = 0; bj < 2; ++bj)
#pragma unroll
                    for (int n = 0; n < 2; ++n) *(f32x4*)(C + off + bj * HALF + n * 16) = ((rv[bj][n] - mu) * rs * gv[bj][n] + bv[bj][n]) * alpha + acc[ai][bj][m][n]; }
    }
};
struct EpiSlabF32 {
    static constexpr bool PERM = false, AFTER_DRAIN = false;
    float* C; int ldc, pad; size_t zC;
    __device__ __forceinline__ void operator()(const f32x4 (&acc)[2][2][4][2], const Unit& u, int wr, int wc, int fr, int fq) const {
        const int row0 = wr * 64 + fr, col0 = u.pn * BM + wc * 32 + 4 * fq;
#pragma unroll
        for (int m = 0; m < 4; ++m) { float* rowp = C + (size_t)u.z * zC + (size_t)(row0 + m * 16) * ldc + col0;
#pragma unroll
            for (int bj = 0; bj < 2; ++bj)
#pragma unroll
                for (int n = 0; n < 2; ++n) *(f32x4*)(rowp + bj * HALF + n * 16) = acc[0][bj][m][n]; }
    }
};
struct ZOrder {
    StaticOrder so; int nz, G, c, per;
    __device__ void init(int M, int N, int nz_, int G_, int c_) { so.init(M, N, 1, 0); nz = nz_; G = G_; c = c_; per = so.nwg; }
    __device__ bool next(int i, Unit& u) const {
        const long L = (long)i * G + c; if (L >= (long)per * nz) return false;
        const int z = (int)(L / per), rem = (int)(L % per);
        StaticOrder t = so; t.c = rem; t.next(0, u); u.z = z; return true;
    }
    __device__ __forceinline__ void a_ready(const Unit&) const {}
    __device__ __forceinline__ void done(const Unit&) const {}
};
struct TileZ3Order {
    StaticOrder so; int G, c, per;
    __device__ void init(int M, int N, int G_, int c_) { so.init(M, N, 1, 0); G = G_; c = c_; per = so.nwg; }
    __device__ bool next(int i, Unit& u) const {
        const int ti = i / 3, z = i - 3 * ti; const long L = (long)ti * G + c; if (L >= per) return false;
        StaticOrder t = so; t.c = (int)L; t.next(0, u); u.z = z; return true;
    }
    __device__ __forceinline__ void a_ready(const Unit&) const {}
    __device__ __forceinline__ void done(const Unit&) const {}
};
template <class Epi, class Sched, bool ALIGN_EPI = false, bool SP2 = false>
__device__ __forceinline__ void gemm_phase(PG8_LAS unsigned char* lds, const Gemm g, const Sched& S, const Epi& E) {
    int tid_l = threadIdx.x; asm volatile("" : "+v"(tid_l));
    const int tid = tid_l, wid = __builtin_amdgcn_readfirstlane(tid >> 6), lane = tid & 63, wr = wid >> 2, wc = wid & 3, fr = lane & 15, fq = lane >> 4;
    const int K = g.K, nt = K / BK;
    unsigned voffA[2], voffB[2];
#pragma unroll
    for (int i = 0; i < 2; ++i) { int R, C; stage_rc(tid * 16 + i * 8192, R, C); const int Rb = Epi::PERM ? ((R & ~31) + perm32(R & 31)) : R;
        voffA[i] = (unsigned)(R * g.lda + C) * 2u; voffB[i] = (unsigned)(Rb * g.ldb + C) * 2u; }
    const size_t kstep = (size_t)(BK * 2);
    const size_t hstepA = (size_t)HALF * g.lda * 2, hstepB = (size_t)HALF * g.ldb * 2;
    const size_t tstepA = 2 * hstepA, tstepB = 2 * hstepB;
    const unsigned ldsw = (unsigned)wid * 1024u;
    const int aoff = lds_byte(wr * 64 + fr, fq * 8), boff = lds_byte(wc * 32 + fr, fq * 8);
#define PG8_SA(b, h) (((b) * 2 + (h)) * HTB)
#define PG8_SB(b, h) ((4 + (b) * 2 + (h)) * HTB)
#define PG8_STAGE(bufoff, gbase, voff) do { _Pragma("unroll") for (int _i = 0; _i < 2; ++_i) \
        __builtin_amdgcn_global_load_lds((const unsigned*)((const char*)(gbase) + (voff)[_i]), (PG8_LAS unsigned*)(lds + (bufoff) + ldsw + _i * 8192), 16, 0, 0); } while (0)
#define PG8_LDA(dst, b, h) do { _Pragma("unroll") for (int m = 0; m < 4; ++m) _Pragma("unroll") for (int k = 0; k < 2; ++k) dst[m][k] = *(const PG8_LAS bf16x8*)(lds + PG8_SA(b, h) + aoff + m * 2048 + k * 1024); } while (0)
#define PG8_LDB(dst, b, h) do { _Pragma("unroll") for (int n = 0; n < 2; ++n) _Pragma("unroll") for (int k = 0; k < 2; ++k) dst[n][k] = *(const PG8_LAS bf16x8*)(lds + PG8_SB(b, h) + boff + n * 2048 + k * 1024); } while (0)
#define PG8_MMA(ai, bj, At, Bt) do { __builtin_amdgcn_s_setprio(1); _Pragma("unroll") for (int m = 0; m < 4; ++m) _Pragma("unroll") for (int n = 0; n < 2; ++n) _Pragma("unroll") for (int k = 0; k < 2; ++k) \
        acc[ai][bj][m][n] = __builtin_amdgcn_mfma_f32_16x16x32_bf16(Bt[n][k], At[m][k], acc[ai][bj][m][n], 0, 0, 0); __builtin_amdgcn_s_setprio(0); } while (0)
#define PG8_WAIT_V(n) asm volatile("s_waitcnt vmcnt(" #n ")" ::: "memory")
#define PG8_WAIT_L(n) asm volatile("s_waitcnt lgkmcnt(" #n ")" ::: "memory")
#define PG8_BAR __builtin_amdgcn_s_barrier()
#define PG8_SCHED __builtin_amdgcn_sched_barrier(0)
    Unit cur, nxt; int ui = 0;
    if (!S.next(0, cur)) return;
    f32x4 acc[2][2][4][2];
#pragma unroll
    for (int a = 0; a < 2; ++a)
#pragma unroll
        for (int b = 0; b < 2; ++b)
#pragma unroll
            for (int m = 0; m < 4; ++m)
#pragma unroll
                for (int n = 0; n < 2; ++n) acc[a][b][m][n] = (f32x4){0.f, 0.f, 0.f, 0.f};
    bf16x8 At[4][2], B0[2][2], B1[2][2];
    const char* cA = (const char*)g.A + (size_t)cur.pm * tstepA + ((size_t)(cur.z / g.zdiv) * g.zA + (size_t)(cur.z % g.zdiv) * g.zA2) * 2; const char* cB = (const char*)g.Bt + (size_t)cur.pn * tstepB + ((size_t)(cur.z / g.zdiv) * g.zB + (size_t)(cur.z % g.zdiv) * g.zB2) * 2;
    S.a_ready(cur);
    if constexpr (SP2) {
        PG8_STAGE(PG8_SB(0, 0), cB, voffB); PG8_STAGE(PG8_SB(0, 1), cB + hstepB, voffB); PG8_STAGE(PG8_SA(0, 0), cA, voffA); PG8_STAGE(PG8_SA(0, 1), cA + hstepA, voffA);
        if (wr == 1) PG8_BAR;
        PG8_WAIT_V(2); PG8_BAR;
        PG8_STAGE(PG8_SB(1, 0), cB + kstep, voffB); PG8_STAGE(PG8_SA(1, 0), cA + kstep, voffA); PG8_STAGE(PG8_SB(1, 1), cB + hstepB + kstep, voffB);
        PG8_WAIT_V(6); PG8_BAR;
    } else {
        PG8_STAGE(PG8_SB(0, 0), cB, voffB); PG8_STAGE(PG8_SA(0, 0), cA, voffA); PG8_STAGE(PG8_SB(0, 1), cB + hstepB, voffB); PG8_STAGE(PG8_SA(0, 1), cA + hstepA, voffA);
        if (wr == 1) PG8_BAR;
        PG8_WAIT_V(4); PG8_BAR;
        PG8_STAGE(PG8_SB(1, 0), cB + kstep, voffB); PG8_STAGE(PG8_SA(1, 0), cA + kstep, voffA); PG8_STAGE(PG8_SB(1, 1), cB + hstepB + kstep, voffB);
        PG8_WAIT_V(6); PG8_BAR;
    }
    for (;;) {
        const bool has_next = S.next(ui + 1, nxt);
        const char* nA = has_next ? (const char*)g.A + (size_t)nxt.pm * tstepA + ((size_t)(nxt.z / g.zdiv) * g.zA + (size_t)(nxt.z % g.zdiv) * g.zA2) * 2 : cA; const char* nB = has_next ? (const char*)g.Bt + (size_t)nxt.pn * tstepB + ((size_t)(nxt.z / g.zdiv) * g.zB + (size_t)(nxt.z % g.zdiv) * g.zB2) * 2 : cB;
        for (int t = 0; t < nt; t += 2) {
            const bool last = (t == nt - 2);
            const char* a1 = cA + (size_t)(t + 1) * kstep;
            const char* a2 = last ? nA : cA + (size_t)(t + 2) * kstep; const char* b2 = last ? nB : cB + (size_t)(t + 2) * kstep;
            const char* a3 = a2 + kstep; const char* b3 = b2 + kstep;
            if (last && has_next) S.a_ready(nxt);
            if constexpr (SP2) {
            PG8_LDB(B0, 0, 0); PG8_LDB(B1, 0, 1); PG8_SCHED; PG8_LDA(At, 0, 0); PG8_STAGE(PG8_SA(1, 1), a1 + hstepA, voffA);
            PG8_WAIT_V(8); PG8_WAIT_L(0); PG8_BAR; PG8_MMA(0, 0, At, B0); PG8_MMA(0, 1, At, B1); PG8_BAR; PG8_SCHED;
            PG8_LDA(At, 0, 1); PG8_STAGE(PG8_SB(0, 0), b2, voffB); PG8_STAGE(PG8_SB(0, 1), b2 + hstepB, voffB); PG8_STAGE(PG8_SA(0, 0), a2, voffA);
            PG8_WAIT_V(8); PG8_WAIT_L(0); PG8_BAR; PG8_MMA(1, 0, At, B0); PG8_MMA(1, 1, At, B1); PG8_BAR; PG8_SCHED;
            PG8_LDB(B0, 1, 0); PG8_LDB(B1, 1, 1); PG8_SCHED; PG8_LDA(At, 1, 0); PG8_STAGE(PG8_SA(0, 1), a2 + hstepA, voffA);
            PG8_WAIT_V(8); PG8_WAIT_L(0); PG8_BAR; PG8_MMA(0, 0, At, B0); PG8_MMA(0, 1, At, B1); PG8_BAR; PG8_SCHED;
            PG8_LDA(At, 1, 1); PG8_STAGE(PG8_SB(1, 0), b3, voffB); PG8_STAGE(PG8_SB(1, 1), b3 + hstepB, voffB); PG8_STAGE(PG8_SA(1, 0), a3, voffA);
            PG8_WAIT_V(8); PG8_WAIT_L(0); PG8_BAR; PG8_MMA(1, 0, At, B0); PG8_MMA(1, 1, At, B1); PG8_BAR; PG8_SCHED;
            } else {
            PG8_LDB(B0, 0, 0); PG8_SCHED; PG8_LDA(At, 0, 0); PG8_STAGE(PG8_SA(1, 1), a1 + hstepA, voffA);
            PG8_WAIT_L(8); PG8_BAR; PG8_WAIT_L(0); PG8_MMA(0, 0, At, B0); PG8_BAR; PG8_SCHED;
            PG8_LDB(B1, 0, 1); PG8_STAGE(PG8_SB(0, 0), b2, voffB);
            PG8_BAR; PG8_WAIT_L(0); PG8_MMA(0, 1, At, B1); PG8_BAR;
            PG8_LDA(At, 0, 1); PG8_STAGE(PG8_SA(0, 0), a2, voffA);
            PG8_BAR; PG8_WAIT_L(0); PG8_MMA(1, 0, At, B0); PG8_BAR; PG8_SCHED;
            PG8_STAGE(PG8_SB(0, 1), b2 + hstepB, voffB);
            PG8_WAIT_V(6); PG8_BAR; PG8_MMA(1, 1, At, B1); PG8_BAR;
            PG8_LDB(B0, 1, 0); PG8_SCHED; PG8_LDA(At, 1, 0); PG8_STAGE(PG8_SA(0, 1), a2 + hstepA, voffA);
            PG8_WAIT_L(8); PG8_BAR; PG8_WAIT_L(0); PG8_MMA(0, 0, At, B0); PG8_BAR; PG8_SCHED;
            PG8_LDB(B1, 1, 1); PG8_STAGE(PG8_SB(1, 0), b3, voffB);
            PG8_BAR; PG8_WAIT_L(0); PG8_MMA(0, 1, At, B1); PG8_BAR;
            PG8_LDA(At, 1, 1); PG8_STAGE(PG8_SA(1, 0), a3, voffA);
            PG8_BAR; PG8_WAIT_L(0); PG8_MMA(1, 0, At, B0); PG8_BAR; PG8_SCHED;
            PG8_STAGE(PG8_SB(1, 1), b3 + hstepB, voffB);
            PG8_WAIT_V(6); PG8_BAR; PG8_MMA(1, 1, At, B1); PG8_BAR;
            }
        }
        if constexpr (ALIGN_EPI) { if (wr == 0) PG8_BAR; }
        if constexpr (!Epi::AFTER_DRAIN) { E(acc, cur, wr, wc, fr, fq); S.done(cur); }
        if (!has_next) break;
#pragma unroll
        for (int a = 0; a < 2; ++a)
#pragma unroll
            for (int b = 0; b < 2; ++b)
#pragma unroll
                for (int m = 0; m < 4; ++m)
#pragma unroll
                    for (int n = 0; n < 2; ++n) acc[a][b][m][n] = (f32x4){0.f, 0.f, 0.f, 0.f};
        cur = nxt; cA = nA; cB = nB; ++ui;
        if constexpr (ALIGN_EPI) { if (wr == 1) PG8_BAR; }
    }
    PG8_WAIT_V(0);
    if constexpr (!ALIGN_EPI) { if (wr == 0) PG8_BAR; }
    PG8_BAR;
    if constexpr (Epi::AFTER_DRAIN) { E.fused(acc, cur, wr, wc, fr, fq, lds, wid, lane); S.done(cur); }
#undef PG8_SA
#undef PG8_SB
#undef PG8_STAGE
#undef PG8_LDA
#undef PG8_LDB
#undef PG8_MMA
#undef PG8_WAIT_V
#undef PG8_WAIT_L
#undef PG8_BAR
#undef PG8_SCHED
}
}

constexpr int D = 2048, NPROMPT = 8192, TP = 4096, NDEC = 128, TD = 4, MROWS = NPROMPT + NDEC, DEPTH = 4;
constexpr int PAST = 16384;
constexpr int INC = 14880, PP = 15104  , MPAD = 8448  ;
constexpr int C_AQ = 0, C_AK = 1024, C_AV = 1280, C_BQ = 1536, C_BK = 2048, C_BV = 2560, C_BG = 3584, C_BLR = 4608,
              C_CQKV = 4624, C_CZ = 7696, C_CA = 8720, C_CB = 8728, C_MG = 8736;
constexpr int DFF = 5632, DFF2 = 11264;
constexpr float ALPHA = 1.681792830507429f;
constexpr size_t O_YP = 0, O_YS = 16777216, O_PK = 17039360, O_PV = 17301504, O_PGLA = 17563648, O_PDELTA = 18612224,
                 O_PDCONV = 19660800, O_PFCONV = 19734528, O_SK = 19914752, O_SV = 24109056, O_SGLA = 28303360,
                 O_SDELTA = 45080576, O_SDCONV = 61857792, O_SFCONV = 63037440, O_TOTAL = 65921024;

typedef unsigned short bf16;
typedef short bf16x8 __attribute__((ext_vector_type(8)));
typedef float f32x16 __attribute__((ext_vector_type(16)));
typedef unsigned u32x4v __attribute__((ext_vector_type(4)));
typedef unsigned u32x2v __attribute__((ext_vector_type(2)));
typedef float f32x4v __attribute__((ext_vector_type(4)));
struct P {
    const float* in[26];
    float* out;
    float *X, *H, *QR, *KR, *AG, *DQKV, *G, *BETA, *OBRAW, *OCRAW, *T3, *Z;
    bf16* PROJ;
    float* ROT;
    float *SMALL, *VD;
    bf16 *Xb, *Hb, *OAb, *OBb, *OCb, *MIXb, *Fb;
    bf16* U16;
    float *ST1, *ST2;
    float *T3d, *Zd1, *Zd2;
    bf16 *Win, *Wbr, *Wout, *Wup, *Wdn;
    bf16 *QB16, *KB16, *VT16;
    bf16 *GQT, *GKT, *GVT, *GA; float* GDEC;
    float* DUB; bf16 *DNW, *DQD, *DAQK, *DKE; float* DDEC;
};
__device__ __forceinline__ unsigned f2bf(float f) { unsigned u = __builtin_bit_cast(unsigned, f); return (u + 0x7fffu + ((u >> 16) & 1u)) >> 16; }
typedef __bf16 bf16x2_t __attribute__((ext_vector_type(2)));
typedef float f32x2_t __attribute__((ext_vector_type(2)));
__device__ __forceinline__ unsigned pk2(float lo, float hi) { f32x2_t v = {lo, hi}; bf16x2_t b = __builtin_convertvector(v, bf16x2_t); return __builtin_bit_cast(unsigned, b); }

__device__ __forceinline__ float ldbf(const bf16* q) { return __builtin_bit_cast(float, (unsigned)(*q) << 16); }
__device__ __forceinline__ f32x4v ldbf4(const bf16* q) { const u32x2v w = *(const u32x2v*)q; f32x4v r; r.x = __builtin_bit_cast(float, w.x << 16); r.y = __builtin_bit_cast(float, w.x & 0xffff0000u); r.z = __builtin_bit_cast(float, w.y << 16); r.w = __builtin_bit_cast(float, w.y & 0xffff0000u); return r; }
__device__ __forceinline__ float2 ldbf2(const bf16* q) { const unsigned w = *(const unsigned*)q; return make_float2(__builtin_bit_cast(float, w << 16), __builtin_bit_cast(float, w & 0xffff0000u)); }
__device__ __forceinline__ int row_seq(int r) { return r < NPROMPT ? (r >> 12) : 2 + ((r - NPROMPT) >> 2); }
__device__ __forceinline__ int row_t(int r) { return r < NPROMPT ? (r & 4095) : ((r - NPROMPT) & 3); }
__device__ __forceinline__ int seq_row0(int s) { return s < 2 ? s * TP : NPROMPT + (s - 2) * TD; }
__device__ __forceinline__ int seq_len(int s) { return s < 2 ? TP : TD; }
#define DPP_F(v, ctrl) __builtin_bit_cast(float, __builtin_amdgcn_update_dpp(0, __builtin_bit_cast(int, (v)), (ctrl), 0xF, 0xF, true))
__device__ __forceinline__ float row16_sum(float v) {
    v += DPP_F(v, 0xB1);
    v += DPP_F(v, 0x4E);
    v += DPP_F(v, 0x141);
    v += DPP_F(v, 0x140);
    return v;
}
__device__ __forceinline__ float wave_sum(float v) {
    v = row16_sum(v);
    v += __shfl_xor(v, 16); v += __shfl_xor(v, 32);
    return v;
}
__device__ __forceinline__ float wave_max(float v) {
#pragma unroll
    for (int o = 1; o < 64; o <<= 1) v = fmaxf(v, __shfl_xor(v, o));
    return v;
}
__device__ __forceinline__ float sigmoidf_(float x) { return __builtin_amdgcn_rcpf(1.f + __expf(-x)); }
__device__ __forceinline__ float siluf_(float x) { return x * __builtin_amdgcn_rcpf(1.f + __expf(-x)); }
__device__ __forceinline__ float softplusf_(float x) { return fmaxf(x, 0.f) + __logf(1.f + __expf(-fabsf(x))); }


struct EpiU {
    static constexpr bool PERM = true, AFTER_DRAIN = false;
    bf16* U16; float* out; int l, pad;
    __device__ __forceinline__ void operator()(const pg8::f32x4 (&acc)[2][2][4][2], const pg8::Unit& u, int wr, int wc, int fr, int fq) const {
        const int row0 = u.pm * 256 + wr * 64 + fr, col0 = u.pn * 256 + wc * 32 + 8 * fq;
#pragma unroll
        for (int ai = 0; ai < 2; ++ai)
#pragma unroll
            for (int m = 0; m < 4; ++m) {
                bf16* rowp = U16 + (size_t)(row0 + ai * 128 + m * 16) * DFF2 + col0;
#pragma unroll
                for (int bj = 0; bj < 2; ++bj) {
                    const pg8::f32x4 v0 = acc[ai][bj][m][0], v1 = acc[ai][bj][m][1];
                    pg8::u32x4 w; w.x = pk2(v0[0], v0[1]); w.y = pk2(v0[2], v0[3]); w.z = pk2(v1[0], v1[1]); w.w = pk2(v1[2], v1[3]);
                    *(pg8::u32x4*)(rowp + bj * 128) = w;
                }
            }
        if (u.pm == 15 || u.pm == 31 || u.pm == 32) {
#pragma unroll
            for (int ai = 0; ai < 2; ++ai)
#pragma unroll
                for (int m = 0; m < 4; ++m) {
                    const int r = row0 + ai * 128 + m * 16;
                    float* op = nullptr;
                    if (r < NPROMPT) { const int t = r & 4095; if (t >= TP - 2) op = out + O_PFCONV + (((size_t)l * 2 + (r >> 12)) * 2 + (t - (TP - 2))) * DFF2 + col0; }
                    else if (r < MROWS) { const int t = (r - NPROMPT) & 3; if (t >= 2) op = out + O_SFCONV + (((size_t)l * 32 + ((r - NPROMPT) >> 2)) * 2 + (t - 2)) * DFF2 + col0; }
                    if (op) {
#pragma unroll
                        for (int bj = 0; bj < 2; ++bj) { *(pg8::f32x4*)(op + bj * 128) = acc[ai][bj][m][0]; *(pg8::f32x4*)(op + bj * 128 + 4) = acc[ai][bj][m][1]; }
                    }
                }
        }
    }
};

struct EpiIn {
    static constexpr bool PERM = true, AFTER_DRAIN = false;
    bf16* O; float* small; const float* rot; bf16* qb; bf16* kb; float* qr; float* kr; float* vd; float* out; int l, pad;
    __device__ __forceinline__ void attn_tiles(const pg8::f32x4 (&acc)[2][2][4][2], const pg8::Unit& u, int wr, int wc, int fr, int fq) const {
        const int row0 = u.pm * 256 + wr * 64 + fr, colt = wc * 32 + 8 * fq;
        const bool rotl = (u.pn <= 4) && ((wc & 1) == 0);
#pragma unroll
        for (int ai = 0; ai < 2; ++ai)
#pragma unroll
            for (int m = 0; m < 4; ++m) {
                const int r = row0 + ai * 128 + m * 16;
                const bool prompt = r < NPROMPT, dec = !prompt && r < MROWS;
                const int t = prompt ? (r & 4095) : ((r - NPROMPT) & 3), sq = prompt ? (r >> 12) : ((r - NPROMPT) >> 2);
                pg8::f32x4 cs[2], sn[2];
                if (rotl) { const float* rp = rot + (size_t)(prompt ? t : (dec ? 4096 + t : 0)) * 16;
                    const pg8::f32x4 a0 = *(const pg8::f32x4*)rp, a1 = *(const pg8::f32x4*)(rp + 4), a2 = *(const pg8::f32x4*)(rp + 8), a3 = *(const pg8::f32x4*)(rp + 12);
                    cs[0] = (pg8::f32x4){a0[0], a0[2], a1[0], a1[2]}; sn[0] = (pg8::f32x4){a0[1], a0[3], a1[1], a1[3]};
                    cs[1] = (pg8::f32x4){a2[0], a2[2], a3[0], a3[2]}; sn[1] = (pg8::f32x4){a2[1], a2[3], a3[1], a3[3]}; }
#pragma unroll
                for (int bj = 0; bj < 2; ++bj) {
                    pg8::f32x4 v[2] = {acc[ai][bj][m][0], acc[ai][bj][m][1]};
                    if (rotl) {
#pragma unroll
                        for (int n = 0; n < 2; ++n) {
                            pg8::f32x4 pt;
#pragma unroll
                            for (int e = 0; e < 4; ++e) pt[e] = __shfl_xor(v[n][e], 16);
                            if (fq == 0) v[n] = v[n] * cs[n] - pt * sn[n];
                            else if (fq == 1) v[n] = v[n] * cs[n] + pt * sn[n];
                        }
                    }
                    const int c = colt + bj * 128;
                    if (u.pn <= 3) {
                        const int cq = u.pn * 256 + c;
                        if (prompt) { pg8::u32x4 w; w.x = pk2(v[0][0], v[0][1]); w.y = pk2(v[0][2], v[0][3]); w.z = pk2(v[1][0], v[1][1]); w.w = pk2(v[1][2], v[1][3]); *(pg8::u32x4*)(qb + (size_t)r * 1024 + cq) = w; }
                        else if (dec) { *(pg8::f32x4*)(qr + (size_t)r * 1024 + cq) = v[0]; *(pg8::f32x4*)(qr + (size_t)r * 1024 + cq + 4) = v[1]; }
                    } else {
                        const bool isk = u.pn == 4;
                        if (prompt) {
                            pg8::u32x4 w; w.x = pk2(v[0][0], v[0][1]); w.y = pk2(v[0][2], v[0][3]); w.z = pk2(v[1][0], v[1][1]); w.w = pk2(v[1][2], v[1][3]);
                            if (isk) *(pg8::u32x4*)(kb + (size_t)r * 256 + c) = w; else *(pg8::u32x4*)(O + (size_t)r * PP + C_AV + c) = w;
                            if (t >= TP - 128) { float* op = out + (isk ? O_PK : O_PV) + (((size_t)l * 2 + sq) * 128 + (t - (TP - 128))) * 256 + c; *(pg8::f32x4*)op = v[0]; *(pg8::f32x4*)(op + 4) = v[1]; }
                        } else if (dec) {
                            float* dp = (isk ? kr + (size_t)r * 256 : vd + (size_t)(r - NPROMPT) * 256) + c; *(pg8::f32x4*)dp = v[0]; *(pg8::f32x4*)(dp + 4) = v[1];
                            float* op = out + (isk ? O_SK : O_SV) + (((size_t)l * 32 + sq) * 128 + 124 + t) * 256 + c; *(pg8::f32x4*)op = v[0]; *(pg8::f32x4*)(op + 4) = v[1];
                        }
                    }
                }
            }
    }
    __device__ __forceinline__ void operator()(const pg8::f32x4 (&acc)[2][2][4][2], const pg8::Unit& u, int wr, int wc, int fr, int fq) const {
        if (u.pn <= 5) { attn_tiles(acc, u, wr, wc, fr, fq); return; }
        const int row0 = u.pm * 256 + wr * 64 + fr, col0 = u.pn * 256 + wc * 32 + 8 * fq;
        const bool sm = wc == 0 && ((u.pn == 18 && fq < 2) || (u.pn == 34 && fq >= 2));
#pragma unroll
        for (int ai = 0; ai < 2; ++ai)
#pragma unroll
            for (int m = 0; m < 4; ++m) {
                const int r = row0 + ai * 128 + m * 16;
                bf16* rowp = O + (size_t)r * PP + col0;
#pragma unroll
                for (int bj = 0; bj < 2; ++bj) {
                    const pg8::f32x4 v0 = acc[ai][bj][m][0], v1 = acc[ai][bj][m][1];
                    pg8::u32x4 w; w.x = pk2(v0[0], v0[1]); w.y = pk2(v0[2], v0[3]); w.z = pk2(v1[0], v1[1]); w.w = pk2(v1[2], v1[3]);
                    *(pg8::u32x4*)(rowp + bj * 128) = w;
                }
                if (sm) { *(pg8::f32x4*)(small + (size_t)r * 32 + 8 * fq) = acc[ai][0][m][0]; *(pg8::f32x4*)(small + (size_t)r * 32 + 8 * fq + 4) = acc[ai][0][m][1]; }
            }
    }
};
struct EpiMix {
    static constexpr bool PERM = true, AFTER_DRAIN = false;
    const bf16* mg; float* accb; bf16* out;
    __device__ __forceinline__ void operator()(const pg8::f32x4 (&acc)[2][2][4][2], const pg8::Unit& u, int wr, int wc, int fr, int fq) const {
        const int row0 = u.pm * 256 + wr * 64 + fr, col0 = u.pn * 256 + wc * 32 + 8 * fq;
#pragma unroll
        for (int ai = 0; ai < 2; ++ai)
#pragma unroll
            for (int m = 0; m < 4; ++m) {
                const size_t r = (size_t)(row0 + ai * 128 + m * 16);
#pragma unroll
                for (int bj = 0; bj < 2; ++bj) {
                    const int col = col0 + bj * 128;
                    const u32x4v gw = *(const u32x4v*)(mg + r * PP + (size_t)u.z * D + col);
                    float gt[8];
                    gt[0] = __builtin_bit_cast(float, gw.x << 16); gt[1] = __builtin_bit_cast(float, gw.x & 0xffff0000u); gt[2] = __builtin_bit_cast(float, gw.y << 16); gt[3] = __builtin_bit_cast(float, gw.y & 0xffff0000u);
                    gt[4] = __builtin_bit_cast(float, gw.z << 16); gt[5] = __builtin_bit_cast(float, gw.z & 0xffff0000u); gt[6] = __builtin_bit_cast(float, gw.w << 16); gt[7] = __builtin_bit_cast(float, gw.w & 0xffff0000u);
                    pg8::f32x4 v0 = acc[ai][bj][m][0], v1 = acc[ai][bj][m][1];
#pragma unroll
                    for (int e = 0; e < 4; ++e) { v0[e] *= sigmoidf_(gt[e]); v1[e] *= sigmoidf_(gt[4 + e]); }
                    float* ap = accb + r * D + col;
                    if (u.z > 0) { v0 += *(const pg8::f32x4*)ap; v1 += *(const pg8::f32x4*)(ap + 4); }
                    if (u.z < 2) { *(pg8::f32x4*)ap = v0; *(pg8::f32x4*)(ap + 4) = v1; }
                    else { pg8::u32x4 w; w.x = pk2(v0[0], v0[1]); w.y = pk2(v0[2], v0[3]); w.z = pk2(v1[0], v1[1]); w.w = pk2(v1[2], v1[3]); *(pg8::u32x4*)(out + r * D + col) = w; }
                }
            }
    }
};
#define LAS __attribute__((address_space(3)))
#define XB_TMO      128
#define XB_XCNT(j)  (256  + 64 * (j))
#define XB_XSUB(j)  (1280 + 64 * (j))
#define XB_XGEN(j)  (2304 + 64 * (j))
#define XB_TOP      3328
#define XB_TOPGEN   3392
#define XCD_BAR_WORDS 3456
#define XB_SPIN_CAP (1u << 18)

__device__ __forceinline__ unsigned xb_ld(unsigned* p)              { return __hip_atomic_load(p, __ATOMIC_RELAXED, __HIP_MEMORY_SCOPE_AGENT); }
__device__ __forceinline__ unsigned xb_add(unsigned* p, unsigned v) { return __hip_atomic_fetch_add(p, v, __ATOMIC_RELAXED, __HIP_MEMORY_SCOPE_AGENT); }
__device__ __forceinline__ unsigned xb_xcc_id() { return (unsigned)__builtin_amdgcn_s_getreg((3 << 11) | 20) & 0xFu; }
#define XB_SPIN(cond, bar) do { unsigned _sp = 0; while (cond) { __builtin_amdgcn_s_sleep(1); \
    if ((++_sp & 255u) == 0u) { if (xb_ld(&(bar)[XB_TMO])) break; if (_sp > XB_SPIN_CAP) { atomicAdd(&(bar)[XB_TMO], 1u); break; } } } } while (0)

struct XcdBarrier {
    unsigned* bar; unsigned x;
    volatile LAS unsigned* st;
};

__device__ __forceinline__ XcdBarrier xcd_barrier_post(unsigned* bar, volatile LAS unsigned* st) {
    XcdBarrier b; b.bar = bar; b.x = xb_xcc_id(); b.st = st;
    if (threadIdx.x == 0) (void)xb_add(&bar[XB_XCNT(b.x)], 1u);
    return b;
}
__device__ __forceinline__ void xcd_barrier_complete(unsigned* bar, unsigned x, unsigned& nloc, unsigned& nx) {
    const unsigned G = gridDim.x * gridDim.y * gridDim.z;
    unsigned sum, cnt, mine, sp = 0u;
    for (;;) {
        sum = 0u; cnt = 0u; mine = 0u;
#pragma unroll
        for (unsigned j = 0; j < 16; ++j) { const unsigned c = xb_ld(&bar[XB_XCNT(j)]); sum += c; cnt += (c > 0u) ? 1u : 0u; mine = (j == x) ? c : mine; }
        if (sum == G) break;
        __builtin_amdgcn_s_sleep(1);
        if ((++sp & 255u) == 0u) { if (xb_ld(&bar[XB_TMO])) break; if (sp > XB_SPIN_CAP) { atomicAdd(&bar[XB_TMO], 1u); break; } }
    }
    nloc = mine > 0u ? mine : 1u; nx = cnt > 0u ? cnt : 1u;
}

__device__ __forceinline__ void xcd_barrier(const XcdBarrier& b) {
    asm volatile("s_waitcnt vmcnt(0)" ::: "memory");
    __syncthreads();
    if (threadIdx.x == 0) {
        unsigned* bar = b.bar;
        __builtin_amdgcn_s_waitcnt(0);
        unsigned nloc = b.st[0], nx = b.st[1];
        if (nloc == 0u) { xcd_barrier_complete(bar, b.x, nloc, nx); b.st[0] = nloc; b.st[1] = nx; }
        const unsigned old = xb_add(&bar[XB_XSUB(b.x)], 1u);
        const unsigned gen = old / nloc;
        if (old + 1u == (gen + 1u) * nloc) {
            __builtin_amdgcn_fence(__ATOMIC_RELEASE, "agent");
            asm volatile("s_waitcnt vmcnt(0)" ::: "memory");
            const unsigned og = xb_add(&bar[XB_TOP], 1u);
            const unsigned tg = og / nx;
            if (og + 1u == (tg + 1u) * nx) xb_add(&bar[XB_TOPGEN], 1u);
            else XB_SPIN(xb_ld(&bar[XB_TOPGEN]) == tg, bar);
            __builtin_amdgcn_fence(__ATOMIC_ACQUIRE, "agent");
            xb_add(&bar[XB_XGEN(b.x)], 1u);
            asm volatile("s_waitcnt vmcnt(0)" ::: "memory");
        } else {
            XB_SPIN(xb_ld(&bar[XB_XGEN(b.x)]) == gen, bar);
            __builtin_amdgcn_fence(__ATOMIC_ACQUIRE, "agent");
            asm volatile("s_waitcnt vmcnt(0)" ::: "memory");
        }
    }
    __syncthreads();
}

__device__ __forceinline__ void wT_load(const float* W, int K, int N, int n0, int k0, LAS float* tile, int t256) {
    const int tr = t256 >> 6, tc = t256 & 63;
#pragma unroll
    for (int i = 0; i < 16; ++i) { const int kk = tr + 4 * i; tile[kk * 65 + tc] = (n0 + tc < N) ? W[(size_t)(k0 + kk) * N + n0 + tc] : 0.f; }
}
__device__ __forceinline__ void wT_store(bf16* Bt, int K, int n0, int k0, const LAS float* tile, int t256) {
#pragma unroll
    for (int j = 0; j < 2; ++j) {
        const int id = t256 + 256 * j, nl = id >> 3, kc = id & 7;
        uint4 o;
        o.x = pk2(tile[(kc * 8 + 0) * 65 + nl], tile[(kc * 8 + 1) * 65 + nl]); o.y = pk2(tile[(kc * 8 + 2) * 65 + nl], tile[(kc * 8 + 3) * 65 + nl]);
        o.z = pk2(tile[(kc * 8 + 4) * 65 + nl], tile[(kc * 8 + 5) * 65 + nl]); o.w = pk2(tile[(kc * 8 + 6) * 65 + nl], tile[(kc * 8 + 7) * 65 + nl]);
        *(uint4*)(Bt + (size_t)(n0 + nl) * K + k0 + kc * 8) = o;
    }
}
constexpr int WT_IN = (15104 / 64) * (2048 / 64), WT_BR = 3 * (2048 / 64) * (1024 / 64), WT_OUT = (2048 / 64) * (2048 / 64), WT_UP = (11264 / 64) * (2048 / 64), WT_DN = (2048 / 64) * (5632 / 64);
constexpr int WT_LAYER = WT_IN + WT_BR + WT_OUT + WT_UP + WT_DN, WT_TOTAL = 4 * WT_LAYER;
struct WTile { const float* W; bf16* Bt; int K, N, n0, k0; };
__device__ __forceinline__ WTile wT_tile(const P& p, int id) {
    WTile w; const int l = id / WT_LAYER; int r = id % WT_LAYER;
    if (r < WT_IN) { w.W = p.in[8] + (size_t)l * 2048 * 14880; w.Bt = p.Win + (size_t)l * 15104 * 2048; w.K = 2048; w.N = 14880; w.n0 = (r / 32) * 64; w.k0 = (r % 32) * 64; return w; }
    r -= WT_IN;
    if (r < WT_BR) { const int b = r / 512, q = r % 512; w.W = p.in[17] + ((size_t)l * 3 + b) * 1024 * 2048; w.Bt = p.Wbr + ((size_t)l * 3 + b) * 2048 * 1024; w.K = 1024; w.N = 2048; w.n0 = (q / 16) * 64; w.k0 = (q % 16) * 64; return w; }
    r -= WT_BR;
    if (r < WT_OUT) { w.W = p.in[18] + (size_t)l * 2048 * 2048; w.Bt = p.Wout + (size_t)l * 2048 * 2048; w.K = 2048; w.N = 2048; w.n0 = (r / 32) * 64; w.k0 = (r % 32) * 64; return w; }
    r -= WT_OUT;
    if (r < WT_UP) { w.W = p.in[21] + (size_t)l * 2048 * 11264; w.Bt = p.Wup + (size_t)l * 11264 * 2048; w.K = 2048; w.N = 11264; w.n0 = (r / 32) * 64; w.k0 = (r % 32) * 64; return w; }
    r -= WT_UP;
    w.W = p.in[23] + (size_t)l * 5632 * 2048; w.Bt = p.Wdn + (size_t)l * 2048 * 5632; w.K = 5632; w.N = 2048; w.n0 = (r / 88) * 64; w.k0 = (r % 88) * 64; return w;
}
__device__ __forceinline__ void wT_wave_task(const P& p, int id, int lane) {
    const WTile w = wT_tile(p, id);
    const int n = w.n0 + lane; const bool ok = n < w.N;
    const float* q = w.W + (size_t)w.k0 * w.N + (ok ? n : 0);
    float v[64];
#pragma unroll
    for (int kk = 0; kk < 64; ++kk) { v[kk] = *q; q += w.N; }
    bf16* o = w.Bt + (size_t)n * w.K + w.k0;
#pragma unroll
    for (int j = 0; j < 8; ++j) { u32x4v x; x.x = pk2(v[8 * j], v[8 * j + 1]); x.y = pk2(v[8 * j + 2], v[8 * j + 3]); x.z = pk2(v[8 * j + 4], v[8 * j + 5]); x.w = pk2(v[8 * j + 6], v[8 * j + 7]);
        if (!ok) x = (u32x4v){0u, 0u, 0u, 0u};
        *(u32x4v*)(o + 8 * j) = x; }
}
__device__ __forceinline__ void xinit_phase(const P& p, size_t i0, size_t stride) {
    const size_t n = (size_t)MROWS * D / 4;
    for (size_t i = i0; i < n; i += stride) {
        const size_t e = i * 4;
        const float4 v = e < (size_t)NPROMPT * D ? *(const float4*)(p.in[0] + e) : *(const float4*)(p.in[1] + (e - (size_t)NPROMPT * D));
        *(float4*)(p.X + e) = v;
        *(uint2*)(p.Xb + e) = make_uint2(pk2(v.x, v.y), pk2(v.z, v.w));
    }
}

__device__ __forceinline__ float sin_rev(float x) {
    x -= floorf(x);
    float y = x > 0.5f ? x - 1.0f : x;
    y = y > 0.25f ? 0.5f - y : (y < -0.25f ? -0.5f - y : y);
    const float a = y * 6.283185307179586f, a2 = a * a;
    float p = -2.5052108385441718e-08f;
    p = fmaf(p, a2, 2.7557319223985893e-06f);
    p = fmaf(p, a2, -1.984126984126984e-04f);
    p = fmaf(p, a2, 8.333333333333333e-03f);
    p = fmaf(p, a2, -1.6666666666666666e-01f);
    return fmaf(a * a2, p, a);
}
__device__ __forceinline__ double rot_inv_rev(int i) {
    const double t[8] = {0.15915494309189535, 0.03086376340470123, 0.005985185712713705, 0.001160663641240061,
                         0.00022507907903927653, 4.364795279280289e-05, 8.464330808241401e-06, 1.6414262627950345e-06};
    double r = t[0];
#pragma unroll
    for (int k = 1; k < 8; ++k) r = (i == k) ? t[k] : r;
    return r;
}
__device__ __forceinline__ void prep_task(const P& p, int l, int r, int part, int lane) {
    const bf16* pr = p.PROJ + (size_t)r * PP;
    const int s = row_seq(r), t = row_t(r);
    const float* cw = p.in[13] + (size_t)l * 4 * 3072;
    const int r0 = seq_row0(s);
    {
        const int hh = part - 1;
        float v2[2];
#pragma unroll
        for (int i = 0; i < 2; ++i) {
            const int c = hh * 128 + lane + 64 * i;
            float y = 0.f;
#pragma unroll
            for (int j = 0; j < 4; ++j) {
                const int tt = t - 3 + j;
                float xv;
                if (tt >= 0) xv = ldbf(p.PROJ + (size_t)(r0 + tt) * PP + C_CQKV + c);
                else xv = s < 2 ? 0.f : p.in[6][(((size_t)l * 32 + (s - 2)) * 3 + (3 + tt)) * 3072 + c];
                y = fmaf(cw[j * 3072 + c], xv, y);
            }
            v2[i] = siluf_(y);
        }
        if (hh < 16) {
            const float ss = wave_sum(v2[0] * v2[0] + v2[1] * v2[1]);
            float sc = __builtin_amdgcn_rsqf(ss + 1e-6f);
            if (hh < 8) sc *= 0.08838834764831845f;
            v2[0] *= sc; v2[1] *= sc;
        }
        p.DQKV[(size_t)r * 3072 + hh * 128 + lane] = v2[0];
        p.DQKV[(size_t)r * 3072 + hh * 128 + lane + 64] = v2[1];
    }
}

constexpr int PREP_ROWS = 5;
__device__ __forceinline__ void prep_rows_task(const P& p, int l, int rb, int lane) {
    float blr[PREP_ROWS][16];
#pragma unroll
    for (int rr = 0; rr < PREP_ROWS; ++rr)
#pragma unroll
        for (int j = 0; j < 16; ++j) blr[rr][j] = p.SMALL[(size_t)(rb + rr) * 32 + j];
    const float* Wg = p.in[10] + (size_t)l * 16 * 512; const float* bg = p.in[11] + (size_t)l * 512;
#pragma unroll 1
    for (int c = lane; c < 512; c += 64) {
        float wg[16]; const float b = bg[c];
#pragma unroll
        for (int j = 0; j < 16; ++j) wg[j] = Wg[j * 512 + c];
#pragma unroll
        for (int rr = 0; rr < PREP_ROWS; ++rr) {
            float z = b;
#pragma unroll
            for (int j = 0; j < 16; ++j) z = fmaf(blr[rr][j], wg[j], z);
            const float ls = fminf(z, 0.f) - __logf(1.f + __expf(-fabsf(z)));
            p.AG[(size_t)(rb + rr) * 512 + c] = ls * (1.f / 16.f);
        }
    }
    if (lane < 8 * PREP_ROWS) {
        const int rr = lane >> 3, hd = lane & 7, r = rb + rr;
        const float a_log = p.in[14][l * 8 + hd], dtb = p.in[15][l * 8 + hd];
        p.G[(size_t)r * 8 + hd] = -__expf(a_log) * softplusf_(p.SMALL[(size_t)r * 32 + 16 + hd] + dtb);
        p.BETA[(size_t)r * 8 + hd] = sigmoidf_(p.SMALL[(size_t)r * 32 + 24 + hd]);
    }
#pragma unroll 1
    for (int rr = 0; rr < PREP_ROWS; ++rr) {
        const int r = rb + rr, s = row_seq(r), t = row_t(r);
        int oi = -1; size_t ob = 0;
        if (s < 2) { if (t >= TP - 3) { oi = t - (TP - 3); ob = O_PDCONV + ((size_t)l * 2 + s) * 3 * 3072; } }
        else if (t >= 1) { oi = t - 1; ob = O_SDCONV + ((size_t)l * 32 + (s - 2)) * 3 * 3072; }
        if (oi >= 0) {
            const bf16* pr = p.PROJ + (size_t)r * PP;
#pragma unroll 1
            for (int c = lane * 4; c < 3072; c += 256) *(f32x4v*)(p.out + ob + (size_t)oi * 3072 + c) = ldbf4(pr + C_CQKV + c);
        }
    }
}
constexpr int CONV_ROWS = 16;
__device__ __forceinline__ void prep_conv_task(const P& p, int l, int task, int lane) {
    const int rg = task / 12, sl = task - rg * 12, c = sl * 256 + lane * 4, ra = rg * CONV_ROWS, t0 = ra & 4095;
    const float* cw = p.in[13] + (size_t)l * 4 * 3072;
    f32x4v x[CONV_ROWS + 3], w[4];
#pragma unroll
    for (int i = 0; i < CONV_ROWS + 3; ++i) {
        if (i < 3 && t0 == 0) x[i] = (f32x4v){0.f, 0.f, 0.f, 0.f};
        else x[i] = ldbf4(p.PROJ + (size_t)(ra - 3 + i) * PP + C_CQKV + c);
    }
#pragma unroll
    for (int j = 0; j < 4; ++j) w[j] = *(const f32x4v*)(cw + j * 3072 + c);
#pragma unroll
    for (int i = 0; i < CONV_ROWS; ++i) {
        f32x4v y = w[0] * x[i] + w[1] * x[i + 1] + w[2] * x[i + 2] + w[3] * x[i + 3];
        y.x = siluf_(y.x); y.y = siluf_(y.y); y.z = siluf_(y.z); y.w = siluf_(y.w);
        if (sl < 8) {
            float ss = y.x * y.x + y.y * y.y + y.z * y.z + y.w * y.w;
            ss = row16_sum(ss); ss += __shfl_xor(ss, 16);
            float sc = __builtin_amdgcn_rsqf(ss + 1e-6f);
            if (sl < 4) sc *= 0.08838834764831845f;
            y = y * sc;
        }
        *(f32x4v*)(p.DQKV + (size_t)(ra + i) * 3072 + c) = y;
    }
}
__device__ __forceinline__ bool kv_ptrs(const P& p, int l, int s, int t, int g, int j, const float*& kp, const float*& vp) {
    kp = nullptr; vp = nullptr;
    if (j > 128) return false;
    if (s < 2) {
        const int tk = t - 128 + j;
        if (tk < 0) return false;
        const size_t rr = (size_t)(s * TP + tk);
        kp = p.KR + rr * 256 + g * 64; vp = nullptr; return true;
    }
    const int jj = t + j;
    if (jj < 128) { const size_t o = ((((size_t)l * 32 + (s - 2)) * 128 + jj) * 4 + g) * 64; kp = p.in[2] + o; vp = p.in[3] + o; }
    else { const size_t rr = (size_t)(NPROMPT + (s - 2) * TD + (jj - 128)); kp = p.KR + rr * 256 + g * 64; vp = p.VD + (rr - NPROMPT) * 256 + g * 64; }
    return true;
}
__device__ __forceinline__ void attn_task(const P& p, int l, int r, int g, int lane) {
    const int s = row_seq(r), t = row_t(r);
    const float *k0, *k1, *k2, *vdummy;
    const bool ok0 = kv_ptrs(p, l, s, t, g, lane, k0, vdummy);
    const bool ok1 = kv_ptrs(p, l, s, t, g, lane + 64, k1, vdummy);
    const bool ok2 = kv_ptrs(p, l, s, t, g, lane + 128, k2, vdummy);
    float sc0[4] = {0, 0, 0, 0}, sc1[4] = {0, 0, 0, 0}, sc2[4] = {0, 0, 0, 0};
    const float* qp = p.QR + (size_t)r * 1024 + g * 256;
    for (int d4 = 0; d4 < 16; ++d4) {
        const float4 z4 = make_float4(0, 0, 0, 0);
        const float4 a = ok0 ? *(const float4*)(k0 + d4 * 4) : z4;
        const float4 b = ok1 ? *(const float4*)(k1 + d4 * 4) : z4;
        const float4 c = ok2 ? *(const float4*)(k2 + d4 * 4) : z4;
#pragma unroll
        for (int h = 0; h < 4; ++h) {
            const float4 qv = *(const float4*)(qp + h * 64 + d4 * 4);
            sc0[h] += qv.x * a.x + qv.y * a.y + qv.z * a.z + qv.w * a.w;
            sc1[h] += qv.x * b.x + qv.y * b.y + qv.z * b.z + qv.w * b.w;
            sc2[h] += qv.x * c.x + qv.y * c.y + qv.z * c.z + qv.w * c.w;
        }
    }
    float p0[4], p1[4], p2[4], den[4];
#pragma unroll
    for (int h = 0; h < 4; ++h) {
        const float sink = p.in[9][l * 16 + g * 4 + h];
        float m = sink;
        sc0[h] *= 0.125f; sc1[h] *= 0.125f; sc2[h] *= 0.125f;
        if (ok0) m = fmaxf(m, sc0[h]);
        if (ok1) m = fmaxf(m, sc1[h]);
        if (ok2) m = fmaxf(m, sc2[h]);
        m = wave_max(m);
        p0[h] = ok0 ? __expf(sc0[h] - m) : 0.f; p1[h] = ok1 ? __expf(sc1[h] - m) : 0.f; p2[h] = ok2 ? __expf(sc2[h] - m) : 0.f;
        den[h] = wave_sum(p0[h] + p1[h] + p2[h]) + __expf(sink - m);
    }
    float o[4] = {0.f, 0.f, 0.f, 0.f};
    {
        const float* cvb = p.in[3] + ((((size_t)l * 32 + (s - 2)) * 128) * 4 + g) * 64 + lane;
        const float* vdb = p.VD + (size_t)((s - 2) * TD) * 256 + g * 64 + lane;
        const int ncache = 128 - t;
#pragma unroll 1
        for (int j0 = 0; j0 < 128; j0 += 8) {
            float vv[8];
#pragma unroll
            for (int e = 0; e < 8; ++e) { const int j = j0 + e; vv[e] = j < ncache ? cvb[(size_t)(t + j) * 256] : vdb[(size_t)(t + j - 128) * 256]; }
#pragma unroll
            for (int e = 0; e < 8; ++e) { const int j = j0 + e, jl = j & 63;
#pragma unroll
                for (int h = 0; h < 4; ++h) { const float pj = j0 < 64 ? __shfl(p0[h], jl) : __shfl(p1[h], jl); o[h] = fmaf(pj, vv[e], o[h]); } }
        }
        { const float vv = vdb[(size_t)t * 256];
#pragma unroll
          for (int h = 0; h < 4; ++h) o[h] = fmaf(__shfl(p2[h], 0), vv, o[h]); }
    }
#pragma unroll
    for (int h = 0; h < 4; ++h) p.OAb[(size_t)r * 1024 + (g * 4 + h) * 64 + lane] = (bf16)f2bf(o[h] / den[h]);
    if (s >= 2 && t == 0) {
        const size_t b0 = ((((size_t)l * 32 + (s - 2)) * 128) * 4 + g) * 64 + lane;
#pragma unroll 1
        for (int i0 = 0; i0 < 124; i0 += 4) {
            float kk[4], vv[4];
#pragma unroll
            for (int e = 0; e < 4; ++e) { kk[e] = p.in[2][b0 + (size_t)(i0 + e + 4) * 256]; vv[e] = p.in[3][b0 + (size_t)(i0 + e + 4) * 256]; }
#pragma unroll
            for (int e = 0; e < 4; ++e) { p.out[O_SK + b0 + (size_t)(i0 + e) * 256] = kk[e]; p.out[O_SV + b0 + (size_t)(i0 + e) * 256] = vv[e]; }
        }
    }
}
__device__ __forceinline__ void gla_task(const P& p, int l, int s, int h, int sl, int lane) {
    const int dkg = lane >> 3, c = lane & 7, col = sl * 8 + c;
    const float* st = p.in[4] + ((((size_t)l * 32 + (s - 2)) * 4 + h) * 128) * 256;
    float S[16];
#pragma unroll
    for (int i = 0; i < 16; ++i) S[i] = st[(size_t)(dkg * 16 + i) * 256 + col];
    const size_t r0 = (size_t)seq_row0(s);
    f32x4v a[TD][4], k[TD][4], q[TD][4]; float v[TD], o[TD];
#pragma unroll
    for (int t = 0; t < TD; ++t) {
        const bf16* pr = p.PROJ + (r0 + t) * PP;
        v[t] = ldbf(pr + C_BV + h * 256 + col);
#pragma unroll
        for (int i4 = 0; i4 < 4; ++i4) {
            a[t][i4] = *(const f32x4v*)(p.AG + (r0 + t) * 512 + h * 128 + dkg * 16 + 4 * i4);
            k[t][i4] = ldbf4(pr + C_BK + h * 128 + dkg * 16 + 4 * i4); q[t][i4] = ldbf4(pr + C_BQ + h * 128 + dkg * 16 + 4 * i4);
        }
    }
#pragma unroll
    for (int t = 0; t < TD; ++t) {
        float ot = 0.f;
#pragma unroll
        for (int i4 = 0; i4 < 4; ++i4) {
            S[4 * i4 + 0] = fmaf(S[4 * i4 + 0], __expf(a[t][i4].x), k[t][i4].x * v[t]); ot = fmaf(q[t][i4].x, S[4 * i4 + 0], ot);
            S[4 * i4 + 1] = fmaf(S[4 * i4 + 1], __expf(a[t][i4].y), k[t][i4].y * v[t]); ot = fmaf(q[t][i4].y, S[4 * i4 + 1], ot);
            S[4 * i4 + 2] = fmaf(S[4 * i4 + 2], __expf(a[t][i4].z), k[t][i4].z * v[t]); ot = fmaf(q[t][i4].z, S[4 * i4 + 2], ot);
            S[4 * i4 + 3] = fmaf(S[4 * i4 + 3], __expf(a[t][i4].w), k[t][i4].w * v[t]); ot = fmaf(q[t][i4].w, S[4 * i4 + 3], ot);
        }
        ot += __shfl_xor(ot, 8); ot += __shfl_xor(ot, 16); ot += __shfl_xor(ot, 32);
        o[t] = ot * 0.08838834764831845f;
    }
    if (dkg == 0) {
#pragma unroll
        for (int t = 0; t < TD; ++t) p.OBRAW[(r0 + t) * 1024 + h * 256 + col] = o[t];
    }
    float* so = p.out + O_SGLA + ((((size_t)l * 32 + (s - 2)) * 4 + h) * 128) * 256;
#pragma unroll
    for (int i = 0; i < 16; ++i) so[(size_t)(dkg * 16 + i) * 256 + col] = S[i];
}
__device__ __forceinline__ void delta_task(const P& p, int l, int s, int h, int sl, int lane) {
    const int dkg = lane >> 3, c = lane & 7, col = sl * 8 + c;
    const float* st = p.in[5] + ((((size_t)l * 32 + (s - 2)) * 8 + h) * 128) * 128;
    float S[16];
#pragma unroll
    for (int i = 0; i < 16; ++i) S[i] = st[(size_t)(dkg * 16 + i) * 128 + col];
    const size_t r0 = (size_t)seq_row0(s);
    f32x4v k[TD][4], q[TD][4]; float v[TD], g[TD], be[TD], o[TD];
#pragma unroll
    for (int t = 0; t < TD; ++t) {
        const float* dq = p.DQKV + (r0 + t) * 3072 + h * 128 + dkg * 16;
        v[t] = dq[2048 - dkg * 16 + col]; g[t] = p.G[(r0 + t) * 8 + h]; be[t] = p.BETA[(r0 + t) * 8 + h];
#pragma unroll
        for (int i4 = 0; i4 < 4; ++i4) { q[t][i4] = *(const f32x4v*)(dq + 4 * i4); k[t][i4] = *(const f32x4v*)(dq + 1024 + 4 * i4); }
    }
#pragma unroll
    for (int t = 0; t < TD; ++t) {
        const float a = __expf(g[t]);
        float kS = 0.f, qS = 0.f, qk = 0.f;
#pragma unroll
        for (int i4 = 0; i4 < 4; ++i4)
#pragma unroll
            for (int e = 0; e < 4; ++e) { kS = fmaf(k[t][i4][e], S[4 * i4 + e], kS); qS = fmaf(q[t][i4][e], S[4 * i4 + e], qS); qk = fmaf(q[t][i4][e], k[t][i4][e], qk); }
        kS += __shfl_xor(kS, 8); kS += __shfl_xor(kS, 16); kS += __shfl_xor(kS, 32);
        qS += __shfl_xor(qS, 8); qS += __shfl_xor(qS, 16); qS += __shfl_xor(qS, 32);
        qk += __shfl_xor(qk, 8); qk += __shfl_xor(qk, 16); qk += __shfl_xor(qk, 32);
        const float u = be[t] * (v[t] - a * kS);
#pragma unroll
        for (int i4 = 0; i4 < 4; ++i4)
#pragma unroll
            for (int e = 0; e < 4; ++e) S[4 * i4 + e] = fmaf(a, S[4 * i4 + e], k[t][i4][e] * u);
        o[t] = a * qS + qk * u;
    }
    if (dkg == 0) {
#pragma unroll
        for (int t = 0; t < TD; ++t) p.OCRAW[(r0 + t) * 1024 + h * 128 + col] = o[t];
    }
    float* so = p.out + O_SDELTA + ((((size_t)l * 32 + (s - 2)) * 8 + h) * 128) * 128;
#pragma unroll
    for (int i = 0; i < 16; ++i) so[(size_t)(dkg * 16 + i) * 128 + col] = S[i];
}
__device__ __forceinline__ void scan_task(const P& p, int l, int task, int lane) {
    if (task < 256) { gla_task(p, l, task >> 7, (task >> 5) & 3, task & 31, lane); return; }
    task -= 256;
    if (task < 256) { delta_task(p, l, task >> 7, (task >> 4) & 7, task & 15, lane); return; }
    task -= 256;
    if (task < 4096) { gla_task(p, l, 2 + (task >> 7), (task >> 5) & 3, task & 31, lane); return; }
    task -= 4096;
    delta_task(p, l, 2 + (task >> 7), (task >> 4) & 7, task & 15, lane);
}
constexpr int N_SCAN_TASKS = 512 + 8192;

constexpr int CH = 64, NCH = TP / CH;
__device__ __forceinline__ f32x16 mma32(bf16x8 a, bf16x8 b, f32x16 c) { return __builtin_amdgcn_mfma_f32_32x32x16_bf16(a, b, c, 0, 0, 0); }
__device__ __forceinline__ int acc_row(int reg, int hh) { return (reg & 3) + 8 * (reg >> 2) + 4 * hh; }
__device__ __forceinline__ f32x16 zero16() { f32x16 z;
#pragma unroll
    for (int i = 0; i < 16; ++i) z[i] = 0.f;
    return z; }
__device__ __forceinline__ float bf2f(unsigned b) { return __builtin_bit_cast(float, b << 16); }
#define LDS_WAIT() asm volatile("s_waitcnt lgkmcnt(0)" ::: "memory")


__device__ __forceinline__ void attn_prompt_task(const P& p, int l, int s, int qb, int h, LAS unsigned char* ldsw, int lane) {
    LAS bf16* PT = (LAS bf16*)ldsw;
    const int r = lane & 31, hh = lane >> 5, g = h >> 2, q0 = 32 * qb;
    bf16x8 qf[4];
#pragma unroll
    for (int ks = 0; ks < 4; ++ks) qf[ks] = *(const bf16x8*)(p.QB16 + (size_t)(s * TP + q0 + r) * 1024 + h * 64 + 16 * ks + 8 * hh);
    f32x16 st[5];
#pragma unroll
    for (int kt = 0; kt < 5; ++kt) {
        int pk = q0 - 128 + 32 * kt + r; pk = pk < 0 ? 0 : pk;
        st[kt] = zero16();
#pragma unroll
        for (int ks = 0; ks < 4; ++ks) { const bf16x8 kf = *(const bf16x8*)(p.KB16 + (size_t)(s * TP + pk) * 256 + g * 64 + 16 * ks + 8 * hh); st[kt] = mma32(kf, qf[ks], st[kt]); }
    }
    const float sink = p.in[9][l * 16 + h];
    float m = sink;
#pragma unroll
    for (int kt = 0; kt < 5; ++kt)
#pragma unroll
        for (int reg = 0; reg < 16; ++reg) {
            const int kk = 32 * kt + acc_row(reg, hh);
            const bool valid = (kk >= r) && (kk <= r + 128) && (q0 - 128 + kk >= 0);
            const float v = valid ? st[kt][reg] * 0.125f : -3.0e38f;
            st[kt][reg] = v; m = fmaxf(m, v);
        }
    m = fmaxf(m, __shfl_xor(m, 32));
    float sum = 0.f;
#pragma unroll
    for (int kt = 0; kt < 5; ++kt)
#pragma unroll
        for (int reg = 0; reg < 16; ++reg) { const float e = st[kt][reg] > -1.0e38f ? __expf(st[kt][reg] - m) : 0.f; st[kt][reg] = e; sum += e; }
    sum += __shfl_xor(sum, 32);
    const float inv = 1.f / (sum + __expf(sink - m));
    f32x16 o[2]; o[0] = zero16(); o[1] = zero16();
#pragma unroll
    for (int kt = 0; kt < 5; ++kt) {
#pragma unroll
        for (int gq = 0; gq < 4; ++gq) { u32x2v w; w.x = pk2(st[kt][4 * gq], st[kt][4 * gq + 1]); w.y = pk2(st[kt][4 * gq + 2], st[kt][4 * gq + 3]); *(LAS u32x2v*)(PT + r * 40 + 8 * gq + 4 * hh) = w; }
        LDS_WAIT();
#pragma unroll
        for (int ks = 0; ks < 2; ++ks) {
            const bf16x8 pf = *(const LAS bf16x8*)(PT + r * 40 + 16 * ks + 8 * hh);
            int p0 = q0 - 128 + 32 * kt + 16 * ks + 8 * hh; p0 = p0 < 0 ? 0 : p0;
#pragma unroll
            for (int dt = 0; dt < 2; ++dt) { const bf16x8 vf = *(const bf16x8*)(p.VT16 + ((size_t)(s * 4 + g) * 64 + 32 * dt + r) * TP + p0); o[dt] = mma32(vf, pf, o[dt]); }
        }
        LDS_WAIT();
    }
#pragma unroll
    for (int dt = 0; dt < 2; ++dt)
#pragma unroll
        for (int gq = 0; gq < 4; ++gq) { u32x2v w; w.x = pk2(o[dt][4 * gq] * inv, o[dt][4 * gq + 1] * inv); w.y = pk2(o[dt][4 * gq + 2] * inv, o[dt][4 * gq + 3] * inv);
            *(u32x2v*)(p.OAb + (size_t)(s * TP + q0 + r) * 1024 + h * 64 + 32 * dt + 8 * gq + 4 * hh) = w; }
}
__device__ __forceinline__ void vt_task(const P& p, int task, LAS unsigned char* ldsw, int lane) {
    const int s = task >> 8, n = (task >> 2) & 63, g = task & 3, r0 = s * TP + n * CH;
    LAS bf16* tile = (LAS bf16*)ldsw;
    { bf16 vv[64];
#pragma unroll
      for (int t = 0; t < 64; ++t) vv[t] = p.PROJ[(size_t)(r0 + t) * PP + C_AV + g * 64 + lane];
#pragma unroll
      for (int t = 0; t < 64; ++t) tile[t * 66 + lane] = vv[t]; }
    LDS_WAIT();
#pragma unroll
    for (int tg = 0; tg < 8; ++tg) { u32x4v w;
        w.x = (unsigned)tile[(8 * tg + 0) * 66 + lane] | ((unsigned)tile[(8 * tg + 1) * 66 + lane] << 16); w.y = (unsigned)tile[(8 * tg + 2) * 66 + lane] | ((unsigned)tile[(8 * tg + 3) * 66 + lane] << 16);
        w.z = (unsigned)tile[(8 * tg + 4) * 66 + lane] | ((unsigned)tile[(8 * tg + 5) * 66 + lane] << 16); w.w = (unsigned)tile[(8 * tg + 6) * 66 + lane] | ((unsigned)tile[(8 * tg + 7) * 66 + lane] << 16);
        *(u32x4v*)(p.VT16 + ((size_t)(s * 4 + g) * 64 + lane) * TP + n * CH + 8 * tg) = w; }
    LDS_WAIT();
}

__device__ __forceinline__ void gla_prepass(const P& p, int ch, LAS unsigned char* lds, int tid) {
    const int s = ch >> 8, n = (ch >> 2) & 63, h = ch & 3, r0 = s * TP + n * CH;
    LAS bf16* QTs = (LAS bf16*)lds;
    LAS bf16* KTs = (LAS bf16*)(lds + 17408);
    LAS bf16* VTs = (LAS bf16*)(lds + 34816);
    LAS bf16* As = (LAS bf16*)(lds + 71680);
    LAS float* PART = (LAS float*)(lds + 80896);
    const int lane = tid & 63, wave = tid >> 6;
    {
        const int dk = tid & 127, part = tid >> 7;
        float gl[16]; bf16 qr[16], kr[16], vr[32]; float sum = 0.f;
#pragma unroll
        for (int i = 0; i < 16; ++i) gl[i] = p.AG[(size_t)(r0 + part * 16 + i) * 512 + h * 128 + dk];
#pragma unroll
        for (int i = 0; i < 16; ++i) { const bf16* pr = p.PROJ + (size_t)(r0 + part * 16 + i) * PP; qr[i] = pr[C_BQ + h * 128 + dk]; kr[i] = pr[C_BK + h * 128 + dk]; }
#pragma unroll
        for (int i = 0; i < 32; ++i) { const int e = tid + 512 * i, t = e >> 8, dv = e & 255; vr[i] = p.PROJ[(size_t)(r0 + t) * PP + C_BV + h * 256 + dv]; }
#pragma unroll
        for (int i = 0; i < 16; ++i) sum += gl[i];
        PART[part * 128 + dk] = sum;
        __syncthreads();
        float pre = 0.f, tot = 0.f;
#pragma unroll
        for (int pp = 0; pp < 4; ++pp) { const float v = PART[pp * 128 + dk]; tot += v; pre += pp < part ? v : 0.f; }
        float b = pre;
#pragma unroll
        for (int i = 0; i < 16; ++i) {
            const int t = part * 16 + i; b += gl[i];
            const float q = bf2f(qr[i]), k = bf2f(kr[i]);
            QTs[t * 136 + dk] = (bf16)f2bf(q * 0.08838834764831845f * __expf(b));
            KTs[t * 136 + dk] = (bf16)f2bf(k * __expf(-b));
        }
        if (part == 0) p.GDEC[(size_t)ch * 128 + dk] = __expf(tot);
#pragma unroll
        for (int i = 0; i < 32; ++i) { const int e = tid + 512 * i, t = e >> 8, dv = e & 255; VTs[dv * 72 + t] = vr[i]; }
    }
    __syncthreads();
#pragma unroll
    for (int i = 0; i < 2; ++i) { const int c = tid + 512 * i, t = c >> 4, c8 = (c & 15) * 8; *(u32x4v*)(p.GQT + ((size_t)ch * 64 + t) * 128 + c8) = *(const LAS u32x4v*)(QTs + t * 136 + c8); }
#pragma unroll
    for (int i = 0; i < 2; ++i) { const int c = tid + 512 * i, dk = c & 127, tg = c >> 7; uint4 w;
        w.x = (unsigned)KTs[(8 * tg + 0) * 136 + dk] | ((unsigned)KTs[(8 * tg + 1) * 136 + dk] << 16); w.y = (unsigned)KTs[(8 * tg + 2) * 136 + dk] | ((unsigned)KTs[(8 * tg + 3) * 136 + dk] << 16);
        w.z = (unsigned)KTs[(8 * tg + 4) * 136 + dk] | ((unsigned)KTs[(8 * tg + 5) * 136 + dk] << 16); w.w = (unsigned)KTs[(8 * tg + 6) * 136 + dk] | ((unsigned)KTs[(8 * tg + 7) * 136 + dk] << 16);
        *(uint4*)(p.GKT + ((size_t)ch * 128 + dk) * 64 + 8 * tg) = w; }
#pragma unroll
    for (int i = 0; i < 4; ++i) { const int c = tid + 512 * i, dv = c >> 3, tg = c & 7; *(u32x4v*)(p.GVT + ((size_t)ch * 256 + dv) * 64 + 8 * tg) = *(const LAS u32x4v*)(VTs + dv * 72 + 8 * tg); }
    if (wave < 4) {
        const int ti = wave >> 1, tj = wave & 1, r = lane & 31, hh = lane >> 5;
        f32x16 acc = zero16();
        if (!(ti == 0 && tj == 1)) {
#pragma unroll
            for (int ks = 0; ks < 8; ++ks) {
                const bf16x8 a = *(const LAS bf16x8*)(QTs + (32 * ti + r) * 136 + 16 * ks + 8 * hh);
                const bf16x8 b = *(const LAS bf16x8*)(KTs + (32 * tj + r) * 136 + 16 * ks + 8 * hh);
                acc = mma32(a, b, acc);
            }
        }
#pragma unroll
        for (int reg = 0; reg < 16; ++reg) { const int tr = 32 * ti + acc_row(reg, hh), sc = 32 * tj + r; As[tr * 72 + sc] = (bf16)f2bf(tr >= sc ? acc[reg] : 0.f); }
    }
    __syncthreads();
    { const int t = tid >> 3, c8 = (tid & 7) * 8; *(u32x4v*)(p.GA + ((size_t)ch * 64 + t) * 64 + c8) = *(const LAS u32x4v*)(As + t * 72 + c8); }
    __syncthreads();
}

#define DMA16(gptr, lptr) __builtin_amdgcn_global_load_lds((const unsigned*)(gptr), (LAS unsigned*)(lptr), 16, 0, 0)
#define VM_WAIT_N(n) asm volatile("s_waitcnt vmcnt(" #n ")" ::: "memory")
#define FRAG16(buf, f, lane) (*(const LAS bf16x8*)((buf) + (f) * 1024 + (lane) * 16))
#define FRAGF4(buf, f, lane) (*(const LAS f32x4v*)((buf) + (f) * 1024 + (lane) * 16))
#ifndef SCAN_LOADERS
#define SCAN_LOADERS 1
#endif
constexpr int SCAN_FLAGS_OFF = 13312;
template <bool SLEEP = false> __device__ __forceinline__ bool lds_wait_ge(volatile LAS unsigned* w, unsigned need, volatile LAS unsigned* abortw) {
    unsigned sp = 0; bool ok = true;
    while (*w < need) { if (SLEEP) __builtin_amdgcn_s_sleep(1); if ((++sp & 1023u) == 0u) { if (*abortw != 0u) { ok = false; break; } if (sp > (1u << 22)) { *abortw = 1u; ok = false; break; } } }
    __builtin_amdgcn_fence(__ATOMIC_ACQUIRE, "workgroup");
    asm volatile("" ::: "memory");
    return ok;
}
__device__ __forceinline__ void gla_issue_A_half(const P& p, int ch, int sl, LAS unsigned char* bufA, int r, int hh, int ti) {
    if (ti == 0) {
#pragma unroll
        for (int ks = 0; ks < 4; ++ks) DMA16(p.GVT + ((size_t)ch * 256 + 32 * sl + r) * 64 + 16 * ks + 8 * hh, bufA + ks * 1024);
    }
#pragma unroll
    for (int ks = 0; ks < 8; ++ks) DMA16(p.GQT + ((size_t)ch * 64 + 32 * ti + r) * 128 + 16 * ks + 8 * hh, bufA + (4 + ti * 8 + ks) * 1024);
#pragma unroll
    for (int ks = 0; ks < 4; ++ks) DMA16(p.GA + ((size_t)ch * 64 + 32 * ti + r) * 64 + 16 * ks + 8 * hh, bufA + (20 + ti * 4 + ks) * 1024);
}
__device__ __forceinline__ void delta_issue_A_half(const P& p, int ch, int sl, LAS unsigned char* bufA, int r, int hh, int ti) {
#pragma unroll
    for (int ks = 0; ks < 8; ++ks) {
        DMA16(p.DNW + ((size_t)ch * 64 + 32 * ti + r) * 128 + 16 * ks + 8 * hh, bufA + (ti * 8 + ks) * 1024);
        DMA16(p.DQD + ((size_t)ch * 64 + 32 * ti + r) * 128 + 16 * ks + 8 * hh, bufA + (16 + ti * 8 + ks) * 1024);
    }
#pragma unroll
    for (int g = 0; g < 4; ++g) DMA16(p.DUB + ((size_t)ch * 128 + 32 * sl + r) * 64 + 32 * ti + 8 * g + 4 * hh, bufA + (32 + ti * 4 + g) * 1024);
}
__device__ __forceinline__ void gla_issue_A(const P& p, int ch, int sl, LAS unsigned char* bufA, int r, int hh) {
#pragma unroll
    for (int ks = 0; ks < 4; ++ks) DMA16(p.GVT + ((size_t)ch * 256 + 32 * sl + r) * 64 + 16 * ks + 8 * hh, bufA + ks * 1024);
#pragma unroll
    for (int ti = 0; ti < 2; ++ti)
#pragma unroll
        for (int ks = 0; ks < 8; ++ks) DMA16(p.GQT + ((size_t)ch * 64 + 32 * ti + r) * 128 + 16 * ks + 8 * hh, bufA + (4 + ti * 8 + ks) * 1024);
#pragma unroll
    for (int ti = 0; ti < 2; ++ti)
#pragma unroll
        for (int ks = 0; ks < 4; ++ks) DMA16(p.GA + ((size_t)ch * 64 + 32 * ti + r) * 64 + 16 * ks + 8 * hh, bufA + (20 + ti * 4 + ks) * 1024);
}
__device__ __forceinline__ void gla_issue_B(const P& p, int ch, LAS unsigned char* bufB, int r, int hh) {
#pragma unroll
    for (int d = 0; d < 4; ++d)
#pragma unroll
        for (int ks = 0; ks < 4; ++ks) DMA16(p.GKT + ((size_t)ch * 128 + 32 * d + r) * 64 + 16 * ks + 8 * hh, bufB + (d * 4 + ks) * 1024);
#pragma unroll
    for (int d = 0; d < 4; ++d)
#pragma unroll
        for (int g = 0; g < 4; ++g) DMA16(p.GDEC + (size_t)ch * 128 + 32 * d + 8 * g + 4 * hh, bufB + (16 + d * 4 + g) * 1024);
}
__device__ __forceinline__ void gla_scan_task(const P& p, int l, int s, int h, int sl, LAS unsigned char* ldsw, int lane) {
    LAS bf16* ST = (LAS bf16*)ldsw;
    LAS unsigned char* bufA = ldsw + 16384; LAS unsigned char* bufB = ldsw + 16384 + 28 * 1024;
    const int r = lane & 31, hh = lane >> 5;
    f32x16 S[4];
#pragma unroll
    for (int d = 0; d < 4; ++d) S[d] = zero16();
    volatile LAS unsigned* FL = (volatile LAS unsigned*)(ldsw + SCAN_FLAGS_OFF);
    if (!SCAN_LOADERS) { const int ch0 = (s * 64 + 0) * 4 + h; gla_issue_A(p, ch0, sl, bufA, r, hh); gla_issue_B(p, ch0, bufB, r, hh); }
#pragma unroll 1
    for (int n = 0; n < NCH; ++n) {
        const int r0 = s * TP + n * CH;
        const int chn = (s * 64 + (n + 1 < NCH ? n + 1 : n)) * 4 + h;
#pragma unroll
        for (int d = 0; d < 4; ++d)
#pragma unroll
            for (int g = 0; g < 4; ++g) { u32x2v w; w.x = pk2(S[d][4 * g], S[d][4 * g + 1]); w.y = pk2(S[d][4 * g + 2], S[d][4 * g + 3]); *(LAS u32x2v*)(ST + r * 136 + 32 * d + 8 * g + 4 * hh) = w; }
        if (SCAN_LOADERS) { LDS_WAIT(); lds_wait_ge(FL + 0, (unsigned)n + 1u, FL + 5); lds_wait_ge(FL + 1, (unsigned)n + 1u, FL + 5); }
        else { VM_WAIT_N(32); LDS_WAIT(); }
        bf16x8 vb[4];
#pragma unroll
        for (int ks = 0; ks < 4; ++ks) vb[ks] = FRAG16(bufA, ks, lane);
#pragma unroll
        for (int ti = 0; ti < 2; ++ti) {
            f32x16 o = zero16();
#pragma unroll
            for (int ks = 0; ks < 8; ++ks) { const bf16x8 b = *(const LAS bf16x8*)(ST + r * 136 + 16 * ks + 8 * hh); o = mma32(FRAG16(bufA, 4 + ti * 8 + ks, lane), b, o); }
#pragma unroll
            for (int ks = 0; ks < 4; ++ks) o = mma32(FRAG16(bufA, 20 + ti * 4 + ks, lane), vb[ks], o);
#pragma unroll
            for (int reg = 0; reg < 16; ++reg) p.OBRAW[(size_t)(r0 + 32 * ti + acc_row(reg, hh)) * 1024 + h * 256 + 32 * sl + r] = o[reg];
        }
        LDS_WAIT();
        if (SCAN_LOADERS) { if (lane == 0) FL[3] = (unsigned)n + 1u; lds_wait_ge(FL + 2, (unsigned)n + 1u, FL + 5); }
        else { gla_issue_A(p, chn, sl, bufA, r, hh); VM_WAIT_N(28); }
#pragma unroll
        for (int d = 0; d < 4; ++d) {
#pragma unroll
            for (int ks = 0; ks < 4; ++ks) S[d] = mma32(FRAG16(bufB, d * 4 + ks, lane), vb[ks], S[d]);
#pragma unroll
            for (int g = 0; g < 4; ++g) { const f32x4v dc = FRAGF4(bufB, 16 + d * 4 + g, lane); S[d][4 * g] *= dc.x; S[d][4 * g + 1] *= dc.y; S[d][4 * g + 2] *= dc.z; S[d][4 * g + 3] *= dc.w; }
        }
        LDS_WAIT();
        if (SCAN_LOADERS) { if (lane == 0) FL[4] = (unsigned)n + 1u; } else gla_issue_B(p, chn, bufB, r, hh);
    }
    VM_WAIT_N(0);
    float* so = p.out + O_PGLA + ((((size_t)l * 2 + s) * 4 + h) * 128) * 256;
#pragma unroll
    for (int d = 0; d < 4; ++d)
#pragma unroll
        for (int reg = 0; reg < 16; ++reg) so[(size_t)(32 * d + acc_row(reg, hh)) * 256 + 32 * sl + r] = S[d][reg];
}

__device__ __forceinline__ void delta_prepass(const P& p, int ch, bool active, LAS unsigned char* ldsh, int t256) {
    const int s = ch >> 9, n = (ch >> 3) & 63, h = ch & 7, r0 = s * TP + n * CH;
    LAS bf16* Kh = (LAS bf16*)ldsh;
    LAS bf16* Kl = (LAS bf16*)(ldsh + 17408);
    LAS float* Lm = (LAS float*)(ldsh + 34816);
    LAS float* GH = (LAS float*)(ldsh + 51200);
    LAS float* BE = GH + 64;
    const int lane = t256 & 63, w4 = t256 >> 6, r = lane & 31, hh = lane >> 5;
    const int ti = w4 >> 1, tj = w4 & 1;
    const int j = t256;
    const bool isw = j >= 128;
    float x[64];
    if (active) {
        const float* src = p.DQKV + (size_t)r0 * 3072 + (isw ? 1024 + h * 128 + (j - 128) : 2048 + h * 128 + j);
#pragma unroll
        for (int c = 0; c < 64; ++c) x[c] = src[(size_t)c * 3072];
        if (w4 == 0) {
            float g = p.G[(size_t)(r0 + lane) * 8 + h];
#pragma unroll
            for (int o = 1; o < 64; o <<= 1) { const float y = __shfl_up(g, o); g += lane >= o ? y : 0.f; }
            GH[lane] = g; BE[lane] = p.BETA[(size_t)(r0 + lane) * 8 + h];
            if (lane >= 60) p.DDEC[(size_t)ch * 4 + (lane - 60)] = __expf(__shfl(g, 63));
        }
#pragma unroll
        for (int i = 0; i < 8; ++i) { const int e = t256 + 256 * i, t = e >> 5, dk = (e & 31) * 4;
            const f32x4v kf = *(const f32x4v*)(p.DQKV + (size_t)(r0 + t) * 3072 + 1024 + h * 128 + dk);
            const unsigned h0 = f2bf(kf.x), h1 = f2bf(kf.y), h2 = f2bf(kf.z), h3 = f2bf(kf.w);
            u32x2v wh, wl; wh.x = h0 | (h1 << 16); wh.y = h2 | (h3 << 16);
            wl.x = f2bf(kf.x - bf2f(h0)) | (f2bf(kf.y - bf2f(h1)) << 16); wl.y = f2bf(kf.z - bf2f(h2)) | (f2bf(kf.w - bf2f(h3)) << 16);
            *(LAS u32x2v*)(Kh + t * 136 + dk) = wh; *(LAS u32x2v*)(Kl + t * 136 + dk) = wl; }
    }
    __syncthreads();
    if (active) {
        f32x16 acc = zero16();
        if (!(ti == 0 && tj == 1)) {
#pragma unroll
            for (int ks = 0; ks < 8; ++ks) {
                const bf16x8 ah = *(const LAS bf16x8*)(Kh + (32 * ti + r) * 136 + 16 * ks + 8 * hh), al = *(const LAS bf16x8*)(Kl + (32 * ti + r) * 136 + 16 * ks + 8 * hh);
                const bf16x8 bh = *(const LAS bf16x8*)(Kh + (32 * tj + r) * 136 + 16 * ks + 8 * hh), bl = *(const LAS bf16x8*)(Kl + (32 * tj + r) * 136 + 16 * ks + 8 * hh);
                acc = mma32(ah, bh, acc); acc = mma32(ah, bl, acc); acc = mma32(al, bh, acc);
            }
        }
#pragma unroll
        for (int reg = 0; reg < 16; ++reg) { const int c = 32 * ti + acc_row(reg, hh), sc = 32 * tj + r;
            Lm[c * 64 + sc] = c > sc ? BE[c] * acc[reg] * __expf(GH[c] - GH[sc]) : 0.f; }
    }
    __syncthreads();
    if (active) {
#pragma unroll
        for (int i = 0; i < 8; ++i) { const int e = t256 + 256 * i, t = e >> 5, dk = (e & 31) * 4;
            const f32x4v qv = *(const f32x4v*)(p.DQKV + (size_t)(r0 + t) * 3072 + h * 128 + dk); const float eg = __expf(GH[t]);
            u32x2v wq, wd; wq.x = f2bf(qv.x) | (f2bf(qv.y) << 16); wq.y = f2bf(qv.z) | (f2bf(qv.w) << 16);
            wd.x = f2bf(qv.x * eg) | (f2bf(qv.y * eg) << 16); wd.y = f2bf(qv.z * eg) | (f2bf(qv.w * eg) << 16);
            *(LAS u32x2v*)(Kl + t * 136 + dk) = wq; *(u32x2v*)(p.DQD + ((size_t)ch * 64 + t) * 128 + dk) = wd; }
#pragma unroll
        for (int c = 0; c < 64; ++c) { float m = BE[c]; if (isw) m *= __expf(GH[c]); x[c] *= m; }
#pragma unroll
        for (int c = 1; c < 64; ++c) {
            asm volatile("" ::: "memory");
            float acc = x[c];
#pragma unroll
            for (int s4 = 0; s4 < (c + 3) / 4; ++s4) { const f32x4v L4 = *(const LAS f32x4v*)(Lm + c * 64 + 4 * s4);
                acc = fmaf(-L4.x, x[4 * s4], acc);
                if (4 * s4 + 1 < c) acc = fmaf(-L4.y, x[4 * s4 + 1], acc);
                if (4 * s4 + 2 < c) acc = fmaf(-L4.z, x[4 * s4 + 2], acc);
                if (4 * s4 + 3 < c) acc = fmaf(-L4.w, x[4 * s4 + 3], acc); }
            x[c] = acc;
        }
        if (j < 128) {
#pragma unroll
            for (int c4 = 0; c4 < 16; ++c4) { f32x4v w; w.x = x[4 * c4]; w.y = x[4 * c4 + 1]; w.z = x[4 * c4 + 2]; w.w = x[4 * c4 + 3]; *(f32x4v*)(p.DUB + ((size_t)ch * 128 + j) * 64 + 4 * c4) = w; }
        } else {
#pragma unroll
            for (int c = 0; c < 64; ++c) p.DNW[((size_t)ch * 64 + c) * 128 + (j - 128)] = (bf16)f2bf(-x[c]);
        }
    }
    __syncthreads();
    if (active) {
        f32x16 acc = zero16();
        if (!(ti == 0 && tj == 1)) {
#pragma unroll
            for (int ks = 0; ks < 8; ++ks) {
                const bf16x8 a = *(const LAS bf16x8*)(Kl + (32 * ti + r) * 136 + 16 * ks + 8 * hh);
                const bf16x8 b = *(const LAS bf16x8*)(Kh + (32 * tj + r) * 136 + 16 * ks + 8 * hh);
                acc = mma32(a, b, acc);
            }
        }
#pragma unroll
        for (int reg = 0; reg < 16; ++reg) { const int c = 32 * ti + acc_row(reg, hh), sc = 32 * tj + r;
            p.DAQK[((size_t)ch * 64 + c) * 64 + sc] = (bf16)f2bf(c >= sc ? acc[reg] * __expf(GH[c] - GH[sc]) : 0.f); }
        const float glast = GH[63];
#pragma unroll
        for (int i = 0; i < 4; ++i) { const int c = t256 + 256 * i, dk = c & 127, tg = c >> 7; float v[8];
#pragma unroll
            for (int e = 0; e < 8; ++e) v[e] = p.DQKV[(size_t)(r0 + 8 * tg + e) * 3072 + 1024 + h * 128 + dk] * __expf(glast - GH[8 * tg + e]);
            uint4 w; w.x = pk2(v[0], v[1]); w.y = pk2(v[2], v[3]); w.z = pk2(v[4], v[5]); w.w = pk2(v[6], v[7]);
            *(uint4*)(p.DKE + ((size_t)ch * 128 + dk) * 64 + 8 * tg) = w; }
    }
    __syncthreads();
}

__device__ __forceinline__ void delta_issue_A(const P& p, int ch, int sl, LAS unsigned char* bufA, int r, int hh) {
#pragma unroll
    for (int ti = 0; ti < 2; ++ti)
#pragma unroll
        for (int ks = 0; ks < 8; ++ks) {
            DMA16(p.DNW + ((size_t)ch * 64 + 32 * ti + r) * 128 + 16 * ks + 8 * hh, bufA + (ti * 8 + ks) * 1024);
            DMA16(p.DQD + ((size_t)ch * 64 + 32 * ti + r) * 128 + 16 * ks + 8 * hh, bufA + (16 + ti * 8 + ks) * 1024);
        }
#pragma unroll
    for (int ti = 0; ti < 2; ++ti)
#pragma unroll
        for (int g = 0; g < 4; ++g) DMA16(p.DUB + ((size_t)ch * 128 + 32 * sl + r) * 64 + 32 * ti + 8 * g + 4 * hh, bufA + (32 + ti * 4 + g) * 1024);
}
__device__ __forceinline__ void delta_issue_B(const P& p, int ch, LAS unsigned char* bufB, int r, int hh) {
#pragma unroll
    for (int ti = 0; ti < 2; ++ti)
#pragma unroll
        for (int ks = 0; ks < 4; ++ks) DMA16(p.DAQK + ((size_t)ch * 64 + 32 * ti + r) * 64 + 16 * ks + 8 * hh, bufB + (ti * 4 + ks) * 1024);
#pragma unroll
    for (int d = 0; d < 4; ++d)
#pragma unroll
        for (int ks = 0; ks < 4; ++ks) DMA16(p.DKE + ((size_t)ch * 128 + 32 * d + r) * 64 + 16 * ks + 8 * hh, bufB + (8 + d * 4 + ks) * 1024);
}
__device__ __forceinline__ void delta_scan_task(const P& p, int l, int s, int h, int sl, LAS unsigned char* ldsw, int lane) {
    LAS bf16* ST = (LAS bf16*)ldsw; LAS bf16* UT = (LAS bf16*)(ldsw + 8704);
    LAS unsigned char* bufA = ldsw + 16384; LAS unsigned char* bufB = ldsw + 16384 + 40 * 1024;
    const int r = lane & 31, hh = lane >> 5;
    f32x16 S[4];
#pragma unroll
    for (int d = 0; d < 4; ++d) S[d] = zero16();
    const float dec_all = p.DDEC[(size_t)((s * 64 + lane) * 8 + h) * 4];
    volatile LAS unsigned* FL = (volatile LAS unsigned*)(ldsw + SCAN_FLAGS_OFF);
    if (!SCAN_LOADERS) { const int ch0 = (s * 64 + 0) * 8 + h; delta_issue_A(p, ch0, sl, bufA, r, hh); delta_issue_B(p, ch0, bufB, r, hh); }
#pragma unroll 1
    for (int n = 0; n < NCH; ++n) {
        const int r0 = s * TP + n * CH;
        const int chn = (s * 64 + (n + 1 < NCH ? n + 1 : n)) * 8 + h;
#pragma unroll
        for (int d = 0; d < 4; ++d)
#pragma unroll
            for (int g = 0; g < 4; ++g) { u32x2v w; w.x = pk2(S[d][4 * g], S[d][4 * g + 1]); w.y = pk2(S[d][4 * g + 2], S[d][4 * g + 3]); *(LAS u32x2v*)(ST + r * 136 + 32 * d + 8 * g + 4 * hh) = w; }
        const float dec = __builtin_bit_cast(float, __builtin_amdgcn_readlane(__builtin_bit_cast(int, dec_all), n));
        if (SCAN_LOADERS) { LDS_WAIT(); lds_wait_ge(FL + 0, (unsigned)n + 1u, FL + 5); lds_wait_ge(FL + 1, (unsigned)n + 1u, FL + 5); }
        else { VM_WAIT_N(24); LDS_WAIT(); }
        f32x16 u[2], o[2];
#pragma unroll
        for (int ti = 0; ti < 2; ++ti) {
#pragma unroll
            for (int g = 0; g < 4; ++g) { const f32x4v ub4 = FRAGF4(bufA, 32 + ti * 4 + g, lane); u[ti][4 * g] = ub4.x; u[ti][4 * g + 1] = ub4.y; u[ti][4 * g + 2] = ub4.z; u[ti][4 * g + 3] = ub4.w; }
            o[ti] = zero16();
#pragma unroll
            for (int ks = 0; ks < 8; ++ks) {
                const bf16x8 b = *(const LAS bf16x8*)(ST + r * 136 + 16 * ks + 8 * hh);
                u[ti] = mma32(FRAG16(bufA, ti * 8 + ks, lane), b, u[ti]); o[ti] = mma32(FRAG16(bufA, 16 + ti * 8 + ks, lane), b, o[ti]);
            }
        }
#pragma unroll
        for (int ti = 0; ti < 2; ++ti)
#pragma unroll
            for (int g = 0; g < 4; ++g) { u32x2v w; w.x = pk2(u[ti][4 * g], u[ti][4 * g + 1]); w.y = pk2(u[ti][4 * g + 2], u[ti][4 * g + 3]); *(LAS u32x2v*)(UT + r * 72 + 32 * ti + 8 * g + 4 * hh) = w; }
        LDS_WAIT();
        if (SCAN_LOADERS) { if (lane == 0) FL[3] = (unsigned)n + 1u; lds_wait_ge(FL + 2, (unsigned)n + 1u, FL + 5); }
        else { delta_issue_A(p, chn, sl, bufA, r, hh); VM_WAIT_N(40); }
        bf16x8 ub[4];
#pragma unroll
        for (int ks = 0; ks < 4; ++ks) ub[ks] = *(const LAS bf16x8*)(UT + r * 72 + 16 * ks + 8 * hh);
#pragma unroll
        for (int ti = 0; ti < 2; ++ti) {
#pragma unroll
            for (int ks = 0; ks < 4; ++ks) o[ti] = mma32(FRAG16(bufB, ti * 4 + ks, lane), ub[ks], o[ti]);
#pragma unroll
            for (int reg = 0; reg < 16; ++reg) p.OCRAW[(size_t)(r0 + 32 * ti + acc_row(reg, hh)) * 1024 + h * 128 + 32 * sl + r] = o[ti][reg];
        }
#pragma unroll
        for (int d = 0; d < 4; ++d) {
#pragma unroll
            for (int reg = 0; reg < 16; ++reg) S[d][reg] *= dec;
#pragma unroll
            for (int ks = 0; ks < 4; ++ks) S[d] = mma32(FRAG16(bufB, 8 + d * 4 + ks, lane), ub[ks], S[d]);
        }
        LDS_WAIT();
        if (SCAN_LOADERS) { if (lane == 0) FL[4] = (unsigned)n + 1u; } else delta_issue_B(p, chn, bufB, r, hh);
    }
    VM_WAIT_N(0);
    float* so = p.out + O_PDELTA + ((((size_t)l * 2 + s) * 8 + h) * 128) * 128;
#pragma unroll
    for (int d = 0; d < 4; ++d)
#pragma unroll
        for (int reg = 0; reg < 16; ++reg) so[(size_t)(32 * d + acc_row(reg, hh)) * 128 + 32 * sl + r] = S[d][reg];
}

__device__ __forceinline__ void scan_loader(const P& p, int id, int role, LAS unsigned char* ldsw, int lane) {
    volatile LAS unsigned* FL = (volatile LAS unsigned*)(ldsw + SCAN_FLAGS_OFF);
    const int r = lane & 31, hh = lane >> 5;
    const bool gla = id < 64; const int q = gla ? id : id - 64;
    const int s = q >> 5, h = gla ? (q >> 3) & 3 : (q >> 2) & 7, sl = gla ? q & 7 : q & 3;
    LAS unsigned char* bufA = ldsw + 16384; LAS unsigned char* bufB = ldsw + 16384 + (gla ? 28 : 40) * 1024;
#pragma unroll 1
    for (int n = 0; n < NCH; ++n) {
        const int ch = gla ? (s * 64 + n) * 4 + h : (s * 64 + n) * 8 + h;
        if (!lds_wait_ge<true>(FL + (role < 2 ? 3 : 4), (unsigned)n, FL + 5)) break;
        if (role < 2) { if (gla) gla_issue_A_half(p, ch, sl, bufA, r, hh, role); else delta_issue_A_half(p, ch, sl, bufA, r, hh, role); }
        else { if (gla) gla_issue_B(p, ch, bufB, r, hh); else delta_issue_B(p, ch, bufB, r, hh); }
        VM_WAIT_N(0);
        if (lane == 0) FL[role] = (unsigned)n + 1u;
    }
    VM_WAIT_N(0);
}

__device__ __forceinline__ void norm_task(const P& p, int l, int r, int part, int lane) {
    const bf16* pr = p.PROJ + (size_t)r * PP;
    if (part == 0) {
        const float* gn = p.in[12] + (size_t)l * 256;
        f32x4v x[4], z[4]; const f32x4v g = *(const f32x4v*)(gn + lane * 4);
#pragma unroll
        for (int h = 0; h < 4; ++h) { x[h] = *(const f32x4v*)(p.OBRAW + (size_t)r * 1024 + h * 256 + lane * 4); z[h] = ldbf4(pr + C_BG + h * 256 + lane * 4); }
#pragma unroll
        for (int h = 0; h < 4; ++h) {
            const float ss = wave_sum(x[h].x * x[h].x + x[h].y * x[h].y + x[h].z * x[h].z + x[h].w * x[h].w);
            const float rs = __builtin_amdgcn_rsqf(ss * (1.f / 256.f) + 1e-6f);
            *(u32x2v*)(p.OBb + (size_t)r * 1024 + h * 256 + lane * 4) = (u32x2v){pk2(x[h].x * rs * g.x * siluf_(z[h].x), x[h].y * rs * g.y * siluf_(z[h].y)), pk2(x[h].z * rs * g.z * siluf_(z[h].z), x[h].w * rs * g.w * siluf_(z[h].w))};
        }
    } else {
        const float* dn = p.in[16] + (size_t)l * 128;
        float2 x[8], z[8]; const float2 g = *(const float2*)(dn + lane * 2);
#pragma unroll
        for (int h = 0; h < 8; ++h) { x[h] = *(const float2*)(p.OCRAW + (size_t)r * 1024 + h * 128 + lane * 2); z[h] = ldbf2(pr + C_CZ + h * 128 + lane * 2); }
#pragma unroll
        for (int h = 0; h < 8; ++h) {
            const float ss = wave_sum(x[h].x * x[h].x + x[h].y * x[h].y);
            const float rs = __builtin_amdgcn_rsqf(ss * (1.f / 128.f) + 1e-6f);
            *(unsigned*)(p.OCb + (size_t)r * 1024 + h * 128 + lane * 2) = pk2(x[h].x * rs * g.x * siluf_(z[h].x), x[h].y * rs * g.y * siluf_(z[h].y));
        }
    }
}

__device__ __forceinline__ void norm_row_task(const P& p, int l, int r, int lane) {
    const bf16* pr = p.PROJ + (size_t)r * PP;
    const float* gn = p.in[12] + (size_t)l * 256; const float* dn = p.in[16] + (size_t)l * 128;
    f32x4v x[4], z[4]; float2 y[8], w[8];
    const f32x4v g = *(const f32x4v*)(gn + lane * 4); const float2 g2 = *(const float2*)(dn + lane * 2);
#pragma unroll
    for (int h = 0; h < 4; ++h) { x[h] = *(const f32x4v*)(p.OBRAW + (size_t)r * 1024 + h * 256 + lane * 4); z[h] = ldbf4(pr + C_BG + h * 256 + lane * 4); }
#pragma unroll
    for (int h = 0; h < 8; ++h) { y[h] = *(const float2*)(p.OCRAW + (size_t)r * 1024 + h * 128 + lane * 2); w[h] = ldbf2(pr + C_CZ + h * 128 + lane * 2); }
#pragma unroll
    for (int h = 0; h < 4; ++h) {
        const float ss = wave_sum(x[h].x * x[h].x + x[h].y * x[h].y + x[h].z * x[h].z + x[h].w * x[h].w);
        const float rs = __builtin_amdgcn_rsqf(ss * (1.f / 256.f) + 1e-6f);
        *(u32x2v*)(p.OBb + (size_t)r * 1024 + h * 256 + lane * 4) = (u32x2v){pk2(x[h].x * rs * g.x * siluf_(z[h].x), x[h].y * rs * g.y * siluf_(z[h].y)), pk2(x[h].z * rs * g.z * siluf_(z[h].z), x[h].w * rs * g.w * siluf_(z[h].w))};
    }
#pragma unroll
    for (int h = 0; h < 8; ++h) {
        const float ss = wave_sum(y[h].x * y[h].x + y[h].y * y[h].y);
        const float rs = __builtin_amdgcn_rsqf(ss * (1.f / 128.f) + 1e-6f);
        *(unsigned*)(p.OCb + (size_t)r * 1024 + h * 128 + lane * 2) = pk2(y[h].x * rs * g2.x * siluf_(w[h].x), y[h].y * rs * g2.y * siluf_(w[h].y));
    }
}

__device__ __forceinline__ void mix_phase(const P& p, int l, size_t i0, size_t stride) {
    const size_t n = (size_t)NDEC * D / 4;
    for (size_t i = i0; i < n; i += stride) {
        const size_t r = NPROMPT + i / (D / 4); const int c = (int)(i % (D / 4)) * 4;
        float4 acc = make_float4(0, 0, 0, 0);
#pragma unroll
        for (int b = 0; b < 3; ++b) {
            const f32x4v g = ldbf4(p.PROJ + r * PP + C_MG + b * D + c);
            float4 y;
            if (r < NPROMPT) y = *(const float4*)(p.T3 + ((size_t)b * MPAD + r) * D + c);
            else { y = make_float4(0, 0, 0, 0);
#pragma unroll
                for (int ks = 0; ks < 4; ++ks) { const float4 q = *(const float4*)(p.T3d + ((size_t)(b * 4 + ks) * NDEC + (r - NPROMPT)) * D + c); y.x += q.x; y.y += q.y; y.z += q.z; y.w += q.w; } }
            acc.x += sigmoidf_(g.x) * y.x; acc.y += sigmoidf_(g.y) * y.y; acc.z += sigmoidf_(g.z) * y.z; acc.w += sigmoidf_(g.w) * y.w;
        }
        *(uint2*)(p.MIXb + r * D + c) = make_uint2(pk2(acc.x, acc.y), pk2(acc.z, acc.w));
    }
}

template <int NS> __device__ __forceinline__ void ln_dec_block(const float* res, const float* zs, const float* g, const float* b, float* out, float* out2, bf16* outb, bool active,
                                                               LAS float* red, int tid) {
    const int c = tid * 4, wave = tid >> 6;
    f32x4v v = (f32x4v){0.f, 0.f, 0.f, 0.f};
    if (active) {
        f32x4v q[NS];
#pragma unroll
        for (int sb = 0; sb < NS; ++sb) q[sb] = *(const f32x4v*)(zs + (size_t)sb * NDEC * D + c);
        const f32x4v a = *(const f32x4v*)(res + c);
        v = q[0];
#pragma unroll
        for (int sb = 1; sb < NS; ++sb) v += q[sb];
        v += a * ALPHA;
    }
    float s = wave_sum((v.x + v.y) + (v.z + v.w));
    if ((tid & 63) == 0) red[wave] = s;
    __syncthreads();
    float mu = 0.f;
#pragma unroll
    for (int w = 0; w < 8; ++w) mu += red[w];
    mu *= (1.f / D);
    v = v - mu;
    float qq = wave_sum((v.x * v.x + v.y * v.y) + (v.z * v.z + v.w * v.w));
    if ((tid & 63) == 0) red[8 + wave] = qq;
    __syncthreads();
    float var = 0.f;
#pragma unroll
    for (int w = 0; w < 8; ++w) var += red[8 + w];
    const float rs = __builtin_amdgcn_rsqf(var * (1.f / D) + 1e-5f);
    if (active) {
        const f32x4v gg = *(const f32x4v*)(g + c), bb = *(const f32x4v*)(b + c);
        const f32x4v o = v * rs * gg + bb;
        *(f32x4v*)(out + c) = o;
        if (out2) *(f32x4v*)(out2 + c) = o;
        *(u32x2v*)(outb + c) = (u32x2v){pk2(o.x, o.y), pk2(o.z, o.w)};
    }
}
__device__ __forceinline__ void ln_rows2(const float* z, const float* g, const float* b, float* stats, float* out2, bf16* outb, int lane) {
    float v[2][32]; float s[2] = {0.f, 0.f};
#pragma unroll
    for (int rr = 0; rr < 2; ++rr)
#pragma unroll
        for (int j = 0; j < 8; ++j) { const float4 c = *(const float4*)(z + (size_t)rr * D + j * 256 + lane * 4); v[rr][4 * j] = c.x; v[rr][4 * j + 1] = c.y; v[rr][4 * j + 2] = c.z; v[rr][4 * j + 3] = c.w; }
#pragma unroll
    for (int rr = 0; rr < 2; ++rr)
#pragma unroll
        for (int j = 0; j < 32; ++j) s[rr] += v[rr][j];
    float mu[2], q[2] = {0.f, 0.f}, rs[2];
    s[0] = wave_sum(s[0]); s[1] = wave_sum(s[1]);
    mu[0] = s[0] * (1.f / D); mu[1] = s[1] * (1.f / D);
#pragma unroll
    for (int rr = 0; rr < 2; ++rr)
#pragma unroll
        for (int j = 0; j < 32; ++j) { v[rr][j] -= mu[rr]; q[rr] += v[rr][j] * v[rr][j]; }
    q[0] = wave_sum(q[0]); q[1] = wave_sum(q[1]);
    rs[0] = __builtin_amdgcn_rsqf(q[0] * (1.f / D) + 1e-5f); rs[1] = __builtin_amdgcn_rsqf(q[1] * (1.f / D) + 1e-5f);
    if (lane == 0) { stats[0] = mu[0]; stats[1] = rs[0]; stats[2] = mu[1]; stats[3] = rs[1]; }
#pragma unroll
    for (int j = 0; j < 8; ++j) {
        const float4 gg = *(const float4*)(g + j * 256 + lane * 4), bb = *(const float4*)(b + j * 256 + lane * 4);
#pragma unroll
        for (int rr = 0; rr < 2; ++rr) {
            float4 o; o.x = v[rr][4 * j] * rs[rr] * gg.x + bb.x; o.y = v[rr][4 * j + 1] * rs[rr] * gg.y + bb.y; o.z = v[rr][4 * j + 2] * rs[rr] * gg.z + bb.z; o.w = v[rr][4 * j + 3] * rs[rr] * gg.w + bb.w;
            if (out2) *(float4*)(out2 + (size_t)rr * D + j * 256 + lane * 4) = o;
            *(uint2*)(outb + (size_t)rr * D + j * 256 + lane * 4) = make_uint2(pk2(o.x, o.y), pk2(o.z, o.w));
        }
    }
}
__device__ __forceinline__ void ln_row(const float* res, const float* z, int nslab, const float* g, const float* b, float* out, float* out2, bf16* outb, int lane) {
    float v[32]; float s = 0.f;
#pragma unroll
    for (int j = 0; j < 8; ++j) {
        const float4 a = res ? *(const float4*)(res + j * 256 + lane * 4) : make_float4(0, 0, 0, 0); float4 c = *(const float4*)(z + j * 256 + lane * 4);
#pragma unroll 1
        for (int sb = 1; sb < nslab; ++sb) { const float4 q = *(const float4*)(z + (size_t)sb * NDEC * D + j * 256 + lane * 4); c.x += q.x; c.y += q.y; c.z += q.z; c.w += q.w; }
        v[4 * j] = ALPHA * a.x + c.x; v[4 * j + 1] = ALPHA * a.y + c.y; v[4 * j + 2] = ALPHA * a.z + c.z; v[4 * j + 3] = ALPHA * a.w + c.w;
        s += (v[4 * j] + v[4 * j + 1]) + (v[4 * j + 2] + v[4 * j + 3]);
    }
    const float mu = wave_sum(s) * (1.f / D);
    float q = 0.f;
#pragma unroll
    for (int j = 0; j < 32; ++j) { v[j] -= mu; q += v[j] * v[j]; }
    const float rs = __builtin_amdgcn_rsqf(wave_sum(q) * (1.f / D) + 1e-5f);
#pragma unroll
    for (int j = 0; j < 8; ++j) {
        const float4 gg = *(const float4*)(g + j * 256 + lane * 4), bb = *(const float4*)(b + j * 256 + lane * 4);
        float4 o; o.x = v[4 * j] * rs * gg.x + bb.x; o.y = v[4 * j + 1] * rs * gg.y + bb.y; o.z = v[4 * j + 2] * rs * gg.z + bb.z; o.w = v[4 * j + 3] * rs * gg.w + bb.w;
        *(float4*)(out + j * 256 + lane * 4) = o;
        if (out2) *(float4*)(out2 + j * 256 + lane * 4) = o;
        *(uint2*)(outb + j * 256 + lane * 4) = make_uint2(pk2(o.x, o.y), pk2(o.z, o.w));
    }
}
__device__ __forceinline__ void bf8_to_f(const u32x4v w, float (&f)[8]) {
    f[0] = bf2f(w.x & 0xffffu); f[1] = __builtin_bit_cast(float, w.x & 0xffff0000u); f[2] = bf2f(w.y & 0xffffu); f[3] = __builtin_bit_cast(float, w.y & 0xffff0000u);
    f[4] = bf2f(w.z & 0xffffu); f[5] = __builtin_bit_cast(float, w.z & 0xffff0000u); f[6] = bf2f(w.w & 0xffffu); f[7] = __builtin_bit_cast(float, w.w & 0xffff0000u);
}
constexpr int FFN_PTASKS = (NPROMPT / 8) * 11, FFN_DTASKS = NDEC * 11, FFN_TASKS = FFN_PTASKS + FFN_DTASKS;
__device__ __forceinline__ void ffnconv_task(const P& p, int l, int task, int lane) {
    const float* cw = p.in[22] + (size_t)l * 3 * DFF2;
    if (task < FFN_PTASKS) {
        const int rg = task / 11, sl = task - rg * 11, c = sl * 512 + lane * 8;
        const int ra = rg * 8, t0 = ra & 4095;
        u32x4v x[2][10];
#pragma unroll
        for (int half = 0; half < 2; ++half)
#pragma unroll
            for (int i = 0; i < 10; ++i) {
                if (i < 2 && t0 == 0) x[half][i] = (u32x4v){0u, 0u, 0u, 0u};
                else x[half][i] = *(const u32x4v*)(p.U16 + (size_t)(ra - 2 + i) * DFF2 + c + half * DFF);
            }
        float w[2][3][8];
#pragma unroll
        for (int half = 0; half < 2; ++half)
#pragma unroll
            for (int j = 0; j < 3; ++j) {
                const f32x4v a = *(const f32x4v*)(cw + j * DFF2 + c + half * DFF), b = *(const f32x4v*)(cw + j * DFF2 + c + half * DFF + 4);
                w[half][j][0] = a.x; w[half][j][1] = a.y; w[half][j][2] = a.z; w[half][j][3] = a.w; w[half][j][4] = b.x; w[half][j][5] = b.y; w[half][j][6] = b.z; w[half][j][7] = b.w;
            }
#pragma unroll
        for (int i = 0; i < 8; ++i) {
            float y[2][8];
#pragma unroll
            for (int half = 0; half < 2; ++half) {
                float a[8], b[8], cc[8];
                bf8_to_f(x[half][i], a); bf8_to_f(x[half][i + 1], b); bf8_to_f(x[half][i + 2], cc);
#pragma unroll
                for (int e = 0; e < 8; ++e) y[half][e] = w[half][0][e] * a[e] + w[half][1][e] * b[e] + w[half][2][e] * cc[e];
            }
            u32x4v o;
            o.x = pk2(siluf_(y[0][0]) * y[1][0], siluf_(y[0][1]) * y[1][1]); o.y = pk2(siluf_(y[0][2]) * y[1][2], siluf_(y[0][3]) * y[1][3]);
            o.z = pk2(siluf_(y[0][4]) * y[1][4], siluf_(y[0][5]) * y[1][5]); o.w = pk2(siluf_(y[0][6]) * y[1][6], siluf_(y[0][7]) * y[1][7]);
            *(u32x4v*)(p.Fb + (size_t)(ra + i) * DFF + c) = o;
        }
        return;
    }
    const int dt = task - FFN_PTASKS, rr = dt / 11, sl = dt - rr * 11, c = sl * 512 + lane * 8;
    const int r = NPROMPT + rr, sq = rr >> 2, t = rr & 3;
    float y[2][8];
#pragma unroll
    for (int half = 0; half < 2; ++half) {
#pragma unroll
        for (int e = 0; e < 8; ++e) y[half][e] = 0.f;
#pragma unroll
        for (int j = 0; j < 3; ++j) {
            const int tt = t - 2 + j; float xv[8];
            if (tt >= 0) bf8_to_f(*(const u32x4v*)(p.U16 + (size_t)(NPROMPT + sq * 4 + tt) * DFF2 + c + half * DFF), xv);
            else { const float* sp = p.in[7] + (((size_t)l * 32 + sq) * 2 + (2 + tt)) * DFF2 + c + half * DFF; const f32x4v a = *(const f32x4v*)sp, b = *(const f32x4v*)(sp + 4);
                xv[0] = a.x; xv[1] = a.y; xv[2] = a.z; xv[3] = a.w; xv[4] = b.x; xv[5] = b.y; xv[6] = b.z; xv[7] = b.w; }
            const f32x4v wa = *(const f32x4v*)(cw + j * DFF2 + c + half * DFF), wb = *(const f32x4v*)(cw + j * DFF2 + c + half * DFF + 4);
            y[half][0] += wa.x * xv[0]; y[half][1] += wa.y * xv[1]; y[half][2] += wa.z * xv[2]; y[half][3] += wa.w * xv[3];
            y[half][4] += wb.x * xv[4]; y[half][5] += wb.y * xv[5]; y[half][6] += wb.z * xv[6]; y[half][7] += wb.w * xv[7];
        }
    }
    u32x4v o;
    o.x = pk2(siluf_(y[0][0]) * y[1][0], siluf_(y[0][1]) * y[1][1]); o.y = pk2(siluf_(y[0][2]) * y[1][2], siluf_(y[0][3]) * y[1][3]);
    o.z = pk2(siluf_(y[0][4]) * y[1][4], siluf_(y[0][5]) * y[1][5]); o.w = pk2(siluf_(y[0][6]) * y[1][6], siluf_(y[0][7]) * y[1][7]);
    *(u32x4v*)(p.Fb + (size_t)r * DFF + c) = o;
}

#ifndef PROBE_MASK
#define PROBE_MASK 0
#endif
#define REP(k) for (int rep_ = 0; rep_ < 1 + ((PROBE_MASK >> (k)) & 1); ++rep_)
constexpr int PH_PER_LAYER = 13, N_PHASES = 1 + PH_PER_LAYER * DEPTH;
constexpr int LDS_MISC = pg8::STAGE_BYTES, LDS_BYTES = pg8::STAGE_BYTES + 1024;
struct Args { P p; unsigned* bar; int ph_lo, ph_hi; };
__global__ void __launch_bounds__(512, 2) mega(Args a) {
    extern __shared__ __attribute__((aligned(16))) unsigned char lds_raw[];
    LAS unsigned char* lds = (LAS unsigned char*)lds_raw;
    const P& p = a.p;
    const int tid = threadIdx.x;
    const int G = gridDim.x, bx = blockIdx.x;
    volatile LAS unsigned* misc = (volatile LAS unsigned*)(lds + LDS_MISC);
    if (tid < 64) misc[tid] = 0u;
    __syncthreads();
    const int lo = a.ph_lo, hi = a.ph_hi;
    const bool one_launch = (hi - lo) > 1;
    XcdBarrier bar; bar.bar = a.bar; bar.x = 0; bar.st = misc + 8;
    if (one_launch) bar = xcd_barrier_post(a.bar, misc + 8);
#define IN(k) (lo <= (k) && (k) < hi)
#define SEAM(k) do { if (IN(k) && IN((k) + 1)) { xcd_barrier(bar); if ((PROBE_MASK >> 17) & 1) xcd_barrier(bar); } } while (0)
    const int ngw = G * 8; const size_t ngt = (size_t)G * 512;
#define PHASE_IDS() int tid_p = threadIdx.x; asm volatile("" : "+v"(tid_p)); const int lane = tid_p & 63, wave = __builtin_amdgcn_readfirstlane(tid_p >> 6), gw = bx * 8 + wave; const size_t gt = (size_t)bx * 512 + tid_p; (void)lane; (void)wave; (void)gw; (void)gt

    if (IN(0)) REP(18) {
        PHASE_IDS();
        LAS float* tile = (LAS float*)(lds + (tid_p >> 8) * 32768);
        const int half = tid_p >> 8, t256 = tid_p & 255;
        for (int it = 0; it < (WT_LAYER + 2 * G - 1) / (2 * G); ++it) {
            const int id = (it * G + bx) * 2 + half;
            WTile w = wT_tile(p, id < WT_LAYER ? id : 0);
            if (id < WT_LAYER) wT_load(w.W, w.K, w.N, w.n0, w.k0, tile, t256);
            __syncthreads();
            if (id < WT_LAYER) wT_store(w.Bt, w.K, w.n0, w.k0, tile, t256);
            __syncthreads();
        }
        xinit_phase(p, gt, ngt);
        for (size_t i = gt; i < (size_t)4100 * 8; i += ngt) {
            const int pi = (int)(i >> 3), fi = (int)(i & 7), pos = pi < 4096 ? pi : PAST + (pi - 4096);
            const double rev = (double)pos * rot_inv_rev(fi); const float fr = (float)(rev - floor(rev));
            p.ROT[2 * i] = sin_rev(fr + 0.25f); p.ROT[2 * i + 1] = sin_rev(fr);
        }
    }
    SEAM(0);
    for (int l = 0; l < DEPTH; ++l) {
        const int pb = 1 + PH_PER_LAYER * l;
        if (IN(pb + 0)) REP(0) {
            pg8::Gemm g{p.Xb, p.Win + (size_t)l * PP * D, MPAD, PP, D, D, D, 1, 0, 0, 0, 0}; EpiIn E{p.PROJ, p.SMALL, p.ROT, p.QB16, p.KB16, p.QR, p.KR, p.VD, p.out, l, 0};
            pg8::StaticOrder S; S.init(MPAD, PP, G, bx);
            pg8::gemm_phase<EpiIn, pg8::StaticOrder, true, true>(lds, g, S, E);
        }
        SEAM(pb + 0);
        if (IN(pb + 1)) REP(1) {
            PHASE_IDS();
            REP(19) for (int task = gw; task < MROWS / PREP_ROWS; task += ngw) prep_rows_task(p, l, task * PREP_ROWS, lane);
            REP(20) for (int task = gw; task < (NPROMPT / CONV_ROWS) * 12; task += ngw) prep_conv_task(p, l, task, lane);
            for (int task = gw; task < NDEC * 24; task += ngw) prep_task(p, l, NPROMPT + task / 24, 1 + task % 24, lane);
        }
        SEAM(pb + 1);
        if (IN(pb + 2)) REP(2) {
            PHASE_IDS();
            for (int it = 0; it < (512 + G - 1) / G; ++it) { const int ch = it * G + bx; if (ch < 512) gla_prepass(p, ch, lds, tid_p); }
            for (int it = 0; it < (1024 + 2 * G - 1) / (2 * G); ++it) { const int ch = (it * G + bx) * 2 + (tid_p >> 8); delta_prepass(p, ch < 1024 ? ch : 0, ch < 1024, lds + (tid_p >> 8) * 65536, tid_p & 255); }
            for (int task = gw; task < 512; task += ngw) vt_task(p, task, lds + wave * 8448, lane);
        }
        SEAM(pb + 2);
        if (IN(pb + 3)) REP(3) {
            PHASE_IDS();
            if (tid_p < 16) ((volatile LAS unsigned*)(lds + SCAN_FLAGS_OFF))[tid_p] = 0u;
            __syncthreads();
            const int nsb = G < 128 ? G : 128;
            const int nrole = SCAN_LOADERS ? 4 : 1;
            const bool scan_block = bx < nsb;
            if (scan_block && wave < nrole) {
                REP(13) for (int id = bx; id < 128; id += G) {
                    if (tid_p < 16) {}
                    if (wave == 0) {
                        if (id < 64) gla_scan_task(p, l, id >> 5, (id >> 3) & 3, id & 7, lds, lane);
                        else delta_scan_task(p, l, (id - 64) >> 5, ((id - 64) >> 2) & 7, (id - 64) & 3, lds, lane);
                    } else scan_loader(p, id, wave - 1, lds, lane);
                }
            } else {
                const int wpb = 8 - nrole;
                const int widx = scan_block ? bx * wpb + (wave - nrole) : nsb * wpb + (bx - nsb) * 8 + wave, nwork = nsb * wpb + (G - nsb) * 8;
                REP(14) for (int task = widx; task < 8192; task += nwork) scan_task(p, l, 512 + task, lane);
                REP(15) for (int task = widx; task < NDEC * 4; task += nwork) attn_task(p, l, NPROMPT + (task >> 2), task & 3, lane);
                REP(16) for (int task = widx; task < 4096; task += nwork) attn_prompt_task(p, l, task >> 11, (task >> 4) & 127, task & 15, lds + 106496 + wave * 2560, lane);
                if (l + 1 < DEPTH && widx >= NDEC * 4) for (int task = widx - NDEC * 4; task < WT_LAYER; task += nwork - NDEC * 4) wT_wave_task(p, (l + 1) * WT_LAYER + task, lane);
            }
        }
        SEAM(pb + 3);
        if (IN(pb + 4)) REP(4) { PHASE_IDS(); for (int task = gw; task < NPROMPT; task += ngw) norm_row_task(p, l, task, lane);
            for (int task = gw; task < NDEC * 2; task += ngw) norm_task(p, l, NPROMPT + (task >> 1), task & 1, lane); }
        SEAM(pb + 4);
        if (IN(pb + 5)) REP(5) {
            {
                pg8::Gemm g{p.OAb, p.Wbr + (size_t)l * 3 * D * 1024, NPROMPT, D, 1024, 1024, 1024, 1, (size_t)MPAD * 1024, (size_t)D * 1024, 0, 0}; EpiMix E{p.PROJ + C_MG, p.T3, p.MIXb};
                pg8::TileZ3Order S; S.init(NPROMPT, D, G, bx);
                pg8::gemm_phase<EpiMix, pg8::TileZ3Order, true, true>(lds, g, S, E);
            }
            {
                pg8::Gemm g{p.OAb + (size_t)NPROMPT * 1024, p.Wbr + (size_t)l * 3 * D * 1024, 256, D, 256, 1024, 1024, 4, (size_t)MPAD * 1024, (size_t)D * 1024, 256, 256}; pg8::EpiSlabF32 E{p.T3d, D, 0, (size_t)NDEC * D};
                pg8::ZOrder S; S.init(256, D, 12, G, bx);
                pg8::gemm_phase<pg8::EpiSlabF32, pg8::ZOrder, true, true>(lds, g, S, E);
            }
        }
        SEAM(pb + 5);
        if (IN(pb + 6)) REP(6) { PHASE_IDS(); mix_phase(p, l, gt, ngt); }
        SEAM(pb + 6);
        if (IN(pb + 7)) REP(7) {
            {
                pg8::Gemm g{p.MIXb, p.Wout + (size_t)l * D * D, NPROMPT, D, D, D, D, 1, 0, 0, 0, 0}; pg8::EpiResF32 E{p.Z, l == 0 ? p.X : nullptr, p.ST2, l == 0 ? nullptr : p.in[24] + (size_t)(l - 1) * D, l == 0 ? nullptr : p.in[25] + (size_t)(l - 1) * D, D, ALPHA};
                pg8::StaticOrder S; S.init(NPROMPT, D, G, bx);
                pg8::gemm_phase<pg8::EpiResF32, pg8::StaticOrder, true, true>(lds, g, S, E);
            }
            {
                pg8::Gemm g{p.MIXb + (size_t)NPROMPT * D, p.Wout + (size_t)l * D * D, 256, D, 256, D, D, 8, 0, 0, 256, 256}; pg8::EpiSlabF32 E{p.Zd1, D, 0, (size_t)NDEC * D};
                pg8::ZOrder S; S.init(256, D, 8, G, bx);
                pg8::gemm_phase<pg8::EpiSlabF32, pg8::ZOrder, true, true>(lds, g, S, E);
            }
        }
        SEAM(pb + 7);
        if (IN(pb + 8)) REP(8) {
            PHASE_IDS();
            for (int pr2 = gw; pr2 < NPROMPT / 2; pr2 += ngw) { const size_t r = (size_t)pr2 * 2; ln_rows2(p.Z + r * D, p.in[19] + (size_t)l * D, p.in[20] + (size_t)l * D, p.ST1 + r * 2, nullptr, p.Hb + r * D, lane); }
            for (int it = 0; it < (NDEC + G - 1) / G; ++it) { const int dr = it * G + bx; const bool act = dr < NDEC; const size_t r = NPROMPT + (act ? dr : 0);
                ln_dec_block<8>(p.X + r * D, p.Zd1 + (r - NPROMPT) * D, p.in[19] + (size_t)l * D, p.in[20] + (size_t)l * D, p.H + r * D, nullptr, p.Hb + r * D, act, (LAS float*)(lds + 64 * it), tid_p); }
        }
        SEAM(pb + 8);
        if (IN(pb + 9)) REP(9) {
            pg8::Gemm g{p.Hb, p.Wup + (size_t)l * DFF2 * D, MPAD, DFF2, D, D, D, 1, 0, 0, 0, 0}; EpiU E{p.U16, p.out, l, 0};
            pg8::StaticOrder S; S.init(MPAD, DFF2, G, bx);
            pg8::gemm_phase<EpiU, pg8::StaticOrder, true, true>(lds, g, S, E);
        }
        SEAM(pb + 9);
        if (IN(pb + 10)) REP(10) { PHASE_IDS(); for (int task = gw; task < FFN_TASKS; task += ngw) ffnconv_task(p, l, task, lane); }
        SEAM(pb + 10);
        if (IN(pb + 11)) REP(11) {
            {
                pg8::Gemm g{p.Fb, p.Wdn + (size_t)l * D * DFF, NPROMPT, D, DFF, DFF, DFF, 1, 0, 0, 0, 0}; pg8::EpiResF32 E{p.Z, nullptr, p.ST1, p.in[19] + (size_t)l * D, p.in[20] + (size_t)l * D, D, ALPHA};
                pg8::StaticOrder S; S.init(NPROMPT, D, G, bx);
                pg8::gemm_phase<pg8::EpiResF32, pg8::StaticOrder, true, true>(lds, g, S, E);
            }
            {
                pg8::Gemm g{p.Fb + (size_t)NPROMPT * DFF, p.Wdn + (size_t)l * D * DFF, 256, D, 256, DFF, DFF, 22, 0, 0, 256, 256}; pg8::EpiSlabF32 E{p.Zd2, D, 0, (size_t)NDEC * D};
                pg8::ZOrder S; S.init(256, D, 22, G, bx);
                pg8::gemm_phase<pg8::EpiSlabF32, pg8::ZOrder, true, true>(lds, g, S, E);
            }
        }
        SEAM(pb + 11);
        if (IN(pb + 12)) REP(12) {
            PHASE_IDS();
            for (int pr2 = gw; pr2 < NPROMPT / 2; pr2 += ngw) { const size_t r = (size_t)pr2 * 2;
                ln_rows2(p.Z + r * D, p.in[24] + (size_t)l * D, p.in[25] + (size_t)l * D, p.ST2 + r * 2, l == DEPTH - 1 ? p.out + O_YP + r * D : nullptr, p.Xb + r * D, lane); }
            for (int it = 0; it < (NDEC + G - 1) / G; ++it) { const int dr = it * G + bx; const bool act = dr < NDEC; const size_t r = NPROMPT + (act ? dr : 0);
                ln_dec_block<22>(p.H + r * D, p.Zd2 + (r - NPROMPT) * D, p.in[24] + (size_t)l * D, p.in[25] + (size_t)l * D, p.X + r * D, l == DEPTH - 1 ? p.out + O_YS + (r - NPROMPT) * D : nullptr, p.Xb + r * D, act, (LAS float*)(lds + 64 * it), tid_p); }
        }
        SEAM(pb + 12);
    }
#undef IN
#undef SEAM
}

#ifndef MK_ONE_LAUNCH
#define MK_ONE_LAUNCH 1
#endif
extern "C" void kernel_launch(void* const* d_in, const int* in_sizes, int n_in, void* d_out, int out_size, void* d_ws, size_t ws_size, hipStream_t stream) {
    static int grid = 0;
    if (n_in != 26 || (size_t)out_size != O_TOTAL) { fprintf(stderr, "kernel_launch: unexpected n_in %d / out_size %d\n", n_in, out_size); return; }
    if (grid == 0) {
        int dev = 0, cus = 0, per_cu = 0;
        if (hipGetDevice(&dev) != hipSuccess || hipDeviceGetAttribute(&cus, hipDeviceAttributeMultiprocessorCount, dev) != hipSuccess) { grid = -1; return; }
        if (hipFuncSetAttribute((const void*)mega, hipFuncAttributeMaxDynamicSharedMemorySize, LDS_BYTES) != hipSuccess) { fprintf(stderr, "kernel_launch: hipFuncSetAttribute failed\n"); grid = -1; return; }
        if (hipOccupancyMaxActiveBlocksPerMultiprocessor(&per_cu, (const void*)mega, 512, LDS_BYTES) != hipSuccess || per_cu < 1) { fprintf(stderr, "kernel_launch: occupancy query says %d blocks per CU\n", per_cu); grid = -1; return; }
        (void)hipGetLastError();
        grid = cus;
    }
    if (grid < 0) return;
    Args a{};
    P& p = a.p;
    for (int i = 0; i < 26; ++i) p.in[i] = (const float*)d_in[i];
    p.out = (float*)d_out;
    size_t off = 0; char* ws = (char*)d_ws;
    auto carve = [&](size_t bytes) { void* q = (void*)(ws + off); off += ((bytes + 255) / 256) * 256; return q; };
    a.bar = (unsigned*)carve((size_t)XCD_BAR_WORDS * 4);
    p.Win = (bf16*)carve((size_t)DEPTH * PP * D * 2); p.Wbr = (bf16*)carve((size_t)DEPTH * 3 * D * 1024 * 2); p.Wout = (bf16*)carve((size_t)DEPTH * D * D * 2);
    p.Wup = (bf16*)carve((size_t)DEPTH * DFF2 * D * 2); p.Wdn = (bf16*)carve((size_t)DEPTH * D * DFF * 2);
    p.X = (float*)carve((size_t)MPAD * D * 4); p.H = (float*)carve((size_t)MPAD * D * 4); p.Z = (float*)carve((size_t)MPAD * D * 4);
    p.Xb = (bf16*)carve((size_t)MPAD * D * 2); p.Hb = (bf16*)carve((size_t)MPAD * D * 2); p.MIXb = (bf16*)carve((size_t)MPAD * D * 2);
    p.OAb = (bf16*)carve((size_t)MPAD * 1024 * 2); p.OBb = (bf16*)carve((size_t)MPAD * 1024 * 2); p.OCb = (bf16*)carve((size_t)MPAD * 1024 * 2);
    p.G = (float*)carve((size_t)MPAD * 8 * 4); p.BETA = (float*)carve((size_t)MPAD * 8 * 4);
    p.ST1 = (float*)carve((size_t)NPROMPT * 2 * 4); p.ST2 = (float*)carve((size_t)NPROMPT * 2 * 4);
    p.T3d = (float*)carve((size_t)42 * NDEC * D * 4); p.Zd1 = p.T3d + (size_t)12 * NDEC * D; p.Zd2 = p.T3d + (size_t)20 * NDEC * D;
    p.PROJ = (bf16*)carve((size_t)MPAD * PP * 2); p.U16 = (bf16*)carve((size_t)MPAD * DFF2 * 2);
    p.ROT = (float*)carve((size_t)4100 * 16 * 4);
    p.SMALL = (float*)carve((size_t)MPAD * 32 * 4); p.VD = (float*)carve((size_t)NDEC * 256 * 4);
    const size_t r2 = off;
    p.QR = (float*)carve((size_t)MPAD * 1024 * 4); p.KR = (float*)carve((size_t)MPAD * 256 * 4); p.AG = (float*)carve((size_t)MPAD * 512 * 4);
    p.DQKV = (float*)carve((size_t)MPAD * 3072 * 4); p.OBRAW = (float*)carve((size_t)MPAD * 1024 * 4); p.OCRAW = (float*)carve((size_t)MPAD * 1024 * 4);
    p.QB16 = (bf16*)carve((size_t)NPROMPT * 1024 * 2); p.KB16 = (bf16*)carve((size_t)NPROMPT * 256 * 2); p.VT16 = (bf16*)carve((size_t)2 * 4 * 64 * TP * 2);
    p.GQT = (bf16*)carve((size_t)512 * 64 * 128 * 2); p.GKT = (bf16*)carve((size_t)512 * 128 * 64 * 2); p.GVT = (bf16*)carve((size_t)512 * 256 * 64 * 2);
    p.GA = (bf16*)carve((size_t)512 * 64 * 64 * 2); p.GDEC = (float*)carve((size_t)512 * 128 * 4);
    p.DUB = (float*)carve((size_t)1024 * 64 * 128 * 4); p.DNW = (bf16*)carve((size_t)1024 * 64 * 128 * 2); p.DQD = (bf16*)carve((size_t)1024 * 64 * 128 * 2);
    p.DAQK = (bf16*)carve((size_t)1024 * 64 * 64 * 2); p.DKE = (bf16*)carve((size_t)1024 * 128 * 64 * 2); p.DDEC = (float*)carve((size_t)1024 * 4 * 4);
    const size_t r2_end = off; off = r2;
    p.T3 = (float*)carve((size_t)3 * MPAD * D * 4); p.Fb = (bf16*)p.T3;
    if (off < r2_end) off = r2_end;
    if (off > ws_size) { fprintf(stderr, "kernel_launch: workspace too small: need %zu have %zu\n", off, ws_size); return; }
    if (hipMemsetAsync(a.bar, 0, (size_t)XCD_BAR_WORDS * 4, stream) != hipSuccess) return;
#if MK_ONE_LAUNCH
    a.ph_lo = 0; a.ph_hi = N_PHASES;
    hipLaunchKernelGGL(mega, dim3(grid), dim3(512), LDS_BYTES, stream, a);
#else
    for (int ph = 0; ph < N_PHASES; ++ph) { a.ph_lo = ph; a.ph_hi = ph + 1; hipLaunchKernelGGL(mega, dim3(grid), dim3(512), LDS_BYTES, stream, a); }
#endif
}
```

```cpp
#include <hip/hip_runtime.h>
#include <cstdio>
#include <cstdint>
namespace pg8 {
#define PG8_LAS __attribute__((address_space(3)))
typedef unsigned short bf16_t;
typedef short bf16x8 __attribute__((ext_vector_type(8)));
typedef float f32x4 __attribute__((ext_vector_type(4)));
typedef unsigned u32x4 __attribute__((ext_vector_type(4)));
constexpr int BM = 256, BK = 64, HALF = 128, HTB = HALF * BK * 2  , STAGE_BYTES = 8 * HTB, NXCD = 8, WGM = 8;

__host__ __device__ __forceinline__ int lds_byte(int r, int c) { const int st = (r >> 4) * 2 + (c >> 5), rr = r & 15, cc = c & 31, ob = rr * 64 + cc * 2; return st * 1024 + (ob ^ (((ob >> 9) & 1) << 5)); }
__host__ __device__ __forceinline__ void stage_rc(int b, int& R, int& C) { const int st = b / 1024, sb = b % 1024, swz = sb ^ (((sb >> 9) & 1) << 5); R = (st >> 1) * 16 + swz / 64; C = (st & 1) * 32 + (swz % 64) / 2; }
__host__ __device__ __forceinline__ int perm32(int rho) { const int n = rho >> 4, i = rho & 15; return 8 * (i >> 2) + 4 * n + (i & 3); }

struct Unit { int pm, pn, z; };
struct Gemm { const bf16_t* A; const bf16_t* Bt; int M, N, K, lda, ldb, zdiv; size_t zA, zB, zA2, zB2; };

struct StaticOrder {
    int nM, nN, nwg, G, c;
    __host__ __device__ void init(int M, int N, int G_, int c_) { nM = M / BM; nN = N / BM; nwg = nM * nN; G = G_; c = c_; }
    __host__ __device__ bool next(int i, Unit& u) const {
        const long L = (long)i * G + c; if (L >= nwg) return false;
        int wgid = (int)L; { const int q = nwg / NXCD, r = nwg % NXCD, xcd = wgid % NXCD, off = wgid / NXCD; wgid = (xcd < r ? xcd * (q + 1) : r * (q + 1) + (xcd - r) * q) + off; }
        const int nig = WGM * nN, gid = wgid / nig, fm = gid * WGM, gsz = (nM - fm) < WGM ? (nM - fm) : WGM;
        u.pm = fm + ((wgid % nig) % gsz); u.pn = (wgid % nig) / gsz; u.z = 0; return true;
    }
    __device__ __forceinline__ void a_ready(const Unit&) const {}
    __device__ __forceinline__ void done(const Unit&) const {}
};

__device__ __forceinline__ unsigned cvt_pk_bf16(float lo, float hi) { unsigned r; asm volatile("v_cvt_pk_bf16_f32 %0, %1, %2" : "=v"(r) : "v"(lo), "v"(hi)); return r; }
typedef float f32x2 __attribute__((ext_vector_type(2)));

struct EpiF32 {
    static constexpr bool PERM = false, AFTER_DRAIN = false;
    float* C; int ldc, zdiv; size_t zC;
    __device__ __forceinline__ void operator()(const f32x4 (&acc)[2][2][4][2], const Unit& u, int wr, int wc, int fr, int fq) const {
        const int row0 = u.pm * BM + wr * 64 + fr, col0 = u.pn * BM + wc * 32 + 4 * fq;
#pragma unroll
        for (int ai = 0; ai < 2; ++ai)
#pragma unroll
            for (int m = 0; m < 4; ++m) { float* rowp = C + (size_t)(u.z / zdiv) * zC + (size_t)(row0 + ai * HALF + m * 16) * ldc + col0;
#pragma unroll
                for (int bj = 0; bj < 2; ++bj)
#pragma unroll
                    for (int n = 0; n < 2; ++n) *(f32x4*)(rowp + bj * HALF + n * 16) = acc[ai][bj][m][n]; }
    }
};
struct EpiResF32 {
    static constexpr bool PERM = false, AFTER_DRAIN = false;
    float* C; const float* resp; const float* stats; const float* g; const float* b; int ldc; float alpha;
    __device__ __forceinline__ void operator()(const f32x4 (&acc)[2][2][4][2], const Unit& u, int wr, int wc, int fr, int fq) const {
        const int row0 = u.pm * BM + wr * 64 + fr, col0 = u.pn * BM + wc * 32 + 4 * fq;
        f32x4 gv[2][2], bv[2][2];
#pragma unroll
        for (int bj = 0; bj < 2; ++bj)
#pragma unroll
            for (int n = 0; n < 2; ++n) { gv[bj][n] = resp ? (f32x4){1.f, 1.f, 1.f, 1.f} : *(const f32x4*)(g + col0 + bj * HALF + n * 16); bv[bj][n] = resp ? (f32x4){0.f, 0.f, 0.f, 0.f} : *(const f32x4*)(b + col0 + bj * HALF + n * 16); }
#pragma unroll
        for (int ai = 0; ai < 2; ++ai)
#pragma unroll
            for (int m = 0; m < 4; ++m) { const int row = row0 + ai * HALF + m * 16; const size_t off = (size_t)row * ldc + col0;
                float mu = 0.f, rs = 1.f;
                if (!resp) { mu = stats[2 * row]; rs = stats[2 * row + 1]; }
                const float* src = resp ? resp : C;
                f32x4 rv[2][2];
#pragma unroll
                for (int bj = 0; bj < 2; ++bj)
#pragma unroll
                    for (int n = 0; n < 2; ++n) rv[bj][n] = *(const f32x4*)(src + off + bj * HALF + n * 16);
#pragma unroll
                for (int bj = 0; bj < 2; ++bj)
#pragma unroll
                    for (int n = 0; n < 2; ++n) *(f32x4*)(C + off + bj * HALF + n * 16) = ((rv[bj][n] - mu) * rs * gv[bj][n] + bv[bj][n]) * alpha + acc[ai][bj][m][n]; }
    }
};
struct EpiSlabF32 {
    static constexpr bool PERM = false, AFTER_DRAIN = false;
    float* C; int ldc, pad; size_t zC;
    __device__ __forceinline__ void operator()(const f32x4 (&acc)[2][2][4][2], const Unit& u, int wr, int wc, int fr, int fq) const {
        const int row0 = wr * 64 + fr, col0 = u.pn * BM + wc * 32 + 4 * fq;
#pragma unroll
        for (int m = 0; m < 4; ++m) { float* rowp = C + (size_t)u.z * zC + (size_t)(row0 + m * 16) * ldc + col0;
#pragma unroll
            for (int bj = 0; bj < 2; ++bj)
#pragma unroll
                for (int n = 0; n < 2; ++n) *(f32x4*)(rowp + bj * HALF + n * 16) = acc[0][bj][m][n]; }
    }
};
struct ZOrder {
    StaticOrder so; int nz, G, c, per;
    __device__ void init(int M, int N, int nz_, int G_, int c_) { so.init(M, N, 1, 0); nz = nz_; G = G_; c = c_; per = so.nwg; }
    __device__ bool next(int i, Unit& u) const {
        const long L = (long)i * G + c; if (L >= (long)per * nz) return false;
        const int z = (int)(L / per), rem = (int)(L % per);
        StaticOrder t = so; t.c = rem; t.next(0, u); u.z = z; return true;
    }
    __device__ __forceinline__ void a_ready(const Unit&) const {}
    __device__ __forceinline__ void done(const Unit&) const {}
};
struct TileZ3Order {
    StaticOrder so; int G, c, per;
    __device__ void init(int M, int N, int G_, int c_) { so.init(M, N, 1, 0); G = G_; c = c_; per = so.nwg; }
    __device__ bool next(int i, Unit& u) const {
        const int ti = i / 3, z = i - 3 * ti; const long L = (long)ti * G + c; if (L >= per) return false;
        StaticOrder t = so; t.c = (int)L; t.next(0, u); u.z = z; return true;
    }
    __device__ __forceinline__ void a_ready(const Unit&) const {}
    __device__ __forceinline__ void done(const Unit&) const {}
};
template <class Epi, class Sched, bool ALIGN_EPI = false, bool SP2 = false>
__device__ __forceinline__ void gemm_phase(PG8_LAS unsigned char* lds, const Gemm g, const Sched& S, const Epi& E) {
    int tid_l = threadIdx.x; asm volatile("" : "+v"(tid_l));
    const int tid = tid_l, wid = __builtin_amdgcn_readfirstlane(tid >> 6), lane = tid & 63, wr = wid >> 2, wc = wid & 3, fr = lane & 15, fq = lane >> 4;
    const int K = g.K, nt = K / BK;
    unsigned voffA[2], voffB[2];
#pragma unroll
    for (int i = 0; i < 2; ++i) { int R, C; stage_rc(tid * 16 + i * 8192, R, C); const int Rb = Epi::PERM ? ((R & ~31) + perm32(R & 31)) : R;
        voffA[i] = (unsigned)(R * g.lda + C) * 2u; voffB[i] = (unsigned)(Rb * g.ldb + C) * 2u; }
    const size_t kstep = (size_t)(BK * 2);
    const size_t hstepA = (size_t)HALF * g.lda * 2, hstepB = (size_t)HALF * g.ldb * 2;
    const size_t tstepA = 2 * hstepA, tstepB = 2 * hstepB;
    const unsigned ldsw = (unsigned)wid * 1024u;
    const int aoff = lds_byte(wr * 64 + fr, fq * 8), boff = lds_byte(wc * 32 + fr, fq * 8);
#define PG8_SA(b, h) (((b) * 2 + (h)) * HTB)
#define PG8_SB(b, h) ((4 + (b) * 2 + (h)) * HTB)
#define PG8_STAGE(bufoff, gbase, voff) do { _Pragma("unroll") for (int _i = 0; _i < 2; ++_i) \
        __builtin_amdgcn_global_load_lds((const unsigned*)((const char*)(gbase) + (voff)[_i]), (PG8_LAS unsigned*)(lds + (bufoff) + ldsw + _i * 8192), 16, 0, 0); } while (0)
#define PG8_LDA(dst, b, h) do { _Pragma("unroll") for (int m = 0; m < 4; ++m) _Pragma("unroll") for (int k = 0; k < 2; ++k) dst[m][k] = *(const PG8_LAS bf16x8*)(lds + PG8_SA(b, h) + aoff + m * 2048 + k * 1024); } while (0)
#define PG8_LDB(dst, b, h) do { _Pragma("unroll") for (int n = 0; n < 2; ++n) _Pragma("unroll") for (int k = 0; k < 2; ++k) dst[n][k] = *(const PG8_LAS bf16x8*)(lds + PG8_SB(b, h) + boff + n * 2048 + k * 1024); } while (0)
#define PG8_MMA(ai, bj, At, Bt) do { __builtin_amdgcn_s_setprio(1); _Pragma("unroll") for (int m = 0; m < 4; ++m) _Pragma("unroll") for (int n = 0; n < 2; ++n) _Pragma("unroll") for (int k = 0; k < 2; ++k) \
        acc[ai][bj][m][n] = __builtin_amdgcn_mfma_f32_16x16x32_bf16(Bt[n][k], At[m][k], acc[ai][bj][m][n], 0, 0, 0); __builtin_amdgcn_s_setprio(0); } while (0)
#define PG8_WAIT_V(n) asm volatile("s_waitcnt vmcnt(" #n ")" ::: "memory")
#define PG8_WAIT_L(n) asm volatile("s_waitcnt lgkmcnt(" #n ")" ::: "memory")
#define PG8_BAR __builtin_amdgcn_s_barrier()
#define PG8_SCHED __builtin_amdgcn_sched_barrier(0)
    Unit cur, nxt; int ui = 0;
    if (!S.next(0, cur)) return;
    f32x4 acc[2][2][4][2];
#pragma unroll
    for (int a = 0; a < 2; ++a)
#pragma unroll
        for (int b = 0; b < 2; ++b)
#pragma unroll
            for (int m = 0; m < 4; ++m)
#pragma unroll
                for (int n = 0; n < 2; ++n) acc[a][b][m][n] = (f32x4){0.f, 0.f, 0.f, 0.f};
    bf16x8 At[4][2], B0[2][2], B1[2][2];
    const char* cA = (const char*)g.A + (size_t)cur.pm * tstepA + ((size_t)(cur.z / g.zdiv) * g.zA + (size_t)(cur.z % g.zdiv) * g.zA2) * 2; const char* cB = (const char*)g.Bt + (size_t)cur.pn * tstepB + ((size_t)(cur.z / g.zdiv) * g.zB + (size_t)(cur.z % g.zdiv) * g.zB2) * 2;
    S.a_ready(cur);
    if constexpr (SP2) {
        PG8_STAGE(PG8_SB(0, 0), cB, voffB); PG8_STAGE(PG8_SB(0, 1), cB + hstepB, voffB); PG8_STAGE(PG8_SA(0, 0), cA, voffA); PG8_STAGE(PG8_SA(0, 1), cA + hstepA, voffA);
        if (wr == 1) PG8_BAR;
        PG8_WAIT_V(2); PG8_BAR;
        PG8_STAGE(PG8_SB(1, 0), cB + kstep, voffB); PG8_STAGE(PG8_SA(1, 0), cA + kstep, voffA); PG8_STAGE(PG8_SB(1, 1), cB + hstepB + kstep, voffB);
        PG8_WAIT_V(6); PG8_BAR;
    } else {
        PG8_STAGE(PG8_SB(0, 0), cB, voffB); PG8_STAGE(PG8_SA(0, 0), cA, voffA); PG8_STAGE(PG8_SB(0, 1), cB + hstepB, voffB); PG8_STAGE(PG8_SA(0, 1), cA + hstepA, voffA);
        if (wr == 1) PG8_BAR;
        PG8_WAIT_V(4); PG8_BAR;
        PG8_STAGE(PG8_SB(1, 0), cB + kstep, voffB); PG8_STAGE(PG8_SA(1, 0), cA + kstep, voffA); PG8_STAGE(PG8_SB(1, 1), cB + hstepB + kstep, voffB);
        PG8_WAIT_V(6); PG8_BAR;
    }
    for (;;) {
        const bool has_next = S.next(ui + 1, nxt);
        const char* nA = has_next ? (const char*)g.A + (size_t)nxt.pm * tstepA + ((size_t)(nxt.z / g.zdiv) * g.zA + (size_t)(nxt.z % g.zdiv) * g.zA2) * 2 : cA; const char* nB = has_next ? (const char*)g.Bt + (size_t)nxt.pn * tstepB + ((size_t)(nxt.z / g.zdiv) * g.zB + (size_t)(nxt.z % g.zdiv) * g.zB2) * 2 : cB;
        for (int t = 0; t < nt; t += 2) {
            const bool last = (t == nt - 2);
            const char* a1 = cA + (size_t)(t + 1) * kstep;
            const char* a2 = last ? nA : cA + (size_t)(t + 2) * kstep; const char* b2 = last ? nB : cB + (size_t)(t + 2) * kstep;
            const char* a3 = a2 + kstep; const char* b3 = b2 + kstep;
            if (last && has_next) S.a_ready(nxt);
            if constexpr (SP2) {
            PG8_LDB(B0, 0, 0); PG8_LDB(B1, 0, 1); PG8_SCHED; PG8_LDA(At, 0, 0); PG8_STAGE(PG8_SA(1, 1), a1 + hstepA, voffA);
            PG8_WAIT_V(8); PG8_WAIT_L(0); PG8_BAR; PG8_MMA(0, 0, At, B0); PG8_MMA(0, 1, At, B1); PG8_BAR; PG8_SCHED;
            PG8_LDA(At, 0, 1); PG8_STAGE(PG8_SB(0, 0), b2, voffB); PG8_STAGE(PG8_SB(0, 1), b2 + hstepB, voffB); PG8_STAGE(PG8_SA(0, 0), a2, voffA);
            PG8_WAIT_V(8); PG8_WAIT_L(0); PG8_BAR; PG8_MMA(1, 0, At, B0); PG8_MMA(1, 1, At, B1); PG8_BAR; PG8_SCHED;
            PG8_LDB(B0, 1, 0); PG8_LDB(B1, 1, 1); PG8_SCHED; PG8_LDA(At, 1, 0); PG8_STAGE(PG8_SA(0, 1), a2 + hstepA, voffA);
            PG8_WAIT_V(8); PG8_WAIT_L(0); PG8_BAR; PG8_MMA(0, 0, At, B0); PG8_MMA(0, 1, At, B1); PG8_BAR; PG8_SCHED;
            PG8_LDA(At, 1, 1); PG8_STAGE(PG8_SB(1, 0), b3, voffB); PG8_STAGE(PG8_SB(1, 1), b3 + hstepB, voffB); PG8_STAGE(PG8_SA(1, 0), a3, voffA);
            PG8_WAIT_V(8); PG8_WAIT_L(0); PG8_BAR; PG8_MMA(1, 0, At, B0); PG8_MMA(1, 1, At, B1); PG8_BAR; PG8_SCHED;
            } else {
            PG8_LDB(B0, 0, 0); PG8_SCHED; PG8_LDA(At, 0, 0); PG8_STAGE(PG8_SA(1, 1), a1 + hstepA, voffA);
            PG8_WAIT_L(8); PG8_BAR; PG8_WAIT_L(0); PG8_MMA(0, 0, At, B0); PG8_BAR; PG8_SCHED;
            PG8_LDB(B1, 0, 1); PG8_STAGE(PG8_SB(0, 0), b2, voffB);
            PG8_BAR; PG8_WAIT_L(0); PG8_MMA(0, 1, At, B1); PG8_BAR;
            PG8_LDA(At, 0, 1); PG8_STAGE(PG8_SA(0, 0), a2, voffA);
            PG8_BAR; PG8_WAIT_L(0); PG8_MMA(1, 0, At, B0); PG8_BAR; PG8_SCHED;
            PG8_STAGE(PG8_SB(0, 1), b2 + hstepB, voffB);
            PG8_WAIT_V(6); PG8_BAR; PG8_MMA(1, 1, At, B1); PG8_BAR;
            PG8_LDB(B0, 1, 0); PG8_SCHED; PG8_LDA(At, 1, 0); PG8_STAGE(PG8_SA(0, 1), a2 + hstepA, voffA);
            PG8_WAIT_L(8); PG8_BAR; PG8_WAIT_L(0); PG8_MMA(0, 0, At, B0); PG8_BAR; PG8_SCHED;
            PG8_LDB(B1, 1, 1); PG8_STAGE(PG8_SB(1, 0), b3, voffB);
            PG8_BAR; PG8_WAIT_L(0); PG8_MMA(0, 1, At, B1); PG8_BAR;
            PG8_LDA(At, 1, 1); PG8_STAGE(PG8_SA(1, 0), a3, voffA);
            PG8_BAR; PG8_WAIT_L(0); PG8_MMA(1, 0, At, B0); PG8_BAR; PG8_SCHED;
            PG8_STAGE(PG8_SB(1, 1), b3 + hstepB, voffB);
            PG8_WAIT_V(6); PG8_BAR; PG8_MMA(1, 1, At, B1); PG8_BAR;
            }
        }
        if constexpr (ALIGN_EPI) { if (wr == 0) PG8_BAR; }
        if constexpr (!Epi::AFTER_DRAIN) { E(acc, cur, wr, wc, fr, fq); S.done(cur); }
        if (!has_next) break;
#pragma unroll
        for (int a = 0; a < 2; ++a)
#pragma unroll
            for (int b = 0; b < 2; ++b)
#pragma unroll
                for (int m = 0; m < 4; ++m)
#pragma unroll
                    for (int n = 0; n < 2; ++n) acc[a][b][m][n] = (f32x4){0.f, 0.f, 0.f, 0.f};
        cur = nxt; cA = nA; cB = nB; ++ui;
        if constexpr (ALIGN_EPI) { if (wr == 1) PG8_BAR; }
    }
    PG8_WAIT_V(0);
    if constexpr (!ALIGN_EPI) { if (wr == 0) PG8_BAR; }
    PG8_BAR;
    if constexpr (Epi::AFTER_DRAIN) { E.fused(acc, cur, wr, wc, fr, fq, lds, wid, lane); S.done(cur); }
#undef PG8_SA
#undef PG8_SB
#undef PG8_STAGE
#undef PG8_LDA
#undef PG8_LDB
#undef PG8_MMA
#undef PG8_WAIT_V
#undef PG8_WAIT_L
#undef PG8_BAR
#undef PG8_SCHED
}
}

constexpr int D = 2048, NPROMPT = 8192, TP = 4096, NDEC = 128, TD = 4, MROWS = NPROMPT + NDEC, DEPTH = 4;
constexpr int PAST = 16384;
constexpr int INC = 14880, PP = 15104  , MPAD = 8448  ;
constexpr int C_AQ = 0, C_AK = 1024, C_AV = 1280, C_BQ = 1536, C_BK = 2048, C_BV = 2560, C_BG = 3584, C_BLR = 4608,
              C_CQKV = 4624, C_CZ = 7696, C_CA = 8720, C_CB = 8728, C_MG = 8736;
constexpr int DFF = 5632, DFF2 = 11264;
constexpr float ALPHA = 1.681792830507429f;
constexpr size_t O_YP = 0, O_YS = 16777216, O_PK = 17039360, O_PV = 17301504, O_PGLA = 17563648, O_PDELTA = 18612224,
                 O_PDCONV = 19660800, O_PFCONV = 19734528, O_SK = 19914752, O_SV = 24109056, O_SGLA = 28303360,
                 O_SDELTA = 45080576, O_SDCONV = 61857792, O_SFCONV = 63037440, O_TOTAL = 65921024;

typedef unsigned short bf16;
typedef short bf16x8 __attribute__((ext_vector_type(8)));
typedef float f32x16 __attribute__((ext_vector_type(16)));
typedef unsigned u32x4v __attribute__((ext_vector_type(4)));
typedef unsigned u32x2v __attribute__((ext_vector_type(2)));
typedef float f32x4v __attribute__((ext_vector_type(4)));
struct P {
    const float* in[26];
    float* out;
    float *X, *H, *QR, *KR, *AG, *DQKV, *G, *BETA, *OBRAW, *OCRAW, *T3, *Z;
    bf16* PROJ;
    float* ROT;
    float *SMALL, *VD;
    bf16 *Xb, *Hb, *OAb, *OBb, *OCb, *MIXb, *Fb;
    bf16* U16;
    float *ST1, *ST2;
    float *T3d, *Zd1, *Zd2;
    bf16 *Win, *Wbr, *Wout, *Wup, *Wdn;
    bf16 *QB16, *KB16, *VT16;
    bf16 *GQT, *GKT, *GVT, *GA; float* GDEC;
    float* DUB; bf16 *DNW, *DQD, *DAQK, *DKE; float* DDEC;
};
__device__ __forceinline__ unsigned f2bf(float f) { unsigned u = __builtin_bit_cast(unsigned, f); return (u + 0x7fffu + ((u >> 16) & 1u)) >> 16; }
typedef __bf16 bf16x2_t __attribute__((ext_vector_type(2)));
typedef float f32x2_t __attribute__((ext_vector_type(2)));
__device__ __forceinline__ unsigned pk2(float lo, float hi) { f32x2_t v = {lo, hi}; bf16x2_t b = __builtin_convertvector(v, bf16x2_t); return __builtin_bit_cast(unsigned, b); }

__device__ __forceinline__ float ldbf(const bf16* q) { return __builtin_bit_cast(float, (unsigned)(*q) << 16); }
__device__ __forceinline__ f32x4v ldbf4(const bf16* q) { const u32x2v w = *(const u32x2v*)q; f32x4v r; r.x = __builtin_bit_cast(float, w.x << 16); r.y = __builtin_bit_cast(float, w.x & 0xffff0000u); r.z = __builtin_bit_cast(float, w.y << 16); r.w = __builtin_bit_cast(float, w.y & 0xffff0000u); return r; }
__device__ __forceinline__ float2 ldbf2(const bf16* q) { const unsigned w = *(const unsigned*)q; return make_float2(__builtin_bit_cast(float, w << 16), __builtin_bit_cast(float, w & 0xffff0000u)); }
__device__ __forceinline__ int row_seq(int r) { return r < NPROMPT ? (r >> 12) : 2 + ((r - NPROMPT) >> 2); }
__device__ __forceinline__ int row_t(int r) { return r < NPROMPT ? (r & 4095) : ((r - NPROMPT) & 3); }
__device__ __forceinline__ int seq_row0(int s) { return s < 2 ? s * TP : NPROMPT + (s - 2) * TD; }
__device__ __forceinline__ int seq_len(int s) { return s < 2 ? TP : TD; }
#define DPP_F(v, ctrl) __builtin_bit_cast(float, __builtin_amdgcn_update_dpp(0, __builtin_bit_cast(int, (v)), (ctrl), 0xF, 0xF, true))
__device__ __forceinline__ float row16_sum(float v) {
    v += DPP_F(v, 0xB1);
    v += DPP_F(v, 0x4E);
    v += DPP_F(v, 0x141);
    v += DPP_F(v, 0x140);
    return v;
}
__device__ __forceinline__ float wave_sum(float v) {
    v = row16_sum(v);
    v += __shfl_xor(v, 16); v += __shfl_xor(v, 32);
    return v;
}
__device__ __forceinline__ float wave_max(float v) {
#pragma unroll
    for (int o = 1; o < 64; o <<= 1) v = fmaxf(v, __shfl_xor(v, o));
    return v;
}
__device__ __forceinline__ float sigmoidf_(float x) { return __builtin_amdgcn_rcpf(1.f + __expf(-x)); }
__device__ __forceinline__ float siluf_(float x) { return x * __builtin_amdgcn_rcpf(1.f + __expf(-x)); }
__device__ __forceinline__ float softplusf_(float x) { return fmaxf(x, 0.f) + __logf(1.f + __expf(-fabsf(x))); }


struct EpiU {
    static constexpr bool PERM = true, AFTER_DRAIN = false;
    bf16* U16; float* out; int l, pad;
    __device__ __forceinline__ void operator()(const pg8::f32x4 (&acc)[2][2][4][2], const pg8::Unit& u, int wr, int wc, int fr, int fq) const {
        const int row0 = u.pm * 256 + wr * 64 + fr, col0 = u.pn * 256 + wc * 32 + 8 * fq;
#pragma unroll
        for (int ai = 0; ai < 2; ++ai)
#pragma unroll
            for (int m = 0; m < 4; ++m) {
                bf16* rowp = U16 + (size_t)(row0 + ai * 128 + m * 16) * DFF2 + col0;
#pragma unroll
                for (int bj = 0; bj < 2; ++bj) {
                    const pg8::f32x4 v0 = acc[ai][bj][m][0], v1 = acc[ai][bj][m][1];
                    pg8::u32x4 w; w.x = pk2(v0[0], v0[1]); w.y = pk2(v0[2], v0[3]); w.z = pk2(v1[0], v1[1]); w.w = pk2(v1[2], v1[3]);
                    *(pg8::u32x4*)(rowp + bj * 128) = w;
                }
            }
        if (u.pm == 15 || u.pm == 31 || u.pm == 32) {
#pragma unroll
            for (int ai = 0; ai < 2; ++ai)
#pragma unroll
                for (int m = 0; m < 4; ++m) {
                    const int r = row0 + ai * 128 + m * 16;
                    float* op = nullptr;
                    if (r < NPROMPT) { const int t = r & 4095; if (t >= TP - 2) op = out + O_PFCONV + (((size_t)l * 2 + (r >> 12)) * 2 + (t - (TP - 2))) * DFF2 + col0; }
                    else if (r < MROWS) { const int t = (r - NPROMPT) & 3; if (t >= 2) op = out + O_SFCONV + (((size_t)l * 32 + ((r - NPROMPT) >> 2)) * 2 + (t - 2)) * DFF2 + col0; }
                    if (op) {
#pragma unroll
                        for (int bj = 0; bj < 2; ++bj) { *(pg8::f32x4*)(op + bj * 128) = acc[ai][bj][m][0]; *(pg8::f32x4*)(op + bj * 128 + 4) = acc[ai][bj][m][1]; }
                    }
                }
        }
    }
};

struct EpiIn {
    static constexpr bool PERM = true, AFTER_DRAIN = false;
    bf16* O; float* small; const float* rot; bf16* qb; bf16* kb; float* qr; float* kr; float* vd; float* out; int l, pad;
    __device__ __forceinline__ void attn_tiles(const pg8::f32x4 (&acc)[2][2][4][2], const pg8::Unit& u, int wr, int wc, int fr, int fq) const {
        const int row0 = u.pm * 256 + wr * 64 + fr, colt = wc * 32 + 8 * fq;
        const bool rotl = (u.pn <= 4) && ((wc & 1) == 0);
#pragma unroll
        for (int ai = 0; ai < 2; ++ai)
#pragma unroll
            for (int m = 0; m < 4; ++m) {
                const int r = row0 + ai * 128 + m * 16;
                const bool prompt = r < NPROMPT, dec = !prompt && r < MROWS;
                const int t = prompt ? (r & 4095) : ((r - NPROMPT) & 3), sq = prompt ? (r >> 12) : ((r - NPROMPT) >> 2);
                pg8::f32x4 cs[2], sn[2];
                if (rotl) { const float* rp = rot + (size_t)(prompt ? t : (dec ? 4096 + t : 0)) * 16;
                    const pg8::f32x4 a0 = *(const pg8::f32x4*)rp, a1 = *(const pg8::f32x4*)(rp + 4), a2 = *(const pg8::f32x4*)(rp + 8), a3 = *(const pg8::f32x4*)(rp + 12);
                    cs[0] = (pg8::f32x4){a0[0], a0[2], a1[0], a1[2]}; sn[0] = (pg8::f32x4){a0[1], a0[3], a1[1], a1[3]};
                    cs[1] = (pg8::f32x4){a2[0], a2[2], a3[0], a3[2]}; sn[1] = (pg8::f32x4){a2[1], a2[3], a3[1], a3[3]}; }
#pragma unroll
                for (int bj = 0; bj < 2; ++bj) {
                    pg8::f32x4 v[2] = {acc[ai][bj][m][0], acc[ai][bj][m][1]};
                    if (rotl) {
#pragma unroll
                        for (int n = 0; n < 2; ++n) {
                            pg8::f32x4 pt;
#pragma unroll
                            for (int e = 0; e < 4; ++e) pt[e] = __shfl_xor(v[n][e], 16);
                            if (fq == 0) v[n] = v[n] * cs[n] - pt * sn[n];
                            else if (fq == 1) v[n] = v[n] * cs[n] + pt * sn[n];
                        }
                    }
                    const int c = colt + bj * 128;
                    if (u.pn <= 3) {
                        const int cq = u.pn * 256 + c;
                        if (prompt) { pg8::u32x4 w; w.x = pk2(v[0][0], v[0][1]); w.y = pk2(v[0][2], v[0][3]); w.z = pk2(v[1][0], v[1][1]); w.w = pk2(v[1][2], v[1][3]); *(pg8::u32x4*)(qb + (size_t)r * 1024 + cq) = w; }
                        else if (dec) { *(pg8::f32x4*)(qr + (size_t)r * 1024 + cq) = v[0]; *(pg8::f32x4*)(qr + (size_t)r * 1024 + cq + 4) = v[1]; }
                    } else {
                        const bool isk = u.pn == 4;
                        if (prompt) {
                            pg8::u32x4 w; w.x = pk2(v[0][0], v[0][1]); w.y = pk2(v[0][2], v[0][3]); w.z = pk2(v[1][0], v[1][1]); w.w = pk2(v[1][2], v[1][3]);
                            if (isk) *(pg8::u32x4*)(kb + (size_t)r * 256 + c) = w; else *(pg8::u32x4*)(O + (size_t)r * PP + C_AV + c) = w;
                            if (t >= TP - 128) { float* op = out + (isk ? O_PK : O_PV) + (((size_t)l * 2 + sq) * 128 + (t - (TP - 128))) * 256 + c; *(pg8::f32x4*)op = v[0]; *(pg8::f32x4*)(op + 4) = v[1]; }
                        } else if (dec) {
                            float* dp = (isk ? kr + (size_t)r * 256 : vd + (size_t)(r - NPROMPT) * 256) + c; *(pg8::f32x4*)dp = v[0]; *(pg8::f32x4*)(dp + 4) = v[1];
                            float* op = out + (isk ? O_SK : O_SV) + (((size_t)l * 32 + sq) * 128 + 124 + t) * 256 + c; *(pg8::f32x4*)op = v[0]; *(pg8::f32x4*)(op + 4) = v[1];
                        }
                    }
                }
            }
    }
    __device__ __forceinline__ void operator()(const pg8::f32x4 (&acc)[2][2][4][2], const pg8::Unit& u, int wr, int wc, int fr, int fq) const {
        if (u.pn <= 5) { attn_tiles(acc, u, wr, wc, fr, fq); return; }
        const int row0 = u.pm * 256 + wr * 64 + fr, col0 = u.pn * 256 + wc * 32 + 8 * fq;
        const bool sm = wc == 0 && ((u.pn == 18 && fq < 2) || (u.pn == 34 && fq >= 2));
#pragma unroll
        for (int ai = 0; ai < 2; ++ai)
#pragma unroll
            for (int m = 0; m < 4; ++m) {
                const int r = row0 + ai * 128 + m * 16;
                bf16* rowp = O + (size_t)r * PP + col0;
#pragma unroll
                for (int bj = 0; bj < 2; ++bj) {
                    const pg8::f32x4 v0 = acc[ai][bj][m][0], v1 = acc[ai][bj][m][1];
                    pg8::u32x4 w; w.x = pk2(v0[0], v0[1]); w.y = pk2(v0[2], v0[3]); w.z = pk2(v1[0], v1[1]); w.w = pk2(v1[2], v1[3]);
                    *(pg8::u32x4*)(rowp + bj * 128) = w;
                }
                if (sm) { *(pg8::f32x4*)(small + (size_t)r * 32 + 8 * fq) = acc[ai][0][m][0]; *(pg8::f32x4*)(small + (size_t)r * 32 + 8 * fq + 4) = acc[ai][0][m][1]; }
            }
    }
};
struct EpiMix {
    static constexpr bool PERM = true, AFTER_DRAIN = false;
    const bf16* mg; float* accb; bf16* out;
    __device__ __forceinline__ void operator()(const pg8::f32x4 (&acc)[2][2][4][2], const pg8::Unit& u, int wr, int wc, int fr, int fq) const {
        const int row0 = u.pm * 256 + wr * 64 + fr, col0 = u.pn * 256 + wc * 32 + 8 * fq;
#pragma unroll
        for (int ai = 0; ai < 2; ++ai)
#pragma unroll
            for (int m = 0; m < 4; ++m) {
                const size_t r = (size_t)(row0 + ai * 128 + m * 16);
#pragma unroll
                for (int bj = 0; bj < 2; ++bj) {
                    const int col = col0 + bj * 128;
                    const u32x4v gw = *(const u32x4v*)(mg + r * PP + (size_t)u.z * D + col);
                    float gt[8];
                    gt[0] = __builtin_bit_cast(float, gw.x << 16); gt[1] = __builtin_bit_cast(float, gw.x & 0xffff0000u); gt[2] = __builtin_bit_cast(float, gw.y << 16); gt[3] = __builtin_bit_cast(float, gw.y & 0xffff0000u);
                    gt[4] = __builtin_bit_cast(float, gw.z << 16); gt[5] = __builtin_bit_cast(float, gw.z & 0xffff0000u); gt[6] = __builtin_bit_cast(float, gw.w << 16); gt[7] = __builtin_bit_cast(float, gw.w & 0xffff0000u);
                    pg8::f32x4 v0 = acc[ai][bj][m][0], v1 = acc[ai][bj][m][1];
#pragma unroll
                    for (int e = 0; e < 4; ++e) { v0[e] *= sigmoidf_(gt[e]); v1[e] *= sigmoidf_(gt[4 + e]); }
                    float* ap = accb + r * D + col;
                    if (u.z > 0) { v0 += *(const pg8::f32x4*)ap; v1 += *(const pg8::f32x4*)(ap + 4); }
                    if (u.z < 2) { *(pg8::f32x4*)ap = v0; *(pg8::f32x4*)(ap + 4) = v1; }
                    else { pg8::u32x4 w; w.x = pk2(v0[0], v0[1]); w.y = pk2(v0[2], v0[3]); w.z = pk2(v1[0], v1[1]); w.w = pk2(v1[2], v1[3]); *(pg8::u32x4*)(out + r * D + col) = w; }
                }
            }
    }
};
#define LAS __attribute__((address_space(3)))
#define XB_TMO      128
#define XB_XCNT(j)  (256  + 64 * (j))
#define XB_XSUB(j)  (1280 + 64 * (j))
#define XB_XGEN(j)  (2304 + 64 * (j))
#define XB_TOP      3328
#define XB_TOPGEN   3392
#define XCD_BAR_WORDS 3456
#define XB_SPIN_CAP (1u << 18)

__device__ __forceinline__ unsigned xb_ld(unsigned* p)              { return __hip_atomic_load(p, __ATOMIC_RELAXED, __HIP_MEMORY_SCOPE_AGENT); }
__device__ __forceinline__ unsigned xb_add(unsigned* p, unsigned v) { return __hip_atomic_fetch_add(p, v, __ATOMIC_RELAXED, __HIP_MEMORY_SCOPE_AGENT); }
__device__ __forceinline__ unsigned xb_xcc_id() { return (unsigned)__builtin_amdgcn_s_getreg((3 << 11) | 20) & 0xFu; }
#define XB_SPIN(cond, bar) do { unsigned _sp = 0; while (cond) { __builtin_amdgcn_s_sleep(1); \
    if ((++_sp & 255u) == 0u) { if (xb_ld(&(bar)[XB_TMO])) break; if (_sp > XB_SPIN_CAP) { atomicAdd(&(bar)[XB_TMO], 1u); break; } } } } while (0)

struct XcdBarrier {
    unsigned* bar; unsigned x;
    volatile LAS unsigned* st;
};

__device__ __forceinline__ XcdBarrier xcd_barrier_post(unsigned* bar, volatile LAS unsigned* st) {
    XcdBarrier b; b.bar = bar; b.x = xb_xcc_id(); b.st = st;
    if (threadIdx.x == 0) (void)xb_add(&bar[XB_XCNT(b.x)], 1u);
    return b;
}
__device__ __forceinline__ void xcd_barrier_complete(unsigned* bar, unsigned x, unsigned& nloc, unsigned& nx) {
    const unsigned G = gridDim.x * gridDim.y * gridDim.z;
    unsigned sum, cnt, mine, sp = 0u;
    for (;;) {
        sum = 0u; cnt = 0u; mine = 0u;
#pragma unroll
        for (unsigned j = 0; j < 16; ++j) { const unsigned c = xb_ld(&bar[XB_XCNT(j)]); sum += c; cnt += (c > 0u) ? 1u : 0u; mine = (j == x) ? c : mine; }
        if (sum == G) break;
        __builtin_amdgcn_s_sleep(1);
        if ((++sp & 255u) == 0u) { if (xb_ld(&bar[XB_TMO])) break; if (sp > XB_SPIN_CAP) { atomicAdd(&bar[XB_TMO], 1u); break; } }
    }
    nloc = mine > 0u ? mine : 1u; nx = cnt > 0u ? cnt : 1u;
}

__device__ __forceinline__ void xcd_barrier(const XcdBarrier& b) {
    asm volatile("s_waitcnt vmcnt(0)" ::: "memory");
    __syncthreads();
    if (threadIdx.x == 0) {
        unsigned* bar = b.bar;
        __builtin_amdgcn_s_waitcnt(0);
        unsigned nloc = b.st[0], nx = b.st[1];
        if (nloc == 0u) { xcd_barrier_complete(bar, b.x, nloc, nx); b.st[0] = nloc; b.st[1] = nx; }
        const unsigned old = xb_add(&bar[XB_XSUB(b.x)], 1u);
        const unsigned gen = old / nloc;
        if (old + 1u == (gen + 1u) * nloc) {
            __builtin_amdgcn_fence(__ATOMIC_RELEASE, "agent");
            asm volatile("s_waitcnt vmcnt(0)" ::: "memory");
            const unsigned og = xb_add(&bar[XB_TOP], 1u);
            const unsigned tg = og / nx;
            if (og + 1u == (tg + 1u) * nx) xb_add(&bar[XB_TOPGEN], 1u);
            else XB_SPIN(xb_ld(&bar[XB_TOPGEN]) == tg, bar);
            __builtin_amdgcn_fence(__ATOMIC_ACQUIRE, "agent");
            xb_add(&bar[XB_XGEN(b.x)], 1u);
            asm volatile("s_waitcnt vmcnt(0)" ::: "memory");
        } else {
            XB_SPIN(xb_ld(&bar[XB_XGEN(b.x)]) == gen, bar);
            __builtin_amdgcn_fence(__ATOMIC_ACQUIRE, "agent");
            asm volatile("s_waitcnt vmcnt(0)" ::: "memory");
        }
    }
    __syncthreads();
}

__device__ __forceinline__ void wT_load(const float* W, int K, int N, int n0, int k0, LAS float* tile, int t256) {
    const int tr = t256 >> 6, tc = t256 & 63;
#pragma unroll
    for (int i = 0; i < 16; ++i) { const int kk = tr + 4 * i; tile[kk * 65 + tc] = (n0 + tc < N) ? W[(size_t)(k0 + kk) * N + n0 + tc] : 0.f; }
}
__device__ __forceinline__ void wT_store(bf16* Bt, int K, int n0, int k0, const LAS float* tile, int t256) {
#pragma unroll
    for (int j = 0; j < 2; ++j) {
        const int id = t256 + 256 * j, nl = id >> 3, kc = id & 7;
        uint4 o;
        o.x = pk2(tile[(kc * 8 + 0) * 65 + nl], tile[(kc * 8 + 1) * 65 + nl]); o.y = pk2(tile[(kc * 8 + 2) * 65 + nl], tile[(kc * 8 + 3) * 65 + nl]);
        o.z = pk2(tile[(kc * 8 + 4) * 65 + nl], tile[(kc * 8 + 5) * 65 + nl]); o.w = pk2(tile[(kc * 8 + 6) * 65 + nl], tile[(kc * 8 + 7) * 65 + nl]);
        *(uint4*)(Bt + (size_t)(n0 + nl) * K + k0 + kc * 8) = o;
    }
}
constexpr int WT_IN = (15104 / 64) * (2048 / 64), WT_BR = 3 * (2048 / 64) * (1024 / 64), WT_OUT = (2048 / 64) * (2048 / 64), WT_UP = (11264 / 64) * (2048 / 64), WT_DN = (2048 / 64) * (5632 / 64);
constexpr int WT_LAYER = WT_IN + WT_BR + WT_OUT + WT_UP + WT_DN, WT_TOTAL = 4 * WT_LAYER;
struct WTile { const float* W; bf16* Bt; int K, N, n0, k0; };
__device__ __forceinline__ WTile wT_tile(const P& p, int id) {
    WTile w; const int l = id / WT_LAYER; int r = id % WT_LAYER;
    if (r < WT_IN) { w.W = p.in[8] + (size_t)l * 2048 * 14880; w.Bt = p.Win + (size_t)l * 15104 * 2048; w.K = 2048; w.N = 14880; w.n0 = (r / 32) * 64; w.k0 = (r % 32) * 64; return w; }
    r -= WT_IN;
    if (r < WT_BR) { const int b = r / 512, q = r % 512; w.W = p.in[17] + ((size_t)l * 3 + b) * 1024 * 2048; w.Bt = p.Wbr + ((size_t)l * 3 + b) * 2048 * 1024; w.K = 1024; w.N = 2048; w.n0 = (q / 16) * 64; w.k0 = (q % 16) * 64; return w; }
    r -= WT_BR;
    if (r < WT_OUT) { w.W = p.in[18] + (size_t)l * 2048 * 2048; w.Bt = p.Wout + (size_t)l * 2048 * 2048; w.K = 2048; w.N = 2048; w.n0 = (r / 32) * 64; w.k0 = (r % 32) * 64; return w; }
    r -= WT_OUT;
    if (r < WT_UP) { w.W = p.in[21] + (size_t)l * 2048 * 11264; w.Bt = p.Wup + (size_t)l * 11264 * 2048; w.K = 2048; w.N = 11264; w.n0 = (r / 32) * 64; w.k0 = (r % 32) * 64; return w; }
    r -= WT_UP;
    w.W = p.in[23] + (size_t)l * 5632 * 2048; w.Bt = p.Wdn + (size_t)l * 2048 * 5632; w.K = 5632; w.N = 2048; w.n0 = (r / 88) * 64; w.k0 = (r % 88) * 64; return w;
}
__device__ __forceinline__ void wT_wave_task(const P& p, int id, int lane) {
    const WTile w = wT_tile(p, id);
    const int n = w.n0 + lane; const bool ok = n < w.N;
    const float* q = w.W + (size_t)w.k0 * w.N + (ok ? n : 0);
    float v[64];
#pragma unroll
    for (int kk = 0; kk < 64; ++kk) { v[kk] = *q; q += w.N; }
    bf16* o = w.Bt + (size_t)n * w.K + w.k0;
#pragma unroll
    for (int j = 0; j < 8; ++j) { u32x4v x; x.x = pk2(v[8 * j], v[8 * j + 1]); x.y = pk2(v[8 * j + 2], v[8 * j + 3]); x.z = pk2(v[8 * j + 4], v[8 * j + 5]); x.w = pk2(v[8 * j + 6], v[8 * j + 7]);
        if (!ok) x = (u32x4v){0u, 0u, 0u, 0u};
        *(u32x4v*)(o + 8 * j) = x; }
}
__device__ __forceinline__ void xinit_phase(const P& p, size_t i0, size_t stride) {
    const size_t n = (size_t)MROWS * D / 4;
    for (size_t i = i0; i < n; i += stride) {
        const size_t e = i * 4;
        const float4 v = e < (size_t)NPROMPT * D ? *(const float4*)(p.in[0] + e) : *(const float4*)(p.in[1] + (e - (size_t)NPROMPT * D));
        *(float4*)(p.X + e) = v;
        *(uint2*)(p.Xb + e) = make_uint2(pk2(v.x, v.y), pk2(v.z, v.w));
    }
}

__device__ __forceinline__ float sin_rev(float x) {
    x -= floorf(x);
    float y = x > 0.5f ? x - 1.0f : x;
    y = y > 0.25f ? 0.5f - y : (y < -0.25f ? -0.5f - y : y);
    const float a = y * 6.283185307179586f, a2 = a * a;
    float p = -2.5052108385441718e-08f;
    p = fmaf(p, a2, 2.7557319223985893e-06f);
    p = fmaf(p, a2, -1.984126984126984e-04f);
    p = fmaf(p, a2, 8.333333333333333e-03f);
    p = fmaf(p, a2, -1.6666666666666666e-01f);
    return fmaf(a * a2, p, a);
}
__device__ __forceinline__ double rot_inv_rev(int i) {
    const double t[8] = {0.15915494309189535, 0.03086376340470123, 0.005985185712713705, 0.001160663641240061,
                         0.00022507907903927653, 4.364795279280289e-05, 8.464330808241401e-06, 1.6414262627950345e-06};
    double r = t[0];
#pragma unroll
    for (int k = 1; k < 8; ++k) r = (i == k) ? t[k] : r;
    return r;
}
__device__ __forceinline__ void prep_task(const P& p, int l, int r, int part, int lane) {
    const bf16* pr = p.PROJ + (size_t)r * PP;
    const int s = row_seq(r), t = row_t(r);
    const float* cw = p.in[13] + (size_t)l * 4 * 3072;
    const int r0 = seq_row0(s);
    {
        const int hh = part - 1;
        float v2[2];
#pragma unroll
        for (int i = 0; i < 2; ++i) {
            const int c = hh * 128 + lane + 64 * i;
            float y = 0.f;
#pragma unroll
            for (int j = 0; j < 4; ++j) {
                const int tt = t - 3 + j;
                float xv;
                if (tt >= 0) xv = ldbf(p.PROJ + (size_t)(r0 + tt) * PP + C_CQKV + c);
                else xv = s < 2 ? 0.f : p.in[6][(((size_t)l * 32 + (s - 2)) * 3 + (3 + tt)) * 3072 + c];
                y = fmaf(cw[j * 3072 + c], xv, y);
            }
            v2[i] = siluf_(y);
        }
        if (hh < 16) {
            const float ss = wave_sum(v2[0] * v2[0] + v2[1] * v2[1]);
            float sc = __builtin_amdgcn_rsqf(ss + 1e-6f);
            if (hh < 8) sc *= 0.08838834764831845f;
            v2[0] *= sc; v2[1] *= sc;
        }
        p.DQKV[(size_t)r * 3072 + hh * 128 + lane] = v2[0];
        p.DQKV[(size_t)r * 3072 + hh * 128 + lane + 64] = v2[1];
    }
}

constexpr int PREP_ROWS = 5;
__device__ __forceinline__ void prep_rows_task(const P& p, int l, int rb, int lane) {
    float blr[PREP_ROWS][16];
#pragma unroll
    for (int rr = 0; rr < PREP_ROWS; ++rr)
#pragma unroll
        for (int j = 0; j < 16; ++j) blr[rr][j] = p.SMALL[(size_t)(rb + rr) * 32 + j];
    const float* Wg = p.in[10] + (size_t)l * 16 * 512; const float* bg = p.in[11] + (size_t)l * 512;
#pragma unroll 2
    for (int c = lane; c < 512; c += 64) {
        float wg[16]; const float b = bg[c];
#pragma unroll
        for (int j = 0; j < 16; ++j) wg[j] = Wg[j * 512 + c];
#pragma unroll
        for (int rr = 0; rr < PREP_ROWS; ++rr) {
            float z = b;
#pragma unroll
            for (int j = 0; j < 16; ++j) z = fmaf(blr[rr][j], wg[j], z);
            const float ls = fminf(z, 0.f) - __logf(1.f + __expf(-fabsf(z)));
            p.AG[(size_t)(rb + rr) * 512 + c] = ls * (1.f / 16.f);
        }
    }
    if (lane < 8 * PREP_ROWS) {
        const int rr = lane >> 3, hd = lane & 7, r = rb + rr;
        const float a_log = p.in[14][l * 8 + hd], dtb = p.in[15][l * 8 + hd];
        p.G[(size_t)r * 8 + hd] = -__expf(a_log) * softplusf_(p.SMALL[(size_t)r * 32 + 16 + hd] + dtb);
        p.BETA[(size_t)r * 8 + hd] = sigmoidf_(p.SMALL[(size_t)r * 32 + 24 + hd]);
    }
#pragma unroll 1
    for (int rr = 0; rr < PREP_ROWS; ++rr) {
        const int r = rb + rr, s = row_seq(r), t = row_t(r);
        int oi = -1; size_t ob = 0;
        if (s < 2) { if (t >= TP - 3) { oi = t - (TP - 3); ob = O_PDCONV + ((size_t)l * 2 + s) * 3 * 3072; } }
        else if (t >= 1) { oi = t - 1; ob = O_SDCONV + ((size_t)l * 32 + (s - 2)) * 3 * 3072; }
        if (oi >= 0) {
            const bf16* pr = p.PROJ + (size_t)r * PP;
#pragma unroll 1
            for (int c = lane * 4; c < 3072; c += 256) *(f32x4v*)(p.out + ob + (size_t)oi * 3072 + c) = ldbf4(pr + C_CQKV + c);
        }
    }
}
constexpr int CONV_ROWS = 16;
__device__ __forceinline__ void prep_conv_task(const P& p, int l, int task, int lane) {
    const int rg = task / 12, sl = task - rg * 12, c = sl * 256 + lane * 4, ra = rg * CONV_ROWS, t0 = ra & 4095;
    const float* cw = p.in[13] + (size_t)l * 4 * 3072;
    f32x4v x[CONV_ROWS + 3], w[4];
#pragma unroll
    for (int i = 0; i < CONV_ROWS + 3; ++i) {
        if (i < 3 && t0 == 0) x[i] = (f32x4v){0.f, 0.f, 0.f, 0.f};
        else x[i] = ldbf4(p.PROJ + (size_t)(ra - 3 + i) * PP + C_CQKV + c);
    }
#pragma unroll
    for (int j = 0; j < 4; ++j) w[j] = *(const f32x4v*)(cw + j * 3072 + c);
#pragma unroll
    for (int i = 0; i < CONV_ROWS; ++i) {
        f32x4v y = w[0] * x[i] + w[1] * x[i + 1] + w[2] * x[i + 2] + w[3] * x[i + 3];
        y.x = siluf_(y.x); y.y = siluf_(y.y); y.z = siluf_(y.z); y.w = siluf_(y.w);
        if (sl < 8) {
            float ss = y.x * y.x + y.y * y.y + y.z * y.z + y.w * y.w;
            ss = row16_sum(ss); ss += __shfl_xor(ss, 16);
            float sc = __builtin_amdgcn_rsqf(ss + 1e-6f);
            if (sl < 4) sc *= 0.08838834764831845f;
            y = y * sc;
        }
        *(f32x4v*)(p.DQKV + (size_t)(ra + i) * 3072 + c) = y;
    }
}
__device__ __forceinline__ bool kv_ptrs(const P& p, int l, int s, int t, int g, int j, const float*& kp, const float*& vp) {
    kp = nullptr; vp = nullptr;
    if (j > 128) return false;
    if (s < 2) {
        const int tk = t - 128 + j;
        if (tk < 0) return false;
        const size_t rr = (size_t)(s * TP + tk);
        kp = p.KR + rr * 256 + g * 64; vp = nullptr; return true;
    }
    const int jj = t + j;
    if (jj < 128) { const size_t o = ((((size_t)l * 32 + (s - 2)) * 128 + jj) * 4 + g) * 64; kp = p.in[2] + o; vp = p.in[3] + o; }
    else { const size_t rr = (size_t)(NPROMPT + (s - 2) * TD + (jj - 128)); kp = p.KR + rr * 256 + g * 64; vp = p.VD + (rr - NPROMPT) * 256 + g * 64; }
    return true;
}
__device__ __forceinline__ void attn_task(const P& p, int l, int r, int g, int lane) {
    const int s = row_seq(r), t = row_t(r);
    const float *k0, *k1, *k2, *vdummy;
    const bool ok0 = kv_ptrs(p, l, s, t, g, lane, k0, vdummy);
    const bool ok1 = kv_ptrs(p, l, s, t, g, lane + 64, k1, vdummy);
    const bool ok2 = kv_ptrs(p, l, s, t, g, lane + 128, k2, vdummy);
    float sc0[4] = {0, 0, 0, 0}, sc1[4] = {0, 0, 0, 0}, sc2[4] = {0, 0, 0, 0};
    const float* qp = p.QR + (size_t)r * 1024 + g * 256;
    for (int d4 = 0; d4 < 16; ++d4) {
        const float4 z4 = make_float4(0, 0, 0, 0);
        const float4 a = ok0 ? *(const float4*)(k0 + d4 * 4) : z4;
        const float4 b = ok1 ? *(const float4*)(k1 + d4 * 4) : z4;
        const float4 c = ok2 ? *(const float4*)(k2 + d4 * 4) : z4;
#pragma unroll
        for (int h = 0; h < 4; ++h) {
            const float4 qv = *(const float4*)(qp + h * 64 + d4 * 4);
            sc0[h] += qv.x * a.x + qv.y * a.y + qv.z * a.z + qv.w * a.w;
            sc1[h] += qv.x * b.x + qv.y * b.y + qv.z * b.z + qv.w * b.w;
            sc2[h] += qv.x * c.x + qv.y * c.y + qv.z * c.z + qv.w * c.w;
        }
    }
    float p0[4], p1[4], p2[4], den[4];
#pragma unroll
    for (int h = 0; h < 4; ++h) {
        const float sink = p.in[9][l * 16 + g * 4 + h];
        float m = sink;
        sc0[h] *= 0.125f; sc1[h] *= 0.125f; sc2[h] *= 0.125f;
        if (ok0) m = fmaxf(m, sc0[h]);
        if (ok1) m = fmaxf(m, sc1[h]);
        if (ok2) m = fmaxf(m, sc2[h]);
        m = wave_max(m);
        p0[h] = ok0 ? __expf(sc0[h] - m) : 0.f; p1[h] = ok1 ? __expf(sc1[h] - m) : 0.f; p2[h] = ok2 ? __expf(sc2[h] - m) : 0.f;
        den[h] = wave_sum(p0[h] + p1[h] + p2[h]) + __expf(sink - m);
    }
    float o[4] = {0.f, 0.f, 0.f, 0.f};
    {
        const float* cvb = p.in[3] + ((((size_t)l * 32 + (s - 2)) * 128) * 4 + g) * 64 + lane;
        const float* vdb = p.VD + (size_t)((s - 2) * TD) * 256 + g * 64 + lane;
        const int ncache = 128 - t;
#pragma unroll 1
        for (int j0 = 0; j0 < 128; j0 += 8) {
            float vv[8];
#pragma unroll
            for (int e = 0; e < 8; ++e) { const int j = j0 + e; vv[e] = j < ncache ? cvb[(size_t)(t + j) * 256] : vdb[(size_t)(t + j - 128) * 256]; }
#pragma unroll
            for (int e = 0; e < 8; ++e) { const int j = j0 + e, jl = j & 63;
#pragma unroll
                for (int h = 0; h < 4; ++h) { const float pj = j0 < 64 ? __shfl(p0[h], jl) : __shfl(p1[h], jl); o[h] = fmaf(pj, vv[e], o[h]); } }
        }
        { const float vv = vdb[(size_t)t * 256];
#pragma unroll
          for (int h = 0; h < 4; ++h) o[h] = fmaf(__shfl(p2[h], 0), vv, o[h]); }
    }
#pragma unroll
    for (int h = 0; h < 4; ++h) p.OAb[(size_t)r * 1024 + (g * 4 + h) * 64 + lane] = (bf16)f2bf(o[h] / den[h]);
    if (s >= 2 && t == 0) {
        const size_t b0 = ((((size_t)l * 32 + (s - 2)) * 128) * 4 + g) * 64 + lane;
#pragma unroll 1
        for (int i0 = 0; i0 < 124; i0 += 4) {
            float kk[4], vv[4];
#pragma unroll
            for (int e = 0; e < 4; ++e) { kk[e] = p.in[2][b0 + (size_t)(i0 + e + 4) * 256]; vv[e] = p.in[3][b0 + (size_t)(i0 + e + 4) * 256]; }
#pragma unroll
            for (int e = 0; e < 4; ++e) { p.out[O_SK + b0 + (size_t)(i0 + e) * 256] = kk[e]; p.out[O_SV + b0 + (size_t)(i0 + e) * 256] = vv[e]; }
        }
    }
}
__device__ __forceinline__ void gla_task(const P& p, int l, int s, int h, int sl, int lane) {
    const int dkg = lane >> 3, c = lane & 7, col = sl * 8 + c;
    const float* st = p.in[4] + ((((size_t)l * 32 + (s - 2)) * 4 + h) * 128) * 256;
    float S[16];
#pragma unroll
    for (int i = 0; i < 16; ++i) S[i] = st[(size_t)(dkg * 16 + i) * 256 + col];
    const size_t r0 = (size_t)seq_row0(s);
    f32x4v a[TD][4], k[TD][4], q[TD][4]; float v[TD], o[TD];
#pragma unroll
    for (int t = 0; t < TD; ++t) {
        const bf16* pr = p.PROJ + (r0 + t) * PP;
        v[t] = ldbf(pr + C_BV + h * 256 + col);
#pragma unroll
        for (int i4 = 0; i4 < 4; ++i4) {
            a[t][i4] = *(const f32x4v*)(p.AG + (r0 + t) * 512 + h * 128 + dkg * 16 + 4 * i4);
            k[t][i4] = ldbf4(pr + C_BK + h * 128 + dkg * 16 + 4 * i4); q[t][i4] = ldbf4(pr + C_BQ + h * 128 + dkg * 16 + 4 * i4);
        }
    }
#pragma unroll
    for (int t = 0; t < TD; ++t) {
        float ot = 0.f;
#pragma unroll
        for (int i4 = 0; i4 < 4; ++i4) {
            S[4 * i4 + 0] = fmaf(S[4 * i4 + 0], __expf(a[t][i4].x), k[t][i4].x * v[t]); ot = fmaf(q[t][i4].x, S[4 * i4 + 0], ot);
            S[4 * i4 + 1] = fmaf(S[4 * i4 + 1], __expf(a[t][i4].y), k[t][i4].y * v[t]); ot = fmaf(q[t][i4].y, S[4 * i4 + 1], ot);
            S[4 * i4 + 2] = fmaf(S[4 * i4 + 2], __expf(a[t][i4].z), k[t][i4].z * v[t]); ot = fmaf(q[t][i4].z, S[4 * i4 + 2], ot);
            S[4 * i4 + 3] = fmaf(S[4 * i4 + 3], __expf(a[t][i4].w), k[t][i4].w * v[t]); ot = fmaf(q[t][i4].w, S[4 * i4 + 3], ot);
        }
        ot += __shfl_xor(ot, 8); ot += __shfl_xor(ot, 16); ot += __shfl_xor(ot, 32);
        o[t] = ot * 0.08838834764831845f;
    }
    if (dkg == 0) {
#pragma unroll
        for (int t = 0; t < TD; ++t) p.OBRAW[(r0 + t) * 1024 + h * 256 + col] = o[t];
    }
    float* so = p.out + O_SGLA + ((((size_t)l * 32 + (s - 2)) * 4 + h) * 128) * 256;
#pragma unroll
    for (int i = 0; i < 16; ++i) so[(size_t)(dkg * 16 + i) * 256 + col] = S[i];
}
__device__ __forceinline__ void delta_task(const P& p, int l, int s, int h, int sl, int lane) {
    const int dkg = lane >> 3, c = lane & 7, col = sl * 8 + c;
    const float* st = p.in[5] + ((((size_t)l * 32 + (s - 2)) * 8 + h) * 128) * 128;
    float S[16];
#pragma unroll
    for (int i = 0; i < 16; ++i) S[i] = st[(size_t)(dkg * 16 + i) * 128 + col];
    const size_t r0 = (size_t)seq_row0(s);
    f32x4v k[TD][4], q[TD][4]; float v[TD], g[TD], be[TD], o[TD];
#pragma unroll
    for (int t = 0; t < TD; ++t) {
        const float* dq = p.DQKV + (r0 + t) * 3072 + h * 128 + dkg * 16;
        v[t] = dq[2048 - dkg * 16 + col]; g[t] = p.G[(r0 + t) * 8 + h]; be[t] = p.BETA[(r0 + t) * 8 + h];
#pragma unroll
        for (int i4 = 0; i4 < 4; ++i4) { q[t][i4] = *(const f32x4v*)(dq + 4 * i4); k[t][i4] = *(const f32x4v*)(dq + 1024 + 4 * i4); }
    }
#pragma unroll
    for (int t = 0; t < TD; ++t) {
        const float a = __expf(g[t]);
        float kS = 0.f, qS = 0.f, qk = 0.f;
#pragma unroll
        for (int i4 = 0; i4 < 4; ++i4)
#pragma unroll
            for (int e = 0; e < 4; ++e) { kS = fmaf(k[t][i4][e], S[4 * i4 + e], kS); qS = fmaf(q[t][i4][e], S[4 * i4 + e], qS); qk = fmaf(q[t][i4][e], k[t][i4][e], qk); }
        kS += __shfl_xor(kS, 8); kS += __shfl_xor(kS, 16); kS += __shfl_xor(kS, 32);
        qS += __shfl_xor(qS, 8); qS += __shfl_xor(qS, 16); qS += __shfl_xor(qS, 32);
        qk += __shfl_xor(qk, 8); qk += __shfl_xor(qk, 16); qk += __shfl_xor(qk, 32);
        const float u = be[t] * (v[t] - a * kS);
#pragma unroll
        for (int i4 = 0; i4 < 4; ++i4)
#pragma unroll
            for (int e = 0; e < 4; ++e) S[4 * i4 + e] = fmaf(a, S[4 * i4 + e], k[t][i4][e] * u);
        o[t] = a * qS + qk * u;
    }
    if (dkg == 0) {
#pragma unroll
        for (int t = 0; t < TD; ++t) p.OCRAW[(r0 + t) * 1024 + h * 128 + col] = o[t];
    }
    float* so = p.out + O_SDELTA + ((((size_t)l * 32 + (s - 2)) * 8 + h) * 128) * 128;
#pragma unroll
    for (int i = 0; i < 16; ++i) so[(size_t)(dkg * 16 + i) * 128 + col] = S[i];
}
__device__ __forceinline__ void scan_task(const P& p, int l, int task, int lane) {
    if (task < 256) { gla_task(p, l, task >> 7, (task >> 5) & 3, task & 31, lane); return; }
    task -= 256;
    if (task < 256) { delta_task(p, l, task >> 7, (task >> 4) & 7, task & 15, lane); return; }
    task -= 256;
    if (task < 4096) { gla_task(p, l, 2 + (task >> 7), (task >> 5) & 3, task & 31, lane); return; }
    task -= 4096;
    delta_task(p, l, 2 + (task >> 7), (task >> 4) & 7, task & 15, lane);
}
constexpr int N_SCAN_TASKS = 512 + 8192;

constexpr int CH = 64, NCH = TP / CH;
__device__ __forceinline__ f32x16 mma32(bf16x8 a, bf16x8 b, f32x16 c) { return __builtin_amdgcn_mfma_f32_32x32x16_bf16(a, b, c, 0, 0, 0); }
__device__ __forceinline__ int acc_row(int reg, int hh) { return (reg & 3) + 8 * (reg >> 2) + 4 * hh; }
__device__ __forceinline__ f32x16 zero16() { f32x16 z;
#pragma unroll
    for (int i = 0; i < 16; ++i) z[i] = 0.f;
    return z; }
__device__ __forceinline__ float bf2f(unsigned b) { return __builtin_bit_cast(float, b << 16); }
#define LDS_WAIT() asm volatile("s_waitcnt lgkmcnt(0)" ::: "memory")


__device__ __forceinline__ void attn_prompt_task(const P& p, int l, int s, int qb, int h, LAS unsigned char* ldsw, int lane) {
    LAS bf16* PT = (LAS bf16*)ldsw;
    const int r = lane & 31, hh = lane >> 5, g = h >> 2, q0 = 32 * qb;
    bf16x8 qf[4];
#pragma unroll
    for (int ks = 0; ks < 4; ++ks) qf[ks] = *(const bf16x8*)(p.QB16 + (size_t)(s * TP + q0 + r) * 1024 + h * 64 + 16 * ks + 8 * hh);
    f32x16 st[5];
#pragma unroll
    for (int kt = 0; kt < 5; ++kt) {
        int pk = q0 - 128 + 32 * kt + r; pk = pk < 0 ? 0 : pk;
        st[kt] = zero16();
#pragma unroll
        for (int ks = 0; ks < 4; ++ks) { const bf16x8 kf = *(const bf16x8*)(p.KB16 + (size_t)(s * TP + pk) * 256 + g * 64 + 16 * ks + 8 * hh); st[kt] = mma32(kf, qf[ks], st[kt]); }
    }
    const float sink = p.in[9][l * 16 + h];
    float m = sink;
#pragma unroll
    for (int kt = 0; kt < 5; ++kt)
#pragma unroll
        for (int reg = 0; reg < 16; ++reg) {
            const int kk = 32 * kt + acc_row(reg, hh);
            const bool valid = (kk >= r) && (kk <= r + 128) && (q0 - 128 + kk >= 0);
            const float v = valid ? st[kt][reg] * 0.125f : -3.0e38f;
            st[kt][reg] = v; m = fmaxf(m, v);
        }
    m = fmaxf(m, __shfl_xor(m, 32));
    float sum = 0.f;
#pragma unroll
    for (int kt = 0; kt < 5; ++kt)
#pragma unroll
        for (int reg = 0; reg < 16; ++reg) { const float e = st[kt][reg] > -1.0e38f ? __expf(st[kt][reg] - m) : 0.f; st[kt][reg] = e; sum += e; }
    sum += __shfl_xor(sum, 32);
    const float inv = 1.f / (sum + __expf(sink - m));
    f32x16 o[2]; o[0] = zero16(); o[1] = zero16();
#pragma unroll
    for (int kt = 0; kt < 5; ++kt) {
#pragma unroll
        for (int gq = 0; gq < 4; ++gq) { u32x2v w; w.x = pk2(st[kt][4 * gq], st[kt][4 * gq + 1]); w.y = pk2(st[kt][4 * gq + 2], st[kt][4 * gq + 3]); *(LAS u32x2v*)(PT + r * 40 + 8 * gq + 4 * hh) = w; }
        LDS_WAIT();
#pragma unroll
        for (int ks = 0; ks < 2; ++ks) {
            const bf16x8 pf = *(const LAS bf16x8*)(PT + r * 40 + 16 * ks + 8 * hh);
            int p0 = q0 - 128 + 32 * kt + 16 * ks + 8 * hh; p0 = p0 < 0 ? 0 : p0;
#pragma unroll
            for (int dt = 0; dt < 2; ++dt) { const bf16x8 vf = *(const bf16x8*)(p.VT16 + ((size_t)(s * 4 + g) * 64 + 32 * dt + r) * TP + p0); o[dt] = mma32(vf, pf, o[dt]); }
        }
        LDS_WAIT();
    }
#pragma unroll
    for (int dt = 0; dt < 2; ++dt)
#pragma unroll
        for (int gq = 0; gq < 4; ++gq) { u32x2v w; w.x = pk2(o[dt][4 * gq] * inv, o[dt][4 * gq + 1] * inv); w.y = pk2(o[dt][4 * gq + 2] * inv, o[dt][4 * gq + 3] * inv);
            *(u32x2v*)(p.OAb + (size_t)(s * TP + q0 + r) * 1024 + h * 64 + 32 * dt + 8 * gq + 4 * hh) = w; }
}
__device__ __forceinline__ void vt_task(const P& p, int task, LAS unsigned char* ldsw, int lane) {
    const int s = task >> 8, n = (task >> 2) & 63, g = task & 3, r0 = s * TP + n * CH;
    LAS bf16* tile = (LAS bf16*)ldsw;
    { bf16 vv[64];
#pragma unroll
      for (int t = 0; t < 64; ++t) vv[t] = p.PROJ[(size_t)(r0 + t) * PP + C_AV + g * 64 + lane];
#pragma unroll
      for (int t = 0; t < 64; ++t) tile[t * 66 + lane] = vv[t]; }
    LDS_WAIT();
#pragma unroll
    for (int tg = 0; tg < 8; ++tg) { u32x4v w;
        w.x = (unsigned)tile[(8 * tg + 0) * 66 + lane] | ((unsigned)tile[(8 * tg + 1) * 66 + lane] << 16); w.y = (unsigned)tile[(8 * tg + 2) * 66 + lane] | ((unsigned)tile[(8 * tg + 3) * 66 + lane] << 16);
        w.z = (unsigned)tile[(8 * tg + 4) * 66 + lane] | ((unsigned)tile[(8 * tg + 5) * 66 + lane] << 16); w.w = (unsigned)tile[(8 * tg + 6) * 66 + lane] | ((unsigned)tile[(8 * tg + 7) * 66 + lane] << 16);
        *(u32x4v*)(p.VT16 + ((size_t)(s * 4 + g) * 64 + lane) * TP + n * CH + 8 * tg) = w; }
    LDS_WAIT();
}

__device__ __forceinline__ void gla_prepass(const P& p, int ch, LAS unsigned char* lds, int tid) {
    const int s = ch >> 8, n = (ch >> 2) & 63, h = ch & 3, r0 = s * TP + n * CH;
    LAS bf16* QTs = (LAS bf16*)lds;
    LAS bf16* KTs = (LAS bf16*)(lds + 17408);
    LAS bf16* VTs = (LAS bf16*)(lds + 34816);
    LAS bf16* As = (LAS bf16*)(lds + 71680);
    LAS float* PART = (LAS float*)(lds + 80896);
    const int lane = tid & 63, wave = tid >> 6;
    {
        const int dk = tid & 127, part = tid >> 7;
        float gl[16]; bf16 qr[16], kr[16], vr[32]; float sum = 0.f;
#pragma unroll
        for (int i = 0; i < 16; ++i) gl[i] = p.AG[(size_t)(r0 + part * 16 + i) * 512 + h * 128 + dk];
#pragma unroll
        for (int i = 0; i < 16; ++i) { const bf16* pr = p.PROJ + (size_t)(r0 + part * 16 + i) * PP; qr[i] = pr[C_BQ + h * 128 + dk]; kr[i] = pr[C_BK + h * 128 + dk]; }
#pragma unroll
        for (int i = 0; i < 32; ++i) { const int e = tid + 512 * i, t = e >> 8, dv = e & 255; vr[i] = p.PROJ[(size_t)(r0 + t) * PP + C_BV + h * 256 + dv]; }
#pragma unroll
        for (int i = 0; i < 16; ++i) sum += gl[i];
        PART[part * 128 + dk] = sum;
        __syncthreads();
        float pre = 0.f, tot = 0.f;
#pragma unroll
        for (int pp = 0; pp < 4; ++pp) { const float v = PART[pp * 128 + dk]; tot += v; pre += pp < part ? v : 0.f; }
        float b = pre;
#pragma unroll
        for (int i = 0; i < 16; ++i) {
            const int t = part * 16 + i; b += gl[i];
            const float q = bf2f(qr[i]), k = bf2f(kr[i]);
            QTs[t * 136 + dk] = (bf16)f2bf(q * 0.08838834764831845f * __expf(b));
            KTs[t * 136 + dk] = (bf16)f2bf(k * __expf(-b));
        }
        if (part == 0) p.GDEC[(size_t)ch * 128 + dk] = __expf(tot);
#pragma unroll
        for (int i = 0; i < 32; ++i) { const int e = tid + 512 * i, t = e >> 8, dv = e & 255; VTs[dv * 72 + t] = vr[i]; }
    }
    __syncthreads();
#pragma unroll
    for (int i = 0; i < 2; ++i) { const int c = tid + 512 * i, t = c >> 4, c8 = (c & 15) * 8; *(u32x4v*)(p.GQT + ((size_t)ch * 64 + t) * 128 + c8) = *(const LAS u32x4v*)(QTs + t * 136 + c8); }
#pragma unroll
    for (int i = 0; i < 2; ++i) { const int c = tid + 512 * i, dk = c & 127, tg = c >> 7; uint4 w;
        w.x = (unsigned)KTs[(8 * tg + 0) * 136 + dk] | ((unsigned)KTs[(8 * tg + 1) * 136 + dk] << 16); w.y = (unsigned)KTs[(8 * tg + 2) * 136 + dk] | ((unsigned)KTs[(8 * tg + 3) * 136 + dk] << 16);
        w.z = (unsigned)KTs[(8 * tg + 4) * 136 + dk] | ((unsigned)KTs[(8 * tg + 5) * 136 + dk] << 16); w.w = (unsigned)KTs[(8 * tg + 6) * 136 + dk] | ((unsigned)KTs[(8 * tg + 7) * 136 + dk] << 16);
        *(uint4*)(p.GKT + ((size_t)ch * 128 + dk) * 64 + 8 * tg) = w; }
#pragma unroll
    for (int i = 0; i < 4; ++i) { const int c = tid + 512 * i, dv = c >> 3, tg = c & 7; *(u32x4v*)(p.GVT + ((size_t)ch * 256 + dv) * 64 + 8 * tg) = *(const LAS u32x4v*)(VTs + dv * 72 + 8 * tg); }
    if (wave < 4) {
        const int ti = wave >> 1, tj = wave & 1, r = lane & 31, hh = lane >> 5;
        f32x16 acc = zero16();
        if (!(ti == 0 && tj == 1)) {
#pragma unroll
            for (int ks = 0; ks < 8; ++ks) {
                const bf16x8 a = *(const LAS bf16x8*)(QTs + (32 * ti + r) * 136 + 16 * ks + 8 * hh);
                const bf16x8 b = *(const LAS bf16x8*)(KTs + (32 * tj + r) * 136 + 16 * ks + 8 * hh);
                acc = mma32(a, b, acc);
            }
        }
#pragma unroll
        for (int reg = 0; reg < 16; ++reg) { const int tr = 32 * ti + acc_row(reg, hh), sc = 32 * tj + r; As[tr * 72 + sc] = (bf16)f2bf(tr >= sc ? acc[reg] : 0.f); }
    }
    __syncthreads();
    { const int t = tid >> 3, c8 = (tid & 7) * 8; *(u32x4v*)(p.GA + ((size_t)ch * 64 + t) * 64 + c8) = *(const LAS u32x4v*)(As + t * 72 + c8); }
    __syncthreads();
}

#define DMA16(gptr, lptr) __builtin_amdgcn_global_load_lds((const unsigned*)(gptr), (LAS unsigned*)(lptr), 16, 0, 0)
#define VM_WAIT_N(n) asm volatile("s_waitcnt vmcnt(" #n ")" ::: "memory")
#define FRAG16(buf, f, lane) (*(const LAS bf16x8*)((buf) + (f) * 1024 + (lane) * 16))
#define FRAGF4(buf, f, lane) (*(const LAS f32x4v*)((buf) + (f) * 1024 + (lane) * 16))
#ifndef SCAN_LOADERS
#define SCAN_LOADERS 1
#endif
constexpr int SCAN_FLAGS_OFF = 13312;
template <bool SLEEP = false> __device__ __forceinline__ bool lds_wait_ge(volatile LAS unsigned* w, unsigned need, volatile LAS unsigned* abortw) {
    unsigned sp = 0; bool ok = true;
    while (*w < need) { if (SLEEP) __builtin_amdgcn_s_sleep(1); if ((++sp & 1023u) == 0u) { if (*abortw != 0u) { ok = false; break; } if (sp > (1u << 22)) { *abortw = 1u; ok = false; break; } } }
    __builtin_amdgcn_fence(__ATOMIC_ACQUIRE, "workgroup");
    asm volatile("" ::: "memory");
    return ok;
}
__device__ __forceinline__ void gla_issue_A_half(const P& p, int ch, int sl, LAS unsigned char* bufA, int r, int hh, int ti) {
    if (ti == 0) {
#pragma unroll
        for (int ks = 0; ks < 4; ++ks) DMA16(p.GVT + ((size_t)ch * 256 + 32 * sl + r) * 64 + 16 * ks + 8 * hh, bufA + ks * 1024);
    }
#pragma unroll
    for (int ks = 0; ks < 8; ++ks) DMA16(p.GQT + ((size_t)ch * 64 + 32 * ti + r) * 128 + 16 * ks + 8 * hh, bufA + (4 + ti * 8 + ks) * 1024);
#pragma unroll
    for (int ks = 0; ks < 4; ++ks) DMA16(p.GA + ((size_t)ch * 64 + 32 * ti + r) * 64 + 16 * ks + 8 * hh, bufA + (20 + ti * 4 + ks) * 1024);
}
__device__ __forceinline__ void delta_issue_A_half(const P& p, int ch, int sl, LAS unsigned char* bufA, int r, int hh, int ti) {
#pragma unroll
    for (int ks = 0; ks < 8; ++ks) {
        DMA16(p.DNW + ((size_t)ch * 64 + 32 * ti + r) * 128 + 16 * ks + 8 * hh, bufA + (ti * 8 + ks) * 1024);
        DMA16(p.DQD + ((size_t)ch * 64 + 32 * ti + r) * 128 + 16 * ks + 8 * hh, bufA + (16 + ti * 8 + ks) * 1024);
    }
#pragma unroll
    for (int g = 0; g < 4; ++g) DMA16(p.DUB + ((size_t)ch * 128 + 32 * sl + r) * 64 + 32 * ti + 8 * g + 4 * hh, bufA + (32 + ti * 4 + g) * 1024);
}
__device__ __forceinline__ void gla_issue_A(const P& p, int ch, int sl, LAS unsigned char* bufA, int r, int hh) {
#pragma unroll
    for (int ks = 0; ks < 4; ++ks) DMA16(p.GVT + ((size_t)ch * 256 + 32 * sl + r) * 64 + 16 * ks + 8 * hh, bufA + ks * 1024);
#pragma unroll
    for (int ti = 0; ti < 2; ++ti)
#pragma unroll
        for (int ks = 0; ks < 8; ++ks) DMA16(p.GQT + ((size_t)ch * 64 + 32 * ti + r) * 128 + 16 * ks + 8 * hh, bufA + (4 + ti * 8 + ks) * 1024);
#pragma unroll
    for (int ti = 0; ti < 2; ++ti)
#pragma unroll
        for (int ks = 0; ks < 4; ++ks) DMA16(p.GA + ((size_t)ch * 64 + 32 * ti + r) * 64 + 16 * ks + 8 * hh, bufA + (20 + ti * 4 + ks) * 1024);
}
__device__ __forceinline__ void gla_issue_B(const P& p, int ch, LAS unsigned char* bufB, int r, int hh) {
#pragma unroll
    for (int d = 0; d < 4; ++d)
#pragma unroll
        for (int ks = 0; ks < 4; ++ks) DMA16(p.GKT + ((size_t)ch * 128 + 32 * d + r) * 64 + 16 * ks + 8 * hh, bufB + (d * 4 + ks) * 1024);
#pragma unroll
    for (int d = 0; d < 4; ++d)
#pragma unroll
        for (int g = 0; g < 4; ++g) DMA16(p.GDEC + (size_t)ch * 128 + 32 * d + 8 * g + 4 * hh, bufB + (16 + d * 4 + g) * 1024);
}
__device__ __forceinline__ void gla_scan_task(const P& p, int l, int s, int h, int sl, LAS unsigned char* ldsw, int lane) {
    LAS bf16* ST = (LAS bf16*)ldsw;
    LAS unsigned char* bufA = ldsw + 16384; LAS unsigned char* bufB = ldsw + 16384 + 28 * 1024;
    const int r = lane & 31, hh = lane >> 5;
    f32x16 S[4];
#pragma unroll
    for (int d = 0; d < 4; ++d) S[d] = zero16();
    volatile LAS unsigned* FL = (volatile LAS unsigned*)(ldsw + SCAN_FLAGS_OFF);
    if (!SCAN_LOADERS) { const int ch0 = (s * 64 + 0) * 4 + h; gla_issue_A(p, ch0, sl, bufA, r, hh); gla_issue_B(p, ch0, bufB, r, hh); }
#pragma unroll 1
    for (int n = 0; n < NCH; ++n) {
        const int r0 = s * TP + n * CH;
        const int chn = (s * 64 + (n + 1 < NCH ? n + 1 : n)) * 4 + h;
#pragma unroll
        for (int d = 0; d < 4; ++d)
#pragma unroll
            for (int g = 0; g < 4; ++g) { u32x2v w; w.x = pk2(S[d][4 * g], S[d][4 * g + 1]); w.y = pk2(S[d][4 * g + 2], S[d][4 * g + 3]); *(LAS u32x2v*)(ST + r * 136 + 32 * d + 8 * g + 4 * hh) = w; }
        if (SCAN_LOADERS) { LDS_WAIT(); lds_wait_ge(FL + 0, (unsigned)n + 1u, FL + 5); lds_wait_ge(FL + 1, (unsigned)n + 1u, FL + 5); }
        else { VM_WAIT_N(32); LDS_WAIT(); }
        bf16x8 vb[4];
#pragma unroll
        for (int ks = 0; ks < 4; ++ks) vb[ks] = FRAG16(bufA, ks, lane);
#pragma unroll
        for (int ti = 0; ti < 2; ++ti) {
            f32x16 o = zero16();
#pragma unroll
            for (int ks = 0; ks < 8; ++ks) { const bf16x8 b = *(const LAS bf16x8*)(ST + r * 136 + 16 * ks + 8 * hh); o = mma32(FRAG16(bufA, 4 + ti * 8 + ks, lane), b, o); }
#pragma unroll
            for (int ks = 0; ks < 4; ++ks) o = mma32(FRAG16(bufA, 20 + ti * 4 + ks, lane), vb[ks], o);
#pragma unroll
            for (int reg = 0; reg < 16; ++reg) p.OBRAW[(size_t)(r0 + 32 * ti + acc_row(reg, hh)) * 1024 + h * 256 + 32 * sl + r] = o[reg];
        }
        LDS_WAIT();
        if (SCAN_LOADERS) { if (lane == 0) FL[3] = (unsigned)n + 1u; lds_wait_ge(FL + 2, (unsigned)n + 1u, FL + 5); }
        else { gla_issue_A(p, chn, sl, bufA, r, hh); VM_WAIT_N(28); }
#pragma unroll
        for (int d = 0; d < 4; ++d) {
#pragma unroll
            for (int ks = 0; ks < 4; ++ks) S[d] = mma32(FRAG16(bufB, d * 4 + ks, lane), vb[ks], S[d]);
#pragma unroll
            for (int g = 0; g < 4; ++g) { const f32x4v dc = FRAGF4(bufB, 16 + d * 4 + g, lane); S[d][4 * g] *= dc.x; S[d][4 * g + 1] *= dc.y; S[d][4 * g + 2] *= dc.z; S[d][4 * g + 3] *= dc.w; }
        }
        LDS_WAIT();
        if (SCAN_LOADERS) { if (lane == 0) FL[4] = (unsigned)n + 1u; } else gla_issue_B(p, chn, bufB, r, hh);
    }
    VM_WAIT_N(0);
    float* so = p.out + O_PGLA + ((((size_t)l * 2 + s) * 4 + h) * 128) * 256;
#pragma unroll
    for (int d = 0; d < 4; ++d)
#pragma unroll
        for (int reg = 0; reg < 16; ++reg) so[(size_t)(32 * d + acc_row(reg, hh)) * 256 + 32 * sl + r] = S[d][reg];
}

__device__ __forceinline__ void delta_prepass(const P& p, int ch, bool active, LAS unsigned char* ldsh, int t256) {
    const int s = ch >> 9, n = (ch >> 3) & 63, h = ch & 7, r0 = s * TP + n * CH;
    LAS bf16* Kh = (LAS bf16*)ldsh;
    LAS bf16* Kl = (LAS bf16*)(ldsh + 17408);
    LAS float* Lm = (LAS float*)(ldsh + 34816);
    LAS float* GH = (LAS float*)(ldsh + 51200);
    LAS float* BE = GH + 64;
    const int lane = t256 & 63, w4 = t256 >> 6, r = lane & 31, hh = lane >> 5;
    const int ti = w4 >> 1, tj = w4 & 1;
    const int j = t256;
    const bool isw = j >= 128;
    float x[64];
    if (active) {
        const float* src = p.DQKV + (size_t)r0 * 3072 + (isw ? 1024 + h * 128 + (j - 128) : 2048 + h * 128 + j);
#pragma unroll
        for (int c = 0; c < 64; ++c) x[c] = src[(size_t)c * 3072];
        if (w4 == 0) {
            float g = p.G[(size_t)(r0 + lane) * 8 + h];
#pragma unroll
            for (int o = 1; o < 64; o <<= 1) { const float y = __shfl_up(g, o); g += lane >= o ? y : 0.f; }
            GH[lane] = g; BE[lane] = p.BETA[(size_t)(r0 + lane) * 8 + h];
            if (lane >= 60) p.DDEC[(size_t)ch * 4 + (lane - 60)] = __expf(__shfl(g, 63));
        }
#pragma unroll
        for (int i = 0; i < 8; ++i) { const int e = t256 + 256 * i, t = e >> 5, dk = (e & 31) * 4;
            const f32x4v kf = *(const f32x4v*)(p.DQKV + (size_t)(r0 + t) * 3072 + 1024 + h * 128 + dk);
            const unsigned h0 = f2bf(kf.x), h1 = f2bf(kf.y), h2 = f2bf(kf.z), h3 = f2bf(kf.w);
            u32x2v wh, wl; wh.x = h0 | (h1 << 16); wh.y = h2 | (h3 << 16);
            wl.x = f2bf(kf.x - bf2f(h0)) | (f2bf(kf.y - bf2f(h1)) << 16); wl.y = f2bf(kf.z - bf2f(h2)) | (f2bf(kf.w - bf2f(h3)) << 16);
            *(LAS u32x2v*)(Kh + t * 136 + dk) = wh; *(LAS u32x2v*)(Kl + t * 136 + dk) = wl; }
    }
    __syncthreads();
    if (active) {
        f32x16 acc = zero16();
        if (!(ti == 0 && tj == 1)) {
#pragma unroll
            for (int ks = 0; ks < 8; ++ks) {
                const bf16x8 ah = *(const LAS bf16x8*)(Kh + (32 * ti + r) * 136 + 16 * ks + 8 * hh), al = *(const LAS bf16x8*)(Kl + (32 * ti + r) * 136 + 16 * ks + 8 * hh);
                const bf16x8 bh = *(const LAS bf16x8*)(Kh + (32 * tj + r) * 136 + 16 * ks + 8 * hh), bl = *(const LAS bf16x8*)(Kl + (32 * tj + r) * 136 + 16 * ks + 8 * hh);
                acc = mma32(ah, bh, acc); acc = mma32(ah, bl, acc); acc = mma32(al, bh, acc);
            }
        }
#pragma unroll
        for (int reg = 0; reg < 16; ++reg) { const int c = 32 * ti + acc_row(reg, hh), sc = 32 * tj + r;
            Lm[c * 64 + sc] = c > sc ? BE[c] * acc[reg] * __expf(GH[c] - GH[sc]) : 0.f; }
    }
    __syncthreads();
    if (active) {
#pragma unroll
        for (int i = 0; i < 8; ++i) { const int e = t256 + 256 * i, t = e >> 5, dk = (e & 31) * 4;
            const f32x4v qv = *(const f32x4v*)(p.DQKV + (size_t)(r0 + t) * 3072 + h * 128 + dk); const float eg = __expf(GH[t]);
            u32x2v wq, wd; wq.x = f2bf(qv.x) | (f2bf(qv.y) << 16); wq.y = f2bf(qv.z) | (f2bf(qv.w) << 16);
            wd.x = f2bf(qv.x * eg) | (f2bf(qv.y * eg) << 16); wd.y = f2bf(qv.z * eg) | (f2bf(qv.w * eg) << 16);
            *(LAS u32x2v*)(Kl + t * 136 + dk) = wq; *(u32x2v*)(p.DQD + ((size_t)ch * 64 + t) * 128 + dk) = wd; }
#pragma unroll
        for (int c = 0; c < 64; ++c) { float m = BE[c]; if (isw) m *= __expf(GH[c]); x[c] *= m; }
#pragma unroll
        for (int c = 1; c < 64; ++c) {
            asm volatile("" ::: "memory");
            float acc = x[c];
#pragma unroll
            for (int s4 = 0; s4 < (c + 3) / 4; ++s4) { const f32x4v L4 = *(const LAS f32x4v*)(Lm + c * 64 + 4 * s4);
                acc = fmaf(-L4.x, x[4 * s4], acc);
                if (4 * s4 + 1 < c) acc = fmaf(-L4.y, x[4 * s4 + 1], acc);
                if (4 * s4 + 2 < c) acc = fmaf(-L4.z, x[4 * s4 + 2], acc);
                if (4 * s4 + 3 < c) acc = fmaf(-L4.w, x[4 * s4 + 3], acc); }
            x[c] = acc;
        }
        if (j < 128) {
#pragma unroll
            for (int c4 = 0; c4 < 16; ++c4) { f32x4v w; w.x = x[4 * c4]; w.y = x[4 * c4 + 1]; w.z = x[4 * c4 + 2]; w.w = x[4 * c4 + 3]; *(f32x4v*)(p.DUB + ((size_t)ch * 128 + j) * 64 + 4 * c4) = w; }
        } else {
#pragma unroll
            for (int c = 0; c < 64; ++c) p.DNW[((size_t)ch * 64 + c) * 128 + (j - 128)] = (bf16)f2bf(-x[c]);
        }
    }
    __syncthreads();
    if (active) {
        f32x16 acc = zero16();
        if (!(ti == 0 && tj == 1)) {
#pragma unroll
            for (int ks = 0; ks < 8; ++ks) {
                const bf16x8 a = *(const LAS bf16x8*)(Kl + (32 * ti + r) * 136 + 16 * ks + 8 * hh);
                const bf16x8 b = *(const LAS bf16x8*)(Kh + (32 * tj + r) * 136 + 16 * ks + 8 * hh);
                acc = mma32(a, b, acc);
            }
        }
#pragma unroll
        for (int reg = 0; reg < 16; ++reg) { const int c = 32 * ti + acc_row(reg, hh), sc = 32 * tj + r;
            p.DAQK[((size_t)ch * 64 + c) * 64 + sc] = (bf16)f2bf(c >= sc ? acc[reg] * __expf(GH[c] - GH[sc]) : 0.f); }
        const float glast = GH[63];
#pragma unroll
        for (int i = 0; i < 4; ++i) { const int c = t256 + 256 * i, dk = c & 127, tg = c >> 7; float v[8];
#pragma unroll
            for (int e = 0; e < 8; ++e) v[e] = p.DQKV[(size_t)(r0 + 8 * tg + e) * 3072 + 1024 + h * 128 + dk] * __expf(glast - GH[8 * tg + e]);
            uint4 w; w.x = pk2(v[0], v[1]); w.y = pk2(v[2], v[3]); w.z = pk2(v[4], v[5]); w.w = pk2(v[6], v[7]);
            *(uint4*)(p.DKE + ((size_t)ch * 128 + dk) * 64 + 8 * tg) = w; }
    }
    __syncthreads();
}

__device__ __forceinline__ void delta_issue_A(const P& p, int ch, int sl, LAS unsigned char* bufA, int r, int hh) {
#pragma unroll
    for (int ti = 0; ti < 2; ++ti)
#pragma unroll
        for (int ks = 0; ks < 8; ++ks) {
            DMA16(p.DNW + ((size_t)ch * 64 + 32 * ti + r) * 128 + 16 * ks + 8 * hh, bufA + (ti * 8 + ks) * 1024);
            DMA16(p.DQD + ((size_t)ch * 64 + 32 * ti + r) * 128 + 16 * ks + 8 * hh, bufA + (16 + ti * 8 + ks) * 1024);
        }
#pragma unroll
    for (int ti = 0; ti < 2; ++ti)
#pragma unroll
        for (int g = 0; g < 4; ++g) DMA16(p.DUB + ((size_t)ch * 128 + 32 * sl + r) * 64 + 32 * ti + 8 * g + 4 * hh, bufA + (32 + ti * 4 + g) * 1024);
}
__device__ __forceinline__ void delta_issue_B(const P& p, int ch, LAS unsigned char* bufB, int r, int hh) {
#pragma unroll
    for (int ti = 0; ti < 2; ++ti)
#pragma unroll
        for (int ks = 0; ks < 4; ++ks) DMA16(p.DAQK + ((size_t)ch * 64 + 32 * ti + r) * 64 + 16 * ks + 8 * hh, bufB + (ti * 4 + ks) * 1024);
#pragma unroll
    for (int d = 0; d < 4; ++d)
#pragma unroll
        for (int ks = 0; ks < 4; ++ks) DMA16(p.DKE + ((size_t)ch * 128 + 32 * d + r) * 64 + 16 * ks + 8 * hh, bufB + (8 + d * 4 + ks) * 1024);
}
__device__ __forceinline__ void delta_scan_task(const P& p, int l, int s, int h, int sl, LAS unsigned char* ldsw, int lane) {
    LAS bf16* ST = (LAS bf16*)ldsw; LAS bf16* UT = (LAS bf16*)(ldsw + 8704);
    LAS unsigned char* bufA = ldsw + 16384; LAS unsigned char* bufB = ldsw + 16384 + 40 * 1024;
    const int r = lane & 31, hh = lane >> 5;
    f32x16 S[4];
#pragma unroll
    for (int d = 0; d < 4; ++d) S[d] = zero16();
    const float dec_all = p.DDEC[(size_t)((s * 64 + lane) * 8 + h) * 4];
    volatile LAS unsigned* FL = (volatile LAS unsigned*)(ldsw + SCAN_FLAGS_OFF);
    if (!SCAN_LOADERS) { const int ch0 = (s * 64 + 0) * 8 + h; delta_issue_A(p, ch0, sl, bufA, r, hh); delta_issue_B(p, ch0, bufB, r, hh); }
#pragma unroll 1
    for (int n = 0; n < NCH; ++n) {
        const int r0 = s * TP + n * CH;
        const int chn = (s * 64 + (n + 1 < NCH ? n + 1 : n)) * 8 + h;
#pragma unroll
        for (int d = 0; d < 4; ++d)
#pragma unroll
            for (int g = 0; g < 4; ++g) { u32x2v w; w.x = pk2(S[d][4 * g], S[d][4 * g + 1]); w.y = pk2(S[d][4 * g + 2], S[d][4 * g + 3]); *(LAS u32x2v*)(ST + r * 136 + 32 * d + 8 * g + 4 * hh) = w; }
        const float dec = __builtin_bit_cast(float, __builtin_amdgcn_readlane(__builtin_bit_cast(int, dec_all), n));
        if (SCAN_LOADERS) { LDS_WAIT(); lds_wait_ge(FL + 0, (unsigned)n + 1u, FL + 5); lds_wait_ge(FL + 1, (unsigned)n + 1u, FL + 5); }
        else { VM_WAIT_N(24); LDS_WAIT(); }
        f32x16 u[2], o[2];
#pragma unroll
        for (int ti = 0; ti < 2; ++ti) {
#pragma unroll
            for (int g = 0; g < 4; ++g) { const f32x4v ub4 = FRAGF4(bufA, 32 + ti * 4 + g, lane); u[ti][4 * g] = ub4.x; u[ti][4 * g + 1] = ub4.y; u[ti][4 * g + 2] = ub4.z; u[ti][4 * g + 3] = ub4.w; }
            o[ti] = zero16();
#pragma unroll
            for (int ks = 0; ks < 8; ++ks) {
                const bf16x8 b = *(const LAS bf16x8*)(ST + r * 136 + 16 * ks + 8 * hh);
                u[ti] = mma32(FRAG16(bufA, ti * 8 + ks, lane), b, u[ti]); o[ti] = mma32(FRAG16(bufA, 16 + ti * 8 + ks, lane), b, o[ti]);
            }
        }
#pragma unroll
        for (int ti = 0; ti < 2; ++ti)
#pragma unroll
            for (int g = 0; g < 4; ++g) { u32x2v w; w.x = pk2(u[ti][4 * g], u[ti][4 * g + 1]); w.y = pk2(u[ti][4 * g + 2], u[ti][4 * g + 3]); *(LAS u32x2v*)(UT + r * 72 + 32 * ti + 8 * g + 4 * hh) = w; }
        LDS_WAIT();
        if (SCAN_LOADERS) { if (lane == 0) FL[3] = (unsigned)n + 1u; lds_wait_ge(FL + 2, (unsigned)n + 1u, FL + 5); }
        else { delta_issue_A(p, chn, sl, bufA, r, hh); VM_WAIT_N(40); }
        bf16x8 ub[4];
#pragma unroll
        for (int ks = 0; ks < 4; ++ks) ub[ks] = *(const LAS bf16x8*)(UT + r * 72 + 16 * ks + 8 * hh);
#pragma unroll
        for (int ti = 0; ti < 2; ++ti) {
#pragma unroll
            for (int ks = 0; ks < 4; ++ks) o[ti] = mma32(FRAG16(bufB, ti * 4 + ks, lane), ub[ks], o[ti]);
#pragma unroll
            for (int reg = 0; reg < 16; ++reg) p.OCRAW[(size_t)(r0 + 32 * ti + acc_row(reg, hh)) * 1024 + h * 128 + 32 * sl + r] = o[ti][reg];
        }
#pragma unroll
        for (int d = 0; d < 4; ++d) {
#pragma unroll
            for (int reg = 0; reg < 16; ++reg) S[d][reg] *= dec;
#pragma unroll
            for (int ks = 0; ks < 4; ++ks) S[d] = mma32(FRAG16(bufB, 8 + d * 4 + ks, lane), ub[ks], S[d]);
        }
        LDS_WAIT();
        if (SCAN_LOADERS) { if (lane == 0) FL[4] = (unsigned)n + 1u; } else delta_issue_B(p, chn, bufB, r, hh);
    }
    VM_WAIT_N(0);
    float* so = p.out + O_PDELTA + ((((size_t)l * 2 + s) * 8 + h) * 128) * 128;
#pragma unroll
    for (int d = 0; d < 4; ++d)
#pragma unroll
        for (int reg = 0; reg < 16; ++reg) so[(size_t)(32 * d + acc_row(reg, hh)) * 128 + 32 * sl + r] = S[d][reg];
}

__device__ __forceinline__ void scan_loader(const P& p, int id, int role, LAS unsigned char* ldsw, int lane) {
    volatile LAS unsigned* FL = (volatile LAS unsigned*)(ldsw + SCAN_FLAGS_OFF);
    const int r = lane & 31, hh = lane >> 5;
    const bool gla = id < 64; const int q = gla ? id : id - 64;
    const int s = q >> 5, h = gla ? (q >> 3) & 3 : (q >> 2) & 7, sl = gla ? q & 7 : q & 3;
    LAS unsigned char* bufA = ldsw + 16384; LAS unsigned char* bufB = ldsw + 16384 + (gla ? 28 : 40) * 1024;
#pragma unroll 1
    for (int n = 0; n < NCH; ++n) {
        const int ch = gla ? (s * 64 + n) * 4 + h : (s * 64 + n) * 8 + h;
        if (!lds_wait_ge<true>(FL + (role < 2 ? 3 : 4), (unsigned)n, FL + 5)) break;
        if (role < 2) { if (gla) gla_issue_A_half(p, ch, sl, bufA, r, hh, role); else delta_issue_A_half(p, ch, sl, bufA, r, hh, role); }
        else { if (gla) gla_issue_B(p, ch, bufB, r, hh); else delta_issue_B(p, ch, bufB, r, hh); }
        VM_WAIT_N(0);
        if (lane == 0) FL[role] = (unsigned)n + 1u;
    }
    VM_WAIT_N(0);
}

__device__ __forceinline__ void norm_task(const P& p, int l, int r, int part, int lane) {
    const bf16* pr = p.PROJ + (size_t)r * PP;
    if (part == 0) {
        const float* gn = p.in[12] + (size_t)l * 256;
        f32x4v x[4], z[4]; const f32x4v g = *(const f32x4v*)(gn + lane * 4);
#pragma unroll
        for (int h = 0; h < 4; ++h) { x[h] = *(const f32x4v*)(p.OBRAW + (size_t)r * 1024 + h * 256 + lane * 4); z[h] = ldbf4(pr + C_BG + h * 256 + lane * 4); }
#pragma unroll
        for (int h = 0; h < 4; ++h) {
            const float ss = wave_sum(x[h].x * x[h].x + x[h].y * x[h].y + x[h].z * x[h].z + x[h].w * x[h].w);
            const float rs = __builtin_amdgcn_rsqf(ss * (1.f / 256.f) + 1e-6f);
            *(u32x2v*)(p.OBb + (size_t)r * 1024 + h * 256 + lane * 4) = (u32x2v){pk2(x[h].x * rs * g.x * siluf_(z[h].x), x[h].y * rs * g.y * siluf_(z[h].y)), pk2(x[h].z * rs * g.z * siluf_(z[h].z), x[h].w * rs * g.w * siluf_(z[h].w))};
        }
    } else {
        const float* dn = p.in[16] + (size_t)l * 128;
        float2 x[8], z[8]; const float2 g = *(const float2*)(dn + lane * 2);
#pragma unroll
        for (int h = 0; h < 8; ++h) { x[h] = *(const float2*)(p.OCRAW + (size_t)r * 1024 + h * 128 + lane * 2); z[h] = ldbf2(pr + C_CZ + h * 128 + lane * 2); }
#pragma unroll
        for (int h = 0; h < 8; ++h) {
            const float ss = wave_sum(x[h].x * x[h].x + x[h].y * x[h].y);
            const float rs = __builtin_amdgcn_rsqf(ss * (1.f / 128.f) + 1e-6f);
            *(unsigned*)(p.OCb + (size_t)r * 1024 + h * 128 + lane * 2) = pk2(x[h].x * rs * g.x * siluf_(z[h].x), x[h].y * rs * g.y * siluf_(z[h].y));
        }
    }
}

__device__ __forceinline__ void norm_row_task(const P& p, int l, int r, int lane) {
    const bf16* pr = p.PROJ + (size_t)r * PP;
    const float* gn = p.in[12] + (size_t)l * 256; const float* dn = p.in[16] + (size_t)l * 128;
    f32x4v x[4], z[4]; float2 y[8], w[8];
    const f32x4v g = *(const f32x4v*)(gn + lane * 4); const float2 g2 = *(const float2*)(dn + lane * 2);
#pragma unroll
    for (int h = 0; h < 4; ++h) { x[h] = *(const f32x4v*)(p.OBRAW + (size_t)r * 1024 + h * 256 + lane * 4); z[h] = ldbf4(pr + C_BG + h * 256 + lane * 4); }
#pragma unroll
    for (int h = 0; h < 8; ++h) { y[h] = *(const float2*)(p.OCRAW + (size_t)r * 1024 + h * 128 + lane * 2); w[h] = ldbf2(pr + C_CZ + h * 128 + lane * 2); }
#pragma unroll
    for (int h = 0; h < 4; ++h) {
        const float ss = wave_sum(x[h].x * x[h].x + x[h].y * x[h].y + x[h].z * x[h].z + x[h].w * x[h].w);
        const float rs = __builtin_amdgcn_rsqf(ss * (1.f / 256.f) + 1e-6f);
        *(u32x2v*)(p.OBb + (size_t)r * 1024 + h * 256 + lane * 4) = (u32x2v){pk2(x[h].x * rs * g.x * siluf_(z[h].x), x[h].y * rs * g.y * siluf_(z[h].y)), pk2(x[h].z * rs * g.z * siluf_(z[h].z), x[h].w * rs * g.w * siluf_(z[h].w))};
    }
#pragma unroll
    for (int h = 0; h < 8; ++h) {
        const float ss = wave_sum(y[h].x * y[h].x + y[h].y * y[h].y);
        const float rs = __builtin_amdgcn_rsqf(ss * (1.f / 128.f) + 1e-6f);
        *(unsigned*)(p.OCb + (size_t)r * 1024 + h * 128 + lane * 2) = pk2(y[h].x * rs * g2.x * siluf_(w[h].x), y[h].y * rs * g2.y * siluf_(w[h].y));
    }
}

__device__ __forceinline__ void mix_phase(const P& p, int l, size_t i0, size_t stride) {
    const size_t n = (size_t)NDEC * D / 4;
    for (size_t i = i0; i < n; i += stride) {
        const size_t r = NPROMPT + i / (D / 4); const int c = (int)(i % (D / 4)) * 4;
        float4 acc = make_float4(0, 0, 0, 0);
#pragma unroll
        for (int b = 0; b < 3; ++b) {
            const f32x4v g = ldbf4(p.PROJ + r * PP + C_MG + b * D + c);
            float4 y;
            if (r < NPROMPT) y = *(const float4*)(p.T3 + ((size_t)b * MPAD + r) * D + c);
            else { y = make_float4(0, 0, 0, 0);
#pragma unroll
                for (int ks = 0; ks < 4; ++ks) { const float4 q = *(const float4*)(p.T3d + ((size_t)(b * 4 + ks) * NDEC + (r - NPROMPT)) * D + c); y.x += q.x; y.y += q.y; y.z += q.z; y.w += q.w; } }
            acc.x += sigmoidf_(g.x) * y.x; acc.y += sigmoidf_(g.y) * y.y; acc.z += sigmoidf_(g.z) * y.z; acc.w += sigmoidf_(g.w) * y.w;
        }
        *(uint2*)(p.MIXb + r * D + c) = make_uint2(pk2(acc.x, acc.y), pk2(acc.z, acc.w));
    }
}

template <int NS> __device__ __forceinline__ void ln_dec_block(const float* res, const float* zs, const float* g, const float* b, float* out, float* out2, bf16* outb, bool active,
                                                               LAS float* red, int tid) {
    const int c = tid * 4, wave = tid >> 6;
    f32x4v v = (f32x4v){0.f, 0.f, 0.f, 0.f};
    if (active) {
        f32x4v q[NS];
#pragma unroll
        for (int sb = 0; sb < NS; ++sb) q[sb] = *(const f32x4v*)(zs + (size_t)sb * NDEC * D + c);
        const f32x4v a = *(const f32x4v*)(res + c);
        v = q[0];
#pragma unroll
        for (int sb = 1; sb < NS; ++sb) v += q[sb];
        v += a * ALPHA;
    }
    float s = wave_sum((v.x + v.y) + (v.z + v.w));
    if ((tid & 63) == 0) red[wave] = s;
    __syncthreads();
    float mu = 0.f;
#pragma unroll
    for (int w = 0; w < 8; ++w) mu += red[w];
    mu *= (1.f / D);
    v = v - mu;
    float qq = wave_sum((v.x * v.x + v.y * v.y) + (v.z * v.z + v.w * v.w));
    if ((tid & 63) == 0) red[8 + wave] = qq;
    __syncthreads();
    float var = 0.f;
#pragma unroll
    for (int w = 0; w < 8; ++w) var += red[8 + w];
    const float rs = __builtin_amdgcn_rsqf(var * (1.f / D) + 1e-5f);
    if (active) {
        const f32x4v gg = *(const f32x4v*)(g + c), bb = *(const f32x4v*)(b + c);
        const f32x4v o = v * rs * gg + bb;
        *(f32x4v*)(out + c) = o;
        if (out2) *(f32x4v*)(out2 + c) = o;
        *(u32x2v*)(outb + c) = (u32x2v){pk2(o.x, o.y), pk2(o.z, o.w)};
    }
}
__device__ __forceinline__ void ln_rows2(const float* z, const float* g, const float* b, float* stats, float* out2, bf16* outb, int lane) {
    float v[2][32]; float s[2] = {0.f, 0.f};
#pragma unroll
    for (int rr = 0; rr < 2; ++rr)
#pragma unroll
        for (int j = 0; j < 8; ++j) { const float4 c = *(const float4*)(z + (size_t)rr * D + j * 256 + lane * 4); v[rr][4 * j] = c.x; v[rr][4 * j + 1] = c.y; v[rr][4 * j + 2] = c.z; v[rr][4 * j + 3] = c.w; }
#pragma unroll
    for (int rr = 0; rr < 2; ++rr)
#pragma unroll
        for (int j = 0; j < 32; ++j) s[rr] += v[rr][j];
    float mu[2], q[2] = {0.f, 0.f}, rs[2];
    s[0] = wave_sum(s[0]); s[1] = wave_sum(s[1]);
    mu[0] = s[0] * (1.f / D); mu[1] = s[1] * (1.f / D);
#pragma unroll
    for (int rr = 0; rr < 2; ++rr)
#pragma unroll
        for (int j = 0; j < 32; ++j) { v[rr][j] -= mu[rr]; q[rr] += v[rr][j] * v[rr][j]; }
    q[0] = wave_sum(q[0]); q[1] = wave_sum(q[1]);
    rs[0] = __builtin_amdgcn_rsqf(q[0] * (1.f / D) + 1e-5f); rs[1] = __builtin_amdgcn_rsqf(q[1] * (1.f / D) + 1e-5f);
    if (lane == 0) { stats[0] = mu[0]; stats[1] = rs[0]; stats[2] = mu[1]; stats[3] = rs[1]; }
#pragma unroll
    for (int j = 0; j < 8; ++j) {
        const float4 gg = *(const float4*)(g + j * 256 + lane * 4), bb = *(const float4*)(b + j * 256 + lane * 4);
#pragma unroll
        for (int rr = 0; rr < 2; ++rr) {
            float4 o; o.x = v[rr][4 * j] * rs[rr] * gg.x + bb.x; o.y = v[rr][4 * j + 1] * rs[rr] * gg.y + bb.y; o.z = v[rr][4 * j + 2] * rs[rr] * gg.z + bb.z; o.w = v[rr][4 * j + 3] * rs[rr] * gg.w + bb.w;
            if (out2) *(float4*)(out2 + (size_t)rr * D + j * 256 + lane * 4) = o;
            *(uint2*)(outb + (size_t)rr * D + j * 256 + lane * 4) = make_uint2(pk2(o.x, o.y), pk2(o.z, o.w));
        }
    }
}
__device__ __forceinline__ void ln_row(const float* res, const float* z, int nslab, const float* g, const float* b, float* out, float* out2, bf16* outb, int lane) {
    float v[32]; float s = 0.f;
#pragma unroll
    for (int j = 0; j < 8; ++j) {
        const float4 a = res ? *(const float4*)(res + j * 256 + lane * 4) : make_float4(0, 0, 0, 0); float4 c = *(const float4*)(z + j * 256 + lane * 4);
#pragma unroll 1
        for (int sb = 1; sb < nslab; ++sb) { const float4 q = *(const float4*)(z + (size_t)sb * NDEC * D + j * 256 + lane * 4); c.x += q.x; c.y += q.y; c.z += q.z; c.w += q.w; }
        v[4 * j] = ALPHA * a.x + c.x; v[4 * j + 1] = ALPHA * a.y + c.y; v[4 * j + 2] = ALPHA * a.z + c.z; v[4 * j + 3] = ALPHA * a.w + c.w;
        s += (v[4 * j] + v[4 * j + 1]) + (v[4 * j + 2] + v[4 * j + 3]);
    }
    const float mu = wave_sum(s) * (1.f / D);
    float q = 0.f;
#pragma unroll
    for (int j = 0; j < 32; ++j) { v[j] -= mu; q += v[j] * v[j]; }
    const float rs = __builtin_amdgcn_rsqf(wave_sum(q) * (1.f / D) + 1e-5f);
#pragma unroll
    for (int j = 0; j < 8; ++j) {
        const float4 gg = *(const float4*)(g + j * 256 + lane * 4), bb = *(const float4*)(b + j * 256 + lane * 4);
        float4 o; o.x = v[4 * j] * rs * gg.x + bb.x; o.y = v[4 * j + 1] * rs * gg.y + bb.y; o.z = v[4 * j + 2] * rs * gg.z + bb.z; o.w = v[4 * j + 3] * rs * gg.w + bb.w;
        *(float4*)(out + j * 256 + lane * 4) = o;
        if (out2) *(float4*)(out2 + j * 256 + lane * 4) = o;
        *(uint2*)(outb + j * 256 + lane * 4) = make_uint2(pk2(o.x, o.y), pk2(o.z, o.w));
    }
}
__device__ __forceinline__ void bf8_to_f(const u32x4v w, float (&f)[8]) {
    f[0] = bf2f(w.x & 0xffffu); f[1] = __builtin_bit_cast(float, w.x & 0xffff0000u); f[2] = bf2f(w.y & 0xffffu); f[3] = __builtin_bit_cast(float, w.y & 0xffff0000u);
    f[4] = bf2f(w.z & 0xffffu); f[5] = __builtin_bit_cast(float, w.z & 0xffff0000u); f[6] = bf2f(w.w & 0xffffu); f[7] = __builtin_bit_cast(float, w.w & 0xffff0000u);
}
constexpr int FFN_PTASKS = (NPROMPT / 8) * 11, FFN_DTASKS = NDEC * 11, FFN_TASKS = FFN_PTASKS + FFN_DTASKS;
__device__ __forceinline__ void ffnconv_task(const P& p, int l, int task, int lane) {
    const float* cw = p.in[22] + (size_t)l * 3 * DFF2;
    if (task < FFN_PTASKS) {
        const int rg = task / 11, sl = task - rg * 11, c = sl * 512 + lane * 8;
        const int ra = rg * 8, t0 = ra & 4095;
        u32x4v x[2][10];
#pragma unroll
        for (int half = 0; half < 2; ++half)
#pragma unroll
            for (int i = 0; i < 10; ++i) {
                if (i < 2 && t0 == 0) x[half][i] = (u32x4v){0u, 0u, 0u, 0u};
                else x[half][i] = *(const u32x4v*)(p.U16 + (size_t)(ra - 2 + i) * DFF2 + c + half * DFF);
            }
        float w[2][3][8];
#pragma unroll
        for (int half = 0; half < 2; ++half)
#pragma unroll
            for (int j = 0; j < 3; ++j) {
                const f32x4v a = *(const f32x4v*)(cw + j * DFF2 + c + half * DFF), b = *(const f32x4v*)(cw + j * DFF2 + c + half * DFF + 4);
                w[half][j][0] = a.x; w[half][j][1] = a.y; w[half][j][2] = a.z; w[half][j][3] = a.w; w[half][j][4] = b.x; w[half][j][5] = b.y; w[half][j][6] = b.z; w[half][j][7] = b.w;
            }
#pragma unroll
        for (int i = 0; i < 8; ++i) {
            float y[2][8];
#pragma unroll
            for (int half = 0; half < 2; ++half) {
                float a[8], b[8], cc[8];
                bf8_to_f(x[half][i], a); bf8_to_f(x[half][i + 1], b); bf8_to_f(x[half][i + 2], cc);
#pragma unroll
                for (int e = 0; e < 8; ++e) y[half][e] = w[half][0][e] * a[e] + w[half][1][e] * b[e] + w[half][2][e] * cc[e];
            }
            u32x4v o;
            o.x = pk2(siluf_(y[0][0]) * y[1][0], siluf_(y[0][1]) * y[1][1]); o.y = pk2(siluf_(y[0][2]) * y[1][2], siluf_(y[0][3]) * y[1][3]);
            o.z = pk2(siluf_(y[0][4]) * y[1][4], siluf_(y[0][5]) * y[1][5]); o.w = pk2(siluf_(y[0][6]) * y[1][6], siluf_(y[0][7]) * y[1][7]);
            *(u32x4v*)(p.Fb + (size_t)(ra + i) * DFF + c) = o;
        }
        return;
    }
    const int dt = task - FFN_PTASKS, rr = dt / 11, sl = dt - rr * 11, c = sl * 512 + lane * 8;
    const int r = NPROMPT + rr, sq = rr >> 2, t = rr & 3;
    float y[2][8];
#pragma unroll
    for (int half = 0; half < 2; ++half) {
#pragma unroll
        for (int e = 0; e < 8; ++e) y[half][e] = 0.f;
#pragma unroll
        for (int j = 0; j < 3; ++j) {
            const int tt = t - 2 + j; float xv[8];
            if (tt >= 0) bf8_to_f(*(const u32x4v*)(p.U16 + (size_t)(NPROMPT + sq * 4 + tt) * DFF2 + c + half * DFF), xv);
            else { const float* sp = p.in[7] + (((size_t)l * 32 + sq) * 2 + (2 + tt)) * DFF2 + c + half * DFF; const f32x4v a = *(const f32x4v*)sp, b = *(const f32x4v*)(sp + 4);
                xv[0] = a.x; xv[1] = a.y; xv[2] = a.z; xv[3] = a.w; xv[4] = b.x; xv[5] = b.y; xv[6] = b.z; xv[7] = b.w; }
            const f32x4v wa = *(const f32x4v*)(cw + j * DFF2 + c + half * DFF), wb = *(const f32x4v*)(cw + j * DFF2 + c + half * DFF + 4);
            y[half][0] += wa.x * xv[0]; y[half][1] += wa.y * xv[1]; y[half][2] += wa.z * xv[2]; y[half][3] += wa.w * xv[3];
            y[half][4] += wb.x * xv[4]; y[half][5] += wb.y * xv[5]; y[half][6] += wb.z * xv[6]; y[half][7] += wb.w * xv[7];
        }
    }
    u32x4v o;
    o.x = pk2(siluf_(y[0][0]) * y[1][0], siluf_(y[0][1]) * y[1][1]); o.y = pk2(siluf_(y[0][2]) * y[1][2], siluf_(y[0][3]) * y[1][3]);
    o.z = pk2(siluf_(y[0][4]) * y[1][4], siluf_(y[0][5]) * y[1][5]); o.w = pk2(siluf_(y[0][6]) * y[1][6], siluf_(y[0][7]) * y[1][7]);
    *(u32x4v*)(p.Fb + (size_t)r * DFF + c) = o;
}

#ifndef PROBE_MASK
#define PROBE_MASK 0
#endif
#define REP(k) for (int rep_ = 0; rep_ < 1 + ((PROBE_MASK >> (k)) & 1); ++rep_)
constexpr int PH_PER_LAYER = 13, N_PHASES = 1 + PH_PER_LAYER * DEPTH;
constexpr int LDS_MISC = pg8::STAGE_BYTES, LDS_BYTES = pg8::STAGE_BYTES + 1024;
struct Args { P p; unsigned* bar; int ph_lo, ph_hi; };
__global__ void __launch_bounds__(512, 2) mega(Args a) {
    extern __shared__ __attribute__((aligned(16))) unsigned char lds_raw[];
    LAS unsigned char* lds = (LAS unsigned char*)lds_raw;
    const P& p = a.p;
    const int tid = threadIdx.x;
    const int G = gridDim.x, bx = blockIdx.x;
    volatile LAS unsigned* misc = (volatile LAS unsigned*)(lds + LDS_MISC);
    if (tid < 64) misc[tid] = 0u;
    __syncthreads();
    const int lo = a.ph_lo, hi = a.ph_hi;
    const bool one_launch = (hi - lo) > 1;
    XcdBarrier bar; bar.bar = a.bar; bar.x = 0; bar.st = misc + 8;
    if (one_launch) bar = xcd_barrier_post(a.bar, misc + 8);
#define IN(k) (lo <= (k) && (k) < hi)
#define SEAM(k) do { if (IN(k) && IN((k) + 1)) { xcd_barrier(bar); if ((PROBE_MASK >> 17) & 1) xcd_barrier(bar); } } while (0)
    const int ngw = G * 8; const size_t ngt = (size_t)G * 512;
#define PHASE_IDS() int tid_p = threadIdx.x; asm volatile("" : "+v"(tid_p)); const int lane = tid_p & 63, wave = __builtin_amdgcn_readfirstlane(tid_p >> 6), gw = bx * 8 + wave; const size_t gt = (size_t)bx * 512 + tid_p; (void)lane; (void)wave; (void)gw; (void)gt

    if (IN(0)) REP(18) {
        PHASE_IDS();
        LAS float* tile = (LAS float*)(lds + (tid_p >> 8) * 32768);
        const int half = tid_p >> 8, t256 = tid_p & 255;
        for (int it = 0; it < (WT_LAYER + 2 * G - 1) / (2 * G); ++it) {
            const int id = (it * G + bx) * 2 + half;
            WTile w = wT_tile(p, id < WT_LAYER ? id : 0);
            if (id < WT_LAYER) wT_load(w.W, w.K, w.N, w.n0, w.k0, tile, t256);
            __syncthreads();
            if (id < WT_LAYER) wT_store(w.Bt, w.K, w.n0, w.k0, tile, t256);
            __syncthreads();
        }
        xinit_phase(p, gt, ngt);
        for (size_t i = gt; i < (size_t)4100 * 8; i += ngt) {
            const int pi = (int)(i >> 3), fi = (int)(i & 7), pos = pi < 4096 ? pi : PAST + (pi - 4096);
            const double rev = (double)pos * rot_inv_rev(fi); const float fr = (float)(rev - floor(rev));
            p.ROT[2 * i] = sin_rev(fr + 0.25f); p.ROT[2 * i + 1] = sin_rev(fr);
        }
    }
    SEAM(0);
    for (int l = 0; l < DEPTH; ++l) {
        const int pb = 1 + PH_PER_LAYER * l;
        if (IN(pb + 0)) REP(0) {
            pg8::Gemm g{p.Xb, p.Win + (size_t)l * PP * D, MPAD, PP, D, D, D, 1, 0, 0, 0, 0}; EpiIn E{p.PROJ, p.SMALL, p.ROT, p.QB16, p.KB16, p.QR, p.KR, p.VD, p.out, l, 0};
            pg8::StaticOrder S; S.init(MPAD, PP, G, bx);
            pg8::gemm_phase<EpiIn, pg8::StaticOrder, true, true>(lds, g, S, E);
        }
        SEAM(pb + 0);
        if (IN(pb + 1)) REP(1) {
            PHASE_IDS();
            REP(19) for (int task = gw; task < MROWS / PREP_ROWS; task += ngw) prep_rows_task(p, l, task * PREP_ROWS, lane);
            REP(20) for (int task = gw; task < (NPROMPT / CONV_ROWS) * 12; task += ngw) prep_conv_task(p, l, task, lane);
            for (int task = gw; task < NDEC * 24; task += ngw) prep_task(p, l, NPROMPT + task / 24, 1 + task % 24, lane);
        }
        SEAM(pb + 1);
        if (IN(pb + 2)) REP(2) {
            PHASE_IDS();
            for (int it = 0; it < (512 + G - 1) / G; ++it) { const int ch = it * G + bx; if (ch < 512) gla_prepass(p, ch, lds, tid_p); }
            for (int it = 0; it < (1024 + 2 * G - 1) / (2 * G); ++it) { const int ch = (it * G + bx) * 2 + (tid_p >> 8); delta_prepass(p, ch < 1024 ? ch : 0, ch < 1024, lds + (tid_p >> 8) * 65536, tid_p & 255); }
            for (int task = gw; task < 512; task += ngw) vt_task(p, task, lds + wave * 8448, lane);
        }
        SEAM(pb + 2);
        if (IN(pb + 3)) REP(3) {
            PHASE_IDS();
            if (tid_p < 16) ((volatile LAS unsigned*)(lds + SCAN_FLAGS_OFF))[tid_p] = 0u;
            __syncthreads();
            const int nsb = G < 128 ? G : 128;
            const int nrole = SCAN_LOADERS ? 4 : 1;
            const bool scan_block = bx < nsb;
            if (scan_block && wave < nrole) {
                REP(13) for (int id = bx; id < 128; id += G) {
                    if (tid_p < 16) {}
                    if (wave == 0) {
                        if (id < 64) gla_scan_task(p, l, id >> 5, (id >> 3) & 3, id & 7, lds, lane);
                        else delta_scan_task(p, l, (id - 64) >> 5, ((id - 64) >> 2) & 7, (id - 64) & 3, lds, lane);
                    } else scan_loader(p, id, wave - 1, lds, lane);
                }
            } else {
                const int wpb = 8 - nrole;
                const int widx = scan_block ? bx * wpb + (wave - nrole) : nsb * wpb + (bx - nsb) * 8 + wave, nwork = nsb * wpb + (G - nsb) * 8;
                REP(14) for (int task = widx; task < 8192; task += nwork) scan_task(p, l, 512 + task, lane);
                REP(15) for (int task = widx; task < NDEC * 4; task += nwork) attn_task(p, l, NPROMPT + (task >> 2), task & 3, lane);
                REP(16) for (int task = widx; task < 4096; task += nwork) attn_prompt_task(p, l, task >> 11, (task >> 4) & 127, task & 15, lds + 106496 + wave * 2560, lane);
                if (l + 1 < DEPTH && widx >= NDEC * 4) for (int task = widx - NDEC * 4; task < WT_LAYER; task += nwork - NDEC * 4) wT_wave_task(p, (l + 1) * WT_LAYER + task, lane);
            }
        }
        SEAM(pb + 3);
        if (IN(pb + 4)) REP(4) { PHASE_IDS(); for (int task = gw; task < NPROMPT; task += ngw) norm_row_task(p, l, task, lane);
            for (int task = gw; task < NDEC * 2; task += ngw) norm_task(p, l, NPROMPT + (task >> 1), task & 1, lane); }
        SEAM(pb + 4);
        if (IN(pb + 5)) REP(5) {
            {
                pg8::Gemm g{p.OAb, p.Wbr + (size_t)l * 3 * D * 1024, NPROMPT, D, 1024, 1024, 1024, 1, (size_t)MPAD * 1024, (size_t)D * 1024, 0, 0}; EpiMix E{p.PROJ + C_MG, p.T3, p.MIXb};
                pg8::TileZ3Order S; S.init(NPROMPT, D, G, bx);
                pg8::gemm_phase<EpiMix, pg8::TileZ3Order, true, true>(lds, g, S, E);
            }
            {
                pg8::Gemm g{p.OAb + (size_t)NPROMPT * 1024, p.Wbr + (size_t)l * 3 * D * 1024, 256, D, 256, 1024, 1024, 4, (size_t)MPAD * 1024, (size_t)D * 1024, 256, 256}; pg8::EpiSlabF32 E{p.T3d, D, 0, (size_t)NDEC * D};
                pg8::ZOrder S; S.init(256, D, 12, G, bx);
                pg8::gemm_phase<pg8::EpiSlabF32, pg8::ZOrder, true, true>(lds, g, S, E);
            }
        }
        SEAM(pb + 5);
        if (IN(pb + 6)) REP(6) { PHASE_IDS(); mix_phase(p, l, gt, ngt); }
        SEAM(pb + 6);
        if (IN(pb + 7)) REP(7) {
            {
                pg8::Gemm g{p.MIXb, p.Wout + (size_t)l * D * D, NPROMPT, D, D, D, D, 1, 0, 0, 0, 0}; pg8::EpiResF32 E{p.Z, l == 0 ? p.X : nullptr, p.ST2, l == 0 ? nullptr : p.in[24] + (size_t)(l - 1) * D, l == 0 ? nullptr : p.in[25] + (size_t)(l - 1) * D, D, ALPHA};
                pg8::StaticOrder S; S.init(NPROMPT, D, G, bx);
                pg8::gemm_phase<pg8::EpiResF32, pg8::StaticOrder, true, true>(lds, g, S, E);
            }
            {
                pg8::Gemm g{p.MIXb + (size_t)NPROMPT * D, p.Wout + (size_t)l * D * D, 256, D, 256, D, D, 8, 0, 0, 256, 256}; pg8::EpiSlabF32 E{p.Zd1, D, 0, (size_t)NDEC * D};
                pg8::ZOrder S; S.init(256, D, 8, G, bx);
                pg8::gemm_phase<pg8::EpiSlabF32, pg8::ZOrder, true, true>(lds, g, S, E);
            }
        }
        SEAM(pb + 7);
        if (IN(pb + 8)) REP(8) {
            PHASE_IDS();
            for (int pr2 = gw; pr2 < NPROMPT / 2; pr2 += ngw) { const size_t r = (size_t)pr2 * 2; ln_rows2(p.Z + r * D, p.in[19] + (size_t)l * D, p.in[20] + (size_t)l * D, p.ST1 + r * 2, nullptr, p.Hb + r * D, lane); }
            for (int it = 0; it < (NDEC + G - 1) / G; ++it) { const int dr = it * G + bx; const bool act = dr < NDEC; const size_t r = NPROMPT + (act ? dr : 0);
                ln_dec_block<8>(p.X + r * D, p.Zd1 + (r - NPROMPT) * D, p.in[19] + (size_t)l * D, p.in[20] + (size_t)l * D, p.H + r * D, nullptr, p.Hb + r * D, act, (LAS float*)(lds + 64 * it), tid_p); }
        }
        SEAM(pb + 8);
        if (IN(pb + 9)) REP(9) {
            pg8::Gemm g{p.Hb, p.Wup + (size_t)l * DFF2 * D, MPAD, DFF2, D, D, D, 1, 0, 0, 0, 0}; EpiU E{p.U16, p.out, l, 0};
            pg8::StaticOrder S; S.init(MPAD, DFF2, G, bx);
            pg8::gemm_phase<EpiU, pg8::StaticOrder, true, true>(lds, g, S, E);
        }
        SEAM(pb + 9);
        if (IN(pb + 10)) REP(10) { PHASE_IDS(); for (int task = gw; task < FFN_TASKS; task += ngw) ffnconv_task(p, l, task, lane); }
        SEAM(pb + 10);
        if (IN(pb + 11)) REP(11) {
            {
                pg8::Gemm g{p.Fb, p.Wdn + (size_t)l * D * DFF, NPROMPT, D, DFF, DFF, DFF, 1, 0, 0, 0, 0}; pg8::EpiResF32 E{p.Z, nullptr, p.ST1, p.in[19] + (size_t)l * D, p.in[20] + (size_t)l * D, D, ALPHA};
                pg8::StaticOrder S; S.init(NPROMPT, D, G, bx);
                pg8::gemm_phase<pg8::EpiResF32, pg8::StaticOrder, true, true>(lds, g, S, E);
            }
            {
                pg8::Gemm g{p.Fb + (size_t)NPROMPT * DFF, p.Wdn + (size_t)l * D * DFF, 256, D, 256, DFF, DFF, 22, 0, 0, 256, 256}; pg8::EpiSlabF32 E{p.Zd2, D, 0, (size_t)NDEC * D};
                pg8::ZOrder S; S.init(256, D, 22, G, bx);
                pg8::gemm_phase<pg8::EpiSlabF32, pg8::ZOrder, true, true>(lds, g, S, E);
            }
        }
        SEAM(pb + 11);
        if (IN(pb + 12)) REP(12) {
            PHASE_IDS();
            for (int pr2 = gw; pr2 < NPROMPT / 2; pr2 += ngw) { const size_t r = (size_t)pr2 * 2;
                ln_rows2(p.Z + r * D, p.in[24] + (size_t)l * D, p.in[25] + (size_t)l * D, p.ST2 + r * 2, l == DEPTH - 1 ? p.out + O_YP + r * D : nullptr, p.Xb + r * D, lane); }
            for (int it = 0; it < (NDEC + G - 1) / G; ++it) { const int dr = it * G + bx; const bool act = dr < NDEC; const size_t r = NPROMPT + (act ? dr : 0);
                ln_dec_block<22>(p.H + r * D, p.Zd2 + (r - NPROMPT) * D, p.in[24] + (size_t)l * D, p.in[25] + (size_t)l * D, p.X + r * D, l == DEPTH - 1 ? p.out + O_YS + (r - NPROMPT) * D : nullptr, p.Xb + r * D, act, (LAS float*)(lds + 64 * it), tid_p); }
        }
        SEAM(pb + 12);
    }
#undef IN
#undef SEAM
}

#ifndef MK_ONE_LAUNCH
#define MK_ONE_LAUNCH 1
#endif
extern "C" void kernel_launch(void* const* d_in, const int* in_sizes, int n_in, void* d_out, int out_size, void* d_ws, size_t ws_size, hipStream_t stream) {
    static int grid = 0;
    if (n_in != 26 || (size_t)out_size != O_TOTAL) { fprintf(stderr, "kernel_launch: unexpected n_in %d / out_size %d\n", n_in, out_size); return; }
    if (grid == 0) {
        int dev = 0, cus = 0, per_cu = 0;
        if (hipGetDevice(&dev) != hipSuccess || hipDeviceGetAttribute(&cus, hipDeviceAttributeMultiprocessorCount, dev) != hipSuccess) { grid = -1; return; }
        if (hipFuncSetAttribute((const void*)mega, hipFuncAttributeMaxDynamicSharedMemorySize, LDS_BYTES) != hipSuccess) { fprintf(stderr, "kernel_launch: hipFuncSetAttribute failed\n"); grid = -1; return; }
        if (hipOccupancyMaxActiveBlocksPerMultiprocessor(&per_cu, (const void*)mega, 512, LDS_BYTES) != hipSuccess || per_cu < 1) { fprintf(stderr, "kernel_launch: occupancy query says %d blocks per CU\n", per_cu); grid = -1; return; }
        (void)hipGetLastError();
        grid = cus;
    }
    if (grid < 0) return;
    Args a{};
    P& p = a.p;
    for (int i = 0; i < 26; ++i) p.in[i] = (const float*)d_in[i];
    p.out = (float*)d_out;
    size_t off = 0; char* ws = (char*)d_ws;
    auto carve = [&](size_t bytes) { void* q = (void*)(ws + off); off += ((bytes + 255) / 256) * 256; return q; };
    a.bar = (unsigned*)carve((size_t)XCD_BAR_WORDS * 4);
    p.Win = (bf16*)carve((size_t)DEPTH * PP * D * 2); p.Wbr = (bf16*)carve((size_t)DEPTH * 3 * D * 1024 * 2); p.Wout = (bf16*)carve((size_t)DEPTH * D * D * 2);
    p.Wup = (bf16*)carve((size_t)DEPTH * DFF2 * D * 2); p.Wdn = (bf16*)carve((size_t)DEPTH * D * DFF * 2);
    p.X = (float*)carve((size_t)MPAD * D * 4); p.H = (float*)carve((size_t)MPAD * D * 4); p.Z = (float*)carve((size_t)MPAD * D * 4);
    p.Xb = (bf16*)carve((size_t)MPAD * D * 2); p.Hb = (bf16*)carve((size_t)MPAD * D * 2); p.MIXb = (bf16*)carve((size_t)MPAD * D * 2);
    p.OAb = (bf16*)carve((size_t)MPAD * 1024 * 2); p.OBb = (bf16*)carve((size_t)MPAD * 1024 * 2); p.OCb = (bf16*)carve((size_t)MPAD * 1024 * 2);
    p.G = (float*)carve((size_t)MPAD * 8 * 4); p.BETA = (float*)carve((size_t)MPAD * 8 * 4);
    p.ST1 = (float*)carve((size_t)NPROMPT * 2 * 4); p.ST2 = (float*)carve((size_t)NPROMPT * 2 * 4);
    p.T3d = (float*)carve((size_t)42 * NDEC * D * 4); p.Zd1 = p.T3d + (size_t)12 * NDEC * D; p.Zd2 = p.T3d + (size_t)20 * NDEC * D;
    p.PROJ = (bf16*)carve((size_t)MPAD * PP * 2); p.U16 = (bf16*)carve((size_t)MPAD * DFF2 * 2);
    p.ROT = (float*)carve((size_t)4100 * 16 * 4);
    p.SMALL = (float*)carve((size_t)MPAD * 32 * 4); p.VD = (float*)carve((size_t)NDEC * 256 * 4);
    const size_t r2 = off;
    p.QR = (float*)carve((size_t)MPAD * 1024 * 4); p.KR = (float*)carve((size_t)MPAD * 256 * 4); p.AG = (float*)carve((size_t)MPAD * 512 * 4);
    p.DQKV = (float*)carve((size_t)MPAD * 3072 * 4); p.OBRAW = (float*)carve((size_t)MPAD * 1024 * 4); p.OCRAW = (float*)carve((size_t)MPAD * 1024 * 4);
    p.QB16 = (bf16*)carve((size_t)NPROMPT * 1024 * 2); p.KB16 = (bf16*)carve((size_t)NPROMPT * 256 * 2); p.VT16 = (bf16*)carve((size_t)2 * 4 * 64 * TP * 2);
    p.GQT = (bf16*)carve((size_t)512 * 64 * 128 * 2); p.GKT = (bf16*)carve((size_t)512 * 128 * 64 * 2); p.GVT = (bf16*)carve((size_t)512 * 256 * 64 * 2);
    p.GA = (bf16*)carve((size_t)512 * 64 * 64 * 2); p.GDEC = (float*)carve((size_t)512 * 128 * 4);
    p.DUB = (float*)carve((size_t)1024 * 64 * 128 * 4); p.DNW = (bf16*)carve((size_t)1024 * 64 * 128 * 2); p.DQD = (bf16*)carve((size_t)1024 * 64 * 128 * 2);
    p.DAQK = (bf16*)carve((size_t)1024 * 64 * 64 * 2); p.DKE = (bf16*)carve((size_t)1024 * 128 * 64 * 2); p.DDEC = (float*)carve((size_t)1024 * 4 * 4);
    const size_t r2_end = off; off = r2;
    p.T3 = (float*)carve((size_t)3 * MPAD * D * 4); p.Fb = (bf16*)p.T3;
    if (off < r2_end) off = r2_end;
    if (off > ws_size) { fprintf(stderr, "kernel_launch: workspace too small: need %zu have %zu\n", off, ws_size); return; }
    if (hipMemsetAsync(a.bar, 0, (size_t)XCD_BAR_WORDS * 4, stream) != hipSuccess) return;
#if MK_ONE_LAUNCH
    a.ph_lo = 0; a.ph_hi = N_PHASES;
    hipLaunchKernelGGL(mega, dim3(grid), dim3(512), LDS_BYTES, stream, a);
#else
    for (int ph = 0; ph < N_PHASES; ++ph) { a.ph_lo = ph; a.ph_hi = ph + 1; hipLaunchKernelGGL(mega, dim3(grid), dim3(512), LDS_BYTES, stream, a); }
#endif
}
```

```cpp
#include <hip/hip_runtime.h>
#include <cstdio>
#include <cstdint>
namespace pg8 {
#define PG8_LAS __attribute__((address_space(3)))
typedef unsigned short bf16_t;
typedef short bf16x8 __attribute__((ext_vector_type(8)));
typedef float f32x4 __attribute__((ext_vector_type(4)));
typedef unsigned u32x4 __attribute__((ext_vector_type(4)));
constexpr int BM = 256, BK = 64, HALF = 128, HTB = HALF * BK * 2  , STAGE_BYTES = 8 * HTB, NXCD = 8, WGM = 8;

__host__ __device__ __forceinline__ int lds_byte(int r, int c) { const int st = (r >> 4) * 2 + (c >> 5), rr = r & 15, cc = c & 31, ob = rr * 64 + cc * 2; return st * 1024 + (ob ^ (((ob >> 9) & 1) << 5)); }
__host__ __device__ __forceinline__ void stage_rc(int b, int& R, int& C) { const int st = b / 1024, sb = b % 1024, swz = sb ^ (((sb >> 9) & 1) << 5); R = (st >> 1) * 16 + swz / 64; C = (st & 1) * 32 + (swz % 64) / 2; }
__host__ __device__ __forceinline__ int perm32(int rho) { const int n = rho >> 4, i = rho & 15; return 8 * (i >> 2) + 4 * n + (i & 3); }

struct Unit { int pm, pn, z; };
struct Gemm { const bf16_t* A; const bf16_t* Bt; int M, N, K, lda, ldb, zdiv; size_t zA, zB, zA2, zB2; };

struct StaticOrder {
    int nM, nN, nwg, G, c;
    __host__ __device__ void init(int M, int N, int G_, int c_) { nM = M / BM; nN = N / BM; nwg = nM * nN; G = G_; c = c_; }
    __host__ __device__ bool next(int i, Unit& u) const {
        const long L = (long)i * G + c; if (L >= nwg) return false;
        int wgid = (int)L; { const int q = nwg / NXCD, r = nwg % NXCD, xcd = wgid % NXCD, off = wgid / NXCD; wgid = (xcd < r ? xcd * (q + 1) : r * (q + 1) + (xcd - r) * q) + off; }
        const int nig = WGM * nN, gid = wgid / nig, fm = gid * WGM, gsz = (nM - fm) < WGM ? (nM - fm) : WGM;
        u.pm = fm + ((wgid % nig) % gsz); u.pn = (wgid % nig) / gsz; u.z = 0; return true;
    }
    __device__ __forceinline__ void a_ready(const Unit&) const {}
    __device__ __forceinline__ void done(const Unit&) const {}
};

__device__ __forceinline__ unsigned cvt_pk_bf16(float lo, float hi) { unsigned r; asm volatile("v_cvt_pk_bf16_f32 %0, %1, %2" : "=v"(r) : "v"(lo), "v"(hi)); return r; }
typedef float f32x2 __attribute__((ext_vector_type(2)));

struct EpiF32 {
    static constexpr bool PERM = false, AFTER_DRAIN = false;
    float* C; int ldc, zdiv; size_t zC;
    __device__ __forceinline__ void operator()(const f32x4 (&acc)[2][2][4][2], const Unit& u, int wr, int wc, int fr, int fq) const {
        const int row0 = u.pm * BM + wr * 64 + fr, col0 = u.pn * BM + wc * 32 + 4 * fq;
#pragma unroll
        for (int ai = 0; ai < 2; ++ai)
#pragma unroll
            for (int m = 0; m < 4; ++m) { float* rowp = C + (size_t)(u.z / zdiv) * zC + (size_t)(row0 + ai * HALF + m * 16) * ldc + col0;
#pragma unroll
                for (int bj = 0; bj < 2; ++bj)
#pragma unroll
                    for (int n = 0; n < 2; ++n) *(f32x4*)(rowp + bj * HALF + n * 16) = acc[ai][bj][m][n]; }
    }
};
struct EpiResF32 {
    static constexpr bool PERM = false, AFTER_DRAIN = false;
    float* C; const float* resp; const float* stats; const float* g; const float* b; int ldc; float alpha;
    __device__ __forceinline__ void operator()(const f32x4 (&acc)[2][2][4][2], const Unit& u, int wr, int wc, int fr, int fq) const {
        const int row0 = u.pm * BM + wr * 64 + fr, col0 = u.pn * BM + wc * 32 + 4 * fq;
        f32x4 gv[2][2], bv[2][2];
#pragma unroll
        for (int bj = 0; bj < 2; ++bj)
#pragma unroll
            for (int n = 0; n < 2; ++n) { gv[bj][n] = resp ? (f32x4){1.f, 1.f, 1.f, 1.f} : *(const f32x4*)(g + col0 + bj * HALF + n * 16); bv[bj][n] = resp ? (f32x4){0.f, 0.f, 0.f, 0.f} : *(const f32x4*)(b + col0 + bj * HALF + n * 16); }
#pragma unroll
        for (int ai = 0; ai < 2; ++ai)
#pragma unroll
            for (int m = 0; m < 4; ++m) { const int row = row0 + ai * HALF + m * 16; const size_t off = (size_t)row * ldc + col0;
                float mu = 0.f, rs = 1.f;
                if (!resp) { mu = stats[2 * row]; rs = stats[2 * row + 1]; }
                const float* src = resp ? resp : C;
                f32x4 rv[2][2];
#pragma unroll
                for (int bj = 0; bj < 2; ++bj)
#pragma unroll
                    for (int n = 0; n < 2; ++n) rv[bj][n] = *(const f32x4*)(src + off + bj * HALF + n * 16);
#pragma unroll
                for (int bj = 0; bj < 2; ++bj)
#pragma unroll
                    for (int n = 0; n < 2; ++n) *(f32x4*)(C + off + bj * HALF + n * 16) = ((rv[bj][n] - mu) * rs * gv[bj][n] + bv[bj][n]) * alpha + acc[ai][bj][m][n]; }
    }
};
struct EpiSlabF32 {
    static constexpr bool PERM = false, AFTER_DRAIN = false;
    float* C; int ldc, pad; size_t zC;
    __device__ __forceinline__ void operator()(const f32x4 (&acc)[2][2][4][2], const Unit& u, int wr, int wc, int fr, int fq) const {
        const int row0 = wr * 64 + fr, col0 = u.pn * BM + wc * 32 + 4 * fq;
#pragma unroll
        for (int m = 0; m < 4; ++m) { float* rowp = C + (size_t)u.z * zC + (size_t)(row0 + m * 16) * ldc + col0;
#pragma unroll
            for (int bj = 0; bj < 2; ++bj)
#pragma unroll
                for (int n = 0; n < 2; ++n) *(f32x4*)(rowp + bj * HALF + n * 16) = acc[0][bj][m][n]; }
    }
};
struct ZOrder {
    StaticOrder so; int nz, G, c, per;
    __device__ void init(int M, int N, int nz_, int G_, int c_) { so.init(M, N, 1, 0); nz = nz_; G = G_; c = c_; per = so.nwg; }
    __device__ bool next(int i, Unit& u) const {
        const long L = (long)i * G + c; if (L >= (long)per * nz) return false;
        const int z = (int)(L / per), rem = (int)(L % per);
        StaticOrder t = so; t.c = rem; t.next(0, u); u.z = z; return true;
    }
    __device__ __forceinline__ void a_ready(const Unit&) const {}
    __device__ __forceinline__ void done(const Unit&) const {}
};
struct TileZ3Order {
    StaticOrder so; int G, c, per;
    __device__ void init(int M, int N, int G_, int c_) { so.init(M, N, 1, 0); G = G_; c = c_; per = so.nwg; }
    __device__ bool next(int i, Unit& u) const {
        const int ti = i / 3, z = i - 3 * ti; const long L = (long)ti * G + c; if (L >= per) return false;
        StaticOrder t = so; t.c = (int)L; t.next(0, u); u.z = z; return true;
    }
    __device__ __forceinline__ void a_ready(const Unit&) const {}
    __device__ __forceinline__ void done(const Unit&) const {}
};
template <class Epi, class Sched, bool ALIGN_EPI = false, bool SP2 = false>
__device__ __forceinline__ void gemm_phase(PG8_LAS unsigned char* lds, const Gemm g, const Sched& S, const Epi& E) {
    int tid_l = threadIdx.x; asm volatile("" : "+v"(tid_l));
    const int tid = tid_l, wid = __builtin_amdgcn_readfirstlane(tid >> 6), lane = tid & 63, wr = wid >> 2, wc = wid & 3, fr = lane & 15, fq = lane >> 4;
    const int K = g.K, nt = K / BK;
    unsigned voffA[2], voffB[2];
#pragma unroll
    for (int i = 0; i < 2; ++i) { int R, C; stage_rc(tid * 16 + i * 8192, R, C); const int Rb = Epi::PERM ? ((R & ~31) + perm32(R & 31)) : R;
        voffA[i] = (unsigned)(R * g.lda + C) * 2u; voffB[i] = (unsigned)(Rb * g.ldb + C) * 2u; }
    const size_t kstep = (size_t)(BK * 2);
    const size_t hstepA = (size_t)HALF * g.lda * 2, hstepB = (size_t)HALF * g.ldb * 2;
    const size_t tstepA = 2 * hstepA, tstepB = 2 * hstepB;
    const unsigned ldsw = (unsigned)wid * 1024u;
    const int aoff = lds_byte(wr * 64 + fr, fq * 8), boff = lds_byte(wc * 32 + fr, fq * 8);
#define PG8_SA(b, h) (((b) * 2 + (h)) * HTB)
#define PG8_SB(b, h) ((4 + (b) * 2 + (h)) * HTB)
#define PG8_STAGE(bufoff, gbase, voff) do { _Pragma("unroll") for (int _i = 0; _i < 2; ++_i) \
        __builtin_amdgcn_global_load_lds((const unsigned*)((const char*)(gbase) + (voff)[_i]), (PG8_LAS unsigned*)(lds + (bufoff) + ldsw + _i * 8192), 16, 0, 0); } while (0)
#define PG8_LDA(dst, b, h) do { _Pragma("unroll") for (int m = 0; m < 4; ++m) _Pragma("unroll") for (int k = 0; k < 2; ++k) dst[m][k] = *(const PG8_LAS bf16x8*)(lds + PG8_SA(b, h) + aoff + m * 2048 + k * 1024); } while (0)
#define PG8_LDB(dst, b, h) do { _Pragma("unroll") for (int n = 0; n < 2; ++n) _Pragma("unroll") for (int k = 0; k < 2; ++k) dst[n][k] = *(const PG8_LAS bf16x8*)(lds + PG8_SB(b, h) + boff + n * 2048 + k * 1024); } while (0)
#define PG8_MMA(ai, bj, At, Bt) do { __builtin_amdgcn_s_setprio(1); _Pragma("unroll") for (int m = 0; m < 4; ++m) _Pragma("unroll") for (int n = 0; n < 2; ++n) _Pragma("unroll") for (int k = 0; k < 2; ++k) \
        acc[ai][bj][m][n] = __builtin_amdgcn_mfma_f32_16x16x32_bf16(Bt[n][k], At[m][k], acc[ai][bj][m][n], 0, 0, 0); __builtin_amdgcn_s_setprio(0); } while (0)
#define PG8_WAIT_V(n) asm volatile("s_waitcnt vmcnt(" #n ")" ::: "memory")
#define PG8_WAIT_L(n) asm volatile("s_waitcnt lgkmcnt(" #n ")" ::: "memory")
#define PG8_BAR __builtin_amdgcn_s_barrier()
#define PG8_SCHED __builtin_amdgcn_sched_barrier(0)
    Unit cur, nxt; int ui = 0;
    if (!S.next(0, cur)) return;
    f32x4 acc[2][2][4][2];
#pragma unroll
    for (int a = 0; a < 2; ++a)
#pragma unroll
        for (int b = 0; b < 2; ++b)
#pragma unroll
            for (int m = 0; m < 4; ++m)
#pragma unroll
                for (int n = 0; n < 2; ++n) acc[a][b][m][n] = (f32x4){0.f, 0.f, 0.f, 0.f};
    bf16x8 At[4][2], B0[2][2], B1[2][2];
    const char* cA = (const char*)g.A + (size_t)cur.pm * tstepA + ((size_t)(cur.z / g.zdiv) * g.zA + (size_t)(cur.z % g.zdiv) * g.zA2) * 2; const char* cB = (const char*)g.Bt + (size_t)cur.pn * tstepB + ((size_t)(cur.z / g.zdiv) * g.zB + (size_t)(cur.z % g.zdiv) * g.zB2) * 2;
    S.a_ready(cur);
    if constexpr (SP2) {
        PG8_STAGE(PG8_SB(0, 0), cB, voffB); PG8_STAGE(PG8_SB(0, 1), cB + hstepB, voffB); PG8_STAGE(PG8_SA(0, 0), cA, voffA); PG8_STAGE(PG8_SA(0, 1), cA + hstepA, voffA);
        if (wr == 1) PG8_BAR;
        PG8_WAIT_V(2); PG8_BAR;
        PG8_STAGE(PG8_SB(1, 0), cB + kstep, voffB); PG8_STAGE(PG8_SA(1, 0), cA + kstep, voffA); PG8_STAGE(PG8_SB(1, 1), cB + hstepB + kstep, voffB);
        PG8_WAIT_V(6); PG8_BAR;
    } else {
        PG8_STAGE(PG8_SB(0, 0), cB, voffB); PG8_STAGE(PG8_SA(0, 0), cA, voffA); PG8_STAGE(PG8_SB(0, 1), cB + hstepB, voffB); PG8_STAGE(PG8_SA(0, 1), cA + hstepA, voffA);
        if (wr == 1) PG8_BAR;
        PG8_WAIT_V(4); PG8_BAR;
        PG8_STAGE(PG8_SB(1, 0), cB + kstep, voffB); PG8_STAGE(PG8_SA(1, 0), cA + kstep, voffA); PG8_STAGE(PG8_SB(1, 1), cB + hstepB + kstep, voffB);
        PG8_WAIT_V(6); PG8_BAR;
    }
    for (;;) {
        const bool has_next = S.next(ui + 1, nxt);
        const char* nA = has_next ? (const char*)g.A + (size_t)nxt.pm * tstepA + ((size_t)(nxt.z / g.zdiv) * g.zA + (size_t)(nxt.z % g.zdiv) * g.zA2) * 2 : cA; const char* nB = has_next ? (const char*)g.Bt + (size_t)nxt.pn * tstepB + ((size_t)(nxt.z / g.zdiv) * g.zB + (size_t)(nxt.z % g.zdiv) * g.zB2) * 2 : cB;
        for (int t = 0; t < nt; t += 2) {
            const bool last = (t == nt - 2);
            const char* a1 = cA + (size_t)(t + 1) * kstep;
            const char* a2 = last ? nA : cA + (size_t)(t + 2) * kstep; const char* b2 = last ? nB : cB + (size_t)(t + 2) * kstep;
            const char* a3 = a2 + kstep; const char* b3 = b2 + kstep;
            if (last && has_next) S.a_ready(nxt);
            if constexpr (SP2) {
            PG8_LDB(B0, 0, 0); PG8_LDB(B1, 0, 1); PG8_SCHED; PG8_LDA(At, 0, 0); PG8_STAGE(PG8_SA(1, 1), a1 + hstepA, voffA);
            PG8_WAIT_V(8); PG8_WAIT_L(0); PG8_BAR; PG8_MMA(0, 0, At, B0); PG8_MMA(0, 1, At, B1); PG8_BAR; PG8_SCHED;
            PG8_LDA(At, 0, 1); PG8_STAGE(PG8_SB(0, 0), b2, voffB); PG8_STAGE(PG8_SB(0, 1), b2 + hstepB, voffB); PG8_STAGE(PG8_SA(0, 0), a2, voffA);
            PG8_WAIT_V(8); PG8_WAIT_L(0); PG8_BAR; PG8_MMA(1, 0, At, B0); PG8_MMA(1, 1, At, B1); PG8_BAR; PG8_SCHED;
            PG8_LDB(B0, 1, 0); PG8_LDB(B1, 1, 1); PG8_SCHED; PG8_LDA(At, 1, 0); PG8_STAGE(PG8_SA(0, 1), a2 + hstepA, voffA);
            PG8_WAIT_V(8); PG8_WAIT_L(0); PG8_BAR; PG8_MMA(0, 0, At, B0); PG8_MMA(0, 1, At, B1); PG8_BAR; PG8_SCHED;
            PG8_LDA(At, 1, 1); PG8_STAGE(PG8_SB(1, 0), b3, voffB); PG8_STAGE(PG8_SB(1, 1), b3 + hstepB, voffB); PG8_STAGE(PG8_SA(1, 0), a3, voffA);
            PG8_WAIT_V(8); PG8_WAIT_L(0); PG8_BAR; PG8_MMA(1, 0, At, B0); PG8_MMA(1, 1, At, B1); PG8_BAR; PG8_SCHED;
            } else {
            PG8_LDB(B0, 0, 0); PG8_SCHED; PG8_LDA(At, 0, 0); PG8_STAGE(PG8_SA(1, 1), a1 + hstepA, voffA);
            PG8_WAIT_L(8); PG8_BAR; PG8_WAIT_L(0); PG8_MMA(0, 0, At, B0); PG8_BAR; PG8_SCHED;
            PG8_LDB(B1, 0, 1); PG8_STAGE(PG8_SB(0, 0), b2, voffB);
            PG8_BAR; PG8_WAIT_L(0); PG8_MMA(0, 1, At, B1); PG8_BAR;
            PG8_LDA(At, 0, 1); PG8_STAGE(PG8_SA(0, 0), a2, voffA);
            PG8_BAR; PG8_WAIT_L(0); PG8_MMA(1, 0, At, B0); PG8_BAR; PG8_SCHED;
            PG8_STAGE(PG8_SB(0, 1), b2 + hstepB, voffB);
            PG8_WAIT_V(6); PG8_BAR; PG8_MMA(1, 1, At, B1); PG8_BAR;
            PG8_LDB(B0, 1, 0); PG8_SCHED; PG8_LDA(At, 1, 0); PG8_STAGE(PG8_SA(0, 1), a2 + hstepA, voffA);
            PG8_WAIT_L(8); PG8_BAR; PG8_WAIT_L(0); PG8_MMA(0, 0, At, B0); PG8_BAR; PG8_SCHED;
            PG8_LDB(B1, 1, 1); PG8_STAGE(PG8_SB(1, 0), b3, voffB);
            PG8_BAR; PG8_WAIT_L(0); PG8_MMA(0, 1, At, B1); PG8_BAR;
            PG8_LDA(At, 1, 1); PG8_STAGE(PG8_SA(1, 0), a3, voffA);
            PG8_BAR; PG8_WAIT_L(0); PG8_MMA(1, 0, At, B0); PG8_BAR; PG8_SCHED;
            PG8_STAGE(PG8_SB(1, 1), b3 + hstepB, voffB);
            PG8_WAIT_V(6); PG8_BAR; PG8_MMA(1, 1, At, B1); PG8_BAR;
            }
        }
        if constexpr (ALIGN_EPI) { if (wr == 0) PG8_BAR; }
        if constexpr (!Epi::AFTER_DRAIN) { E(acc, cur, wr, wc, fr, fq); S.done(cur); }
        if (!has_next) break;
#pragma unroll
        for (int a = 0; a < 2; ++a)
#pragma unroll
            for (int b = 0; b < 2; ++b)
#pragma unroll
                for (int m = 0; m < 4; ++m)
#pragma unroll
                    for (int n = 0; n < 2; ++n) acc[a][b][m][n] = (f32x4){0.f, 0.f, 0.f, 0.f};
        cur = nxt; cA = nA; cB = nB; ++ui;
        if constexpr (ALIGN_EPI) { if (wr == 1) PG8_BAR; }
    }
    PG8_WAIT_V(0);
    if constexpr (!ALIGN_EPI) { if (wr == 0) PG8_BAR; }
    PG8_BAR;
    if constexpr (Epi::AFTER_DRAIN) { E.fused(acc, cur, wr, wc, fr, fq, lds, wid, lane); S.done(cur); }
#undef PG8_SA
#undef PG8_SB
#undef PG8_STAGE
#undef PG8_LDA
#undef PG8_LDB
#undef PG8_MMA
#undef PG8_WAIT_V
#undef PG8_WAIT_L
#undef PG8_BAR
#undef PG8_SCHED
}
}

constexpr int D = 2048, NPROMPT = 8192, TP = 4096, NDEC = 128, TD = 4, MROWS = NPROMPT + NDEC, DEPTH = 4;
constexpr int PAST = 16384;
constexpr int INC = 14880, PP = 15104  , MPAD = 8448  ;
constexpr int C_AQ = 0, C_AK = 1024, C_AV = 1280, C_BQ = 1536, C_BK = 2048, C_BV = 2560, C_BG = 3584, C_BLR = 4608,
              C_CQKV = 4624, C_CZ = 7696, C_CA = 8720, C_CB = 8728, C_MG = 8736;
constexpr int DFF = 5632, DFF2 = 11264;
constexpr float ALPHA = 1.681792830507429f;
constexpr size_t O_YP = 0, O_YS = 16777216, O_PK = 17039360, O_PV = 17301504, O_PGLA = 17563648, O_PDELTA = 18612224,
                 O_PDCONV = 19660800, O_PFCONV = 19734528, O_SK = 19914752, O_SV = 24109056, O_SGLA = 28303360,
                 O_SDELTA = 45080576, O_SDCONV = 61857792, O_SFCONV = 63037440, O_TOTAL = 65921024;

typedef unsigned short bf16;
typedef short bf16x8 __attribute__((ext_vector_type(8)));
typedef float f32x16 __attribute__((ext_vector_type(16)));
typedef unsigned u32x4v __attribute__((ext_vector_type(4)));
typedef unsigned u32x2v __attribute__((ext_vector_type(2)));
typedef float f32x4v __attribute__((ext_vector_type(4)));
struct P {
    const float* in[26];
    float* out;
    float *X, *H, *QR, *KR, *AG, *DQKV, *G, *BETA, *OBRAW, *OCRAW, *T3, *Z;
    bf16* PROJ;
    float* ROT;
    float *SMALL, *VD;
    bf16 *Xb, *Hb, *OAb, *OBb, *OCb, *MIXb, *Fb;
    bf16* U16;
    float *ST1, *ST2;
    float *T3d, *Zd1, *Zd2;
    bf16 *Win, *Wbr, *Wout, *Wup, *Wdn;
    bf16 *QB16, *KB16, *VT16;
    bf16 *GQT, *GKT, *GVT, *GA; float* GDEC;
    float* DUB; bf16 *DNW, *DQD, *DAQK, *DKE; float* DDEC;
};
__device__ __forceinline__ unsigned f2bf(float f) { unsigned u = __builtin_bit_cast(unsigned, f); return (u + 0x7fffu + ((u >> 16) & 1u)) >> 16; }
typedef __bf16 bf16x2_t __attribute__((ext_vector_type(2)));
typedef float f32x2_t __attribute__((ext_vector_type(2)));
__device__ __forceinline__ unsigned pk2(float lo, float hi) { f32x2_t v = {lo, hi}; bf16x2_t b = __builtin_convertvector(v, bf16x2_t); return __builtin_bit_cast(unsigned, b); }

__device__ __forceinline__ float ldbf(const bf16* q) { return __builtin_bit_cast(float, (unsigned)(*q) << 16); }
__device__ __forceinline__ f32x4v ldbf4(const bf16* q) { const u32x2v w = *(const u32x2v*)q; f32x4v r; r.x = __builtin_bit_cast(float, w.x << 16); r.y = __builtin_bit_cast(float, w.x & 0xffff0000u); r.z = __builtin_bit_cast(float, w.y << 16); r.w = __builtin_bit_cast(float, w.y & 0xffff0000u); return r; }
__device__ __forceinline__ float2 ldbf2(const bf16* q) { const unsigned w = *(const unsigned*)q; return make_float2(__builtin_bit_cast(float, w << 16), __builtin_bit_cast(float, w & 0xffff0000u)); }
__device__ __forceinline__ int row_seq(int r) { return r < NPROMPT ? (r >> 12) : 2 + ((r - NPROMPT) >> 2); }
__device__ __forceinline__ int row_t(int r) { return r < NPROMPT ? (r & 4095) : ((r - NPROMPT) & 3); }
__device__ __forceinline__ int seq_row0(int s) { return s < 2 ? s * TP : NPROMPT + (s - 2) * TD; }
__device__ __forceinline__ int seq_len(int s) { return s < 2 ? TP : TD; }
#define DPP_F(v, ctrl) __builtin_bit_cast(float, __builtin_amdgcn_update_dpp(0, __builtin_bit_cast(int, (v)), (ctrl), 0xF, 0xF, true))
__device__ __forceinline__ float row16_sum(float v) {
    v += DPP_F(v, 0xB1);
    v += DPP_F(v, 0x4E);
    v += DPP_F(v, 0x141);
    v += DPP_F(v, 0x140);
    return v;
}
__device__ __forceinline__ float wave_sum(float v) {
    v = row16_sum(v);
    v += __shfl_xor(v, 16); v += __shfl_xor(v, 32);
    return v;
}
__device__ __forceinline__ float wave_max(float v) {
#pragma unroll
    for (int o = 1; o < 64; o <<= 1) v = fmaxf(v, __shfl_xor(v, o));
    return v;
}
__device__ __forceinline__ float sigmoidf_(float x) { return __builtin_amdgcn_rcpf(1.f + __expf(-x)); }
__device__ __forceinline__ float siluf_(float x) { return x * __builtin_amdgcn_rcpf(1.f + __expf(-x)); }
__device__ __forceinline__ float softplusf_(float x) { return fmaxf(x, 0.f) + __logf(1.f + __expf(-fabsf(x))); }


struct EpiU {
    static constexpr bool PERM = true, AFTER_DRAIN = false;
    bf16* U16; float* out; int l, pad;
    __device__ __forceinline__ void operator()(const pg8::f32x4 (&acc)[2][2][4][2], const pg8::Unit& u, int wr, int wc, int fr, int fq) const {
        const int row0 = u.pm * 256 + wr * 64 + fr, col0 = u.pn * 256 + wc * 32 + 8 * fq;
#pragma unroll
        for (int ai = 0; ai < 2; ++ai)
#pragma unroll
            for (int m = 0; m < 4; ++m) {
                bf16* rowp = U16 + (size_t)(row0 + ai * 128 + m * 16) * DFF2 + col0;
#pragma unroll
                for (int bj = 0; bj < 2; ++bj) {
                    const pg8::f32x4 v0 = acc[ai][bj][m][0], v1 = acc[ai][bj][m][1];
                    pg8::u32x4 w; w.x = pk2(v0[0], v0[1]); w.y = pk2(v0[2], v0[3]); w.z = pk2(v1[0], v1[1]); w.w = pk2(v1[2], v1[3]);
                    *(pg8::u32x4*)(rowp + bj * 128) = w;
                }
            }
        if (u.pm == 15 || u.pm == 31 || u.pm == 32) {
#pragma unroll
            for (int ai = 0; ai < 2; ++ai)
#pragma unroll
                for (int m = 0; m < 4; ++m) {
                    const int r = row0 + ai * 128 + m * 16;
                    float* op = nullptr;
                    if (r < NPROMPT) { const int t = r & 4095; if (t >= TP - 2) op = out + O_PFCONV + (((size_t)l * 2 + (r >> 12)) * 2 + (t - (TP - 2))) * DFF2 + col0; }
                    else if (r < MROWS) { const int t = (r - NPROMPT) & 3; if (t >= 2) op = out + O_SFCONV + (((size_t)l * 32 + ((r - NPROMPT) >> 2)) * 2 + (t - 2)) * DFF2 + col0; }
                    if (op) {
#pragma unroll
                        for (int bj = 0; bj < 2; ++bj) { *(pg8::f32x4*)(op + bj * 128) = acc[ai][bj][m][0]; *(pg8::f32x4*)(op + bj * 128 + 4) = acc[ai][bj][m][1]; }
                    }
                }
        }
    }
};

struct EpiIn {
    static constexpr bool PERM = true, AFTER_DRAIN = false;
    bf16* O; float* small; const float* rot; bf16* qb; bf16* kb; float* qr; float* kr; float* vd; float* out; int l, pad;
    __device__ __forceinline__ void attn_tiles(const pg8::f32x4 (&acc)[2][2][4][2], const pg8::Unit& u, int wr, int wc, int fr, int fq) const {
        const int row0 = u.pm * 256 + wr * 64 + fr, colt = wc * 32 + 8 * fq;
        const bool rotl = (u.pn <= 4) && ((wc & 1) == 0);
#pragma unroll
        for (int ai = 0; ai < 2; ++ai)
#pragma unroll
            for (int m = 0; m < 4; ++m) {
                const int r = row0 + ai * 128 + m * 16;
                const bool prompt = r < NPROMPT, dec = !prompt && r < MROWS;
                const int t = prompt ? (r & 4095) : ((r - NPROMPT) & 3), sq = prompt ? (r >> 12) : ((r - NPROMPT) >> 2);
                pg8::f32x4 cs[2], sn[2];
                if (rotl) { const float* rp = rot + (size_t)(prompt ? t : (dec ? 4096 + t : 0)) * 16;
                    const pg8::f32x4 a0 = *(const pg8::f32x4*)rp, a1 = *(const pg8::f32x4*)(rp + 4), a2 = *(const pg8::f32x4*)(rp + 8), a3 = *(const pg8::f32x4*)(rp + 12);
                    cs[0] = (pg8::f32x4){a0[0], a0[2], a1[0], a1[2]}; sn[0] = (pg8::f32x4){a0[1], a0[3], a1[1], a1[3]};
                    cs[1] = (pg8::f32x4){a2[0], a2[2], a3[0], a3[2]}; sn[1] = (pg8::f32x4){a2[1], a2[3], a3[1], a3[3]}; }
#pragma unroll
                for (int bj = 0; bj < 2; ++bj) {
                    pg8::f32x4 v[2] = {acc[ai][bj][m][0], acc[ai][bj][m][1]};
                    if (rotl) {
#pragma unroll
                        for (int n = 0; n < 2; ++n) {
                            pg8::f32x4 pt;
#pragma unroll
                            for (int e = 0; e < 4; ++e) pt[e] = __shfl_xor(v[n][e], 16);
                            if (fq == 0) v[n] = v[n] * cs[n] - pt * sn[n];
                            else if (fq == 1) v[n] = v[n] * cs[n] + pt * sn[n];
                        }
                    }
                    const int c = colt + bj * 128;
                    if (u.pn <= 3) {
                        const int cq = u.pn * 256 + c;
                        if (prompt) { pg8::u32x4 w; w.x = pk2(v[0][0], v[0][1]); w.y = pk2(v[0][2], v[0][3]); w.z = pk2(v[1][0], v[1][1]); w.w = pk2(v[1][2], v[1][3]); *(pg8::u32x4*)(qb + (size_t)r * 1024 + cq) = w; }
                        else if (dec) { *(pg8::f32x4*)(qr + (size_t)r * 1024 + cq) = v[0]; *(pg8::f32x4*)(qr + (size_t)r * 1024 + cq + 4) = v[1]; }
                    } else {
                        const bool isk = u.pn == 4;
                        if (prompt) {
                            pg8::u32x4 w; w.x = pk2(v[0][0], v[0][1]); w.y = pk2(v[0][2], v[0][3]); w.z = pk2(v[1][0], v[1][1]); w.w = pk2(v[1][2], v[1][3]);
                            if (isk) *(pg8::u32x4*)(kb + (size_t)r * 256 + c) = w; else *(pg8::u32x4*)(O + (size_t)r * PP + C_AV + c) = w;
                            if (t >= TP - 128) { float* op = out + (isk ? O_PK : O_PV) + (((size_t)l * 2 + sq) * 128 + (t - (TP - 128))) * 256 + c; *(pg8::f32x4*)op = v[0]; *(pg8::f32x4*)(op + 4) = v[1]; }
                        } else if (dec) {
                            float* dp = (isk ? kr + (size_t)r * 256 : vd + (size_t)(r - NPROMPT) * 256) + c; *(pg8::f32x4*)dp = v[0]; *(pg8::f32x4*)(dp + 4) = v[1];
                            float* op = out + (isk ? O_SK : O_SV) + (((size_t)l * 32 + sq) * 128 + 124 + t) * 256 + c; *(pg8::f32x4*)op = v[0]; *(pg8::f32x4*)(op + 4) = v[1];
                        }
                    }
                }
            }
    }
    __device__ __forceinline__ void operator()(const pg8::f32x4 (&acc)[2][2][4][2], const pg8::Unit& u, int wr, int wc, int fr, int fq) const {
        if (u.pn <= 5) { attn_tiles(acc, u, wr, wc, fr, fq); return; }
        const int row0 = u.pm * 256 + wr * 64 + fr, col0 = u.pn * 256 + wc * 32 + 8 * fq;
        const bool sm = wc == 0 && ((u.pn == 18 && fq < 2) || (u.pn == 34 && fq >= 2));
#pragma unroll
        for (int ai = 0; ai < 2; ++ai)
#pragma unroll
            for (int m = 0; m < 4; ++m) {
                const int r = row0 + ai * 128 + m * 16;
                bf16* rowp = O + (size_t)r * PP + col0;
#pragma unroll
                for (int bj = 0; bj < 2; ++bj) {
                    const pg8::f32x4 v0 = acc[ai][bj][m][0], v1 = acc[ai][bj][m][1];
                    pg8::u32x4 w; w.x = pk2(v0[0], v0[1]); w.y = pk2(v0[2], v0[3]); w.z = pk2(v1[0], v1[1]); w.w = pk2(v1[2], v1[3]);
                    *(pg8::u32x4*)(rowp + bj * 128) = w;
                }
                if (sm) { *(pg8::f32x4*)(small + (size_t)r * 32 + 8 * fq) = acc[ai][0][m][0]; *(pg8::f32x4*)(small + (size_t)r * 32 + 8 * fq + 4) = acc[ai][0][m][1]; }
            }
    }
};
struct EpiMix {
    static constexpr bool PERM = true, AFTER_DRAIN = false;
    const bf16* mg; float* accb; bf16* out;
    __device__ __forceinline__ void operator()(const pg8::f32x4 (&acc)[2][2][4][2], const pg8::Unit& u, int wr, int wc, int fr, int fq) const {
        const int row0 = u.pm * 256 + wr * 64 + fr, col0 = u.pn * 256 + wc * 32 + 8 * fq;
#pragma unroll
        for (int ai = 0; ai < 2; ++ai)
#pragma unroll
            for (int m = 0; m < 4; ++m) {
                const size_t r = (size_t)(row0 + ai * 128 + m * 16);
#pragma unroll
                for (int bj = 0; bj < 2; ++bj) {
                    const int col = col0 + bj * 128;
                    const u32x4v gw = *(const u32x4v*)(mg + r * PP + (size_t)u.z * D + col);
                    float gt[8];
                    gt[0] = __builtin_bit_cast(float, gw.x << 16); gt[1] = __builtin_bit_cast(float, gw.x & 0xffff0000u); gt[2] = __builtin_bit_cast(float, gw.y << 16); gt[3] = __builtin_bit_cast(float, gw.y & 0xffff0000u);
                    gt[4] = __builtin_bit_cast(float, gw.z << 16); gt[5] = __builtin_bit_cast(float, gw.z & 0xffff0000u); gt[6] = __builtin_bit_cast(float, gw.w << 16); gt[7] = __builtin_bit_cast(float, gw.w & 0xffff0000u);
                    pg8::f32x4 v0 = acc[ai][bj][m][0], v1 = acc[ai][bj][m][1];
#pragma unroll
                    for (int e = 0; e < 4; ++e) { v0[e] *= sigmoidf_(gt[e]); v1[e] *= sigmoidf_(gt[4 + e]); }
                    float* ap = accb + r * D + col;
                    if (u.z > 0) { v0 += *(const pg8::f32x4*)ap; v1 += *(const pg8::f32x4*)(ap + 4); }
                    if (u.z < 2) { *(pg8::f32x4*)ap = v0; *(pg8::f32x4*)(ap + 4) = v1; }
                    else { pg8::u32x4 w; w.x = pk2(v0[0], v0[1]); w.y = pk2(v0[2], v0[3]); w.z = pk2(v1[0], v1[1]); w.w = pk2(v1[2], v1[3]); *(pg8::u32x4*)(out + r * D + col) = w; }
                }
            }
    }
};
#define LAS __attribute__((address_space(3)))
#define XB_TMO      128
#define XB_XCNT(j)  (256  + 64 * (j))
#define XB_XSUB(j)  (1280 + 64 * (j))
#define XB_XGEN(j)  (2304 + 64 * (j))
#define XB_TOP      3328
#define XB_TOPGEN   3392
#define XCD_BAR_WORDS 3456
#define XB_SPIN_CAP (1u << 18)

__device__ __forceinline__ unsigned xb_ld(unsigned* p)              { return __hip_atomic_load(p, __ATOMIC_RELAXED, __HIP_MEMORY_SCOPE_AGENT); }
__device__ __forceinline__ unsigned xb_add(unsigned* p, unsigned v) { return __hip_atomic_fetch_add(p, v, __ATOMIC_RELAXED, __HIP_MEMORY_SCOPE_AGENT); }
__device__ __forceinline__ unsigned xb_xcc_id() { return (unsigned)__builtin_amdgcn_s_getreg((3 << 11) | 20) & 0xFu; }
#define XB_SPIN(cond, bar) do { unsigned _sp = 0; while (cond) { __builtin_amdgcn_s_sleep(1); \
    if ((++_sp & 255u) == 0u) { if (xb_ld(&(bar)[XB_TMO])) break; if (_sp > XB_SPIN_CAP) { atomicAdd(&(bar)[XB_TMO], 1u); break; } } } } while (0)

struct XcdBarrier {
    unsigned* bar; unsigned x;
    volatile LAS unsigned* st;
};

__device__ __forceinline__ XcdBarrier xcd_barrier_post(unsigned* bar, volatile LAS unsigned* st) {
    XcdBarrier b; b.bar = bar; b.x = xb_xcc_id(); b.st = st;
    if (threadIdx.x == 0) (void)xb_add(&bar[XB_XCNT(b.x)], 1u);
    return b;
}
__device__ __forceinline__ void xcd_barrier_complete(unsigned* bar, unsigned x, unsigned& nloc, unsigned& nx) {
    const unsigned G = gridDim.x * gridDim.y * gridDim.z;
    unsigned sum, cnt, mine, sp = 0u;
    for (;;) {
        sum = 0u; cnt = 0u; mine = 0u;
#pragma unroll
        for (unsigned j = 0; j < 16; ++j) { const unsigned c = xb_ld(&bar[XB_XCNT(j)]); sum += c; cnt += (c > 0u) ? 1u : 0u; mine = (j == x) ? c : mine; }
        if (sum == G) break;
        __builtin_amdgcn_s_sleep(1);
        if ((++sp & 255u) == 0u) { if (xb_ld(&bar[XB_TMO])) break; if (sp > XB_SPIN_CAP) { atomicAdd(&bar[XB_TMO], 1u); break; } }
    }
    nloc = mine > 0u ? mine : 1u; nx = cnt > 0u ? cnt : 1u;
}

__device__ __forceinline__ void xcd_barrier(const XcdBarrier& b) {
    asm volatile("s_waitcnt vmcnt(0)" ::: "memory");
    __syncthreads();
    if (threadIdx.x == 0) {
        unsigned* bar = b.bar;
        __builtin_amdgcn_s_waitcnt(0);
        unsigned nloc = b.st[0], nx = b.st[1];
        if (nloc == 0u) { xcd_barrier_complete(bar, b.x, nloc, nx); b.st[0] = nloc; b.st[1] = nx; }
        const unsigned old = xb_add(&bar[XB_XSUB(b.x)], 1u);
        const unsigned gen = old / nloc;
        if (old + 1u == (gen + 1u) * nloc) {
            __builtin_amdgcn_fence(__ATOMIC_RELEASE, "agent");
            asm volatile("s_waitcnt vmcnt(0)" ::: "memory");
            const unsigned og = xb_add(&bar[XB_TOP], 1u);
            const unsigned tg = og / nx;
            if (og + 1u == (tg + 1u) * nx) xb_add(&bar[XB_TOPGEN], 1u);
            else XB_SPIN(xb_ld(&bar[XB_TOPGEN]) == tg, bar);
            __builtin_amdgcn_fence(__ATOMIC_ACQUIRE, "agent");
            xb_add(&bar[XB_XGEN(b.x)], 1u);
            asm volatile("s_waitcnt vmcnt(0)" ::: "memory");
        } else {
            XB_SPIN(xb_ld(&bar[XB_XGEN(b.x)]) == gen, bar);
            __builtin_amdgcn_fence(__ATOMIC_ACQUIRE, "agent");
            asm volatile("s_waitcnt vmcnt(0)" ::: "memory");
        }
    }
    __syncthreads();
}

__device__ __forceinline__ void wT_load(const float* W, int K, int N, int n0, int k0, LAS float* tile, int t256) {
    const int tr = t256 >> 6, tc = t256 & 63;
#pragma unroll
    for (int i = 0; i < 16; ++i) { const int kk = tr + 4 * i; tile[kk * 65 + tc] = (n0 + tc < N) ? W[(size_t)(k0 + kk) * N + n0 + tc] : 0.f; }
}
__device__ __forceinline__ void wT_store(bf16* Bt, int K, int n0, int k0, const LAS float* tile, int t256) {
#pragma unroll
    for (int j = 0; j < 2; ++j) {
        const int id = t256 + 256 * j, nl = id >> 3, kc = id & 7;
        uint4 o;
        o.x = pk2(tile[(kc * 8 + 0) * 65 + nl], tile[(kc * 8 + 1) * 65 + nl]); o.y = pk2(tile[(kc * 8 + 2) * 65 + nl], tile[(kc * 8 + 3) * 65 + nl]);
        o.z = pk2(tile[(kc * 8 + 4) * 65 + nl], tile[(kc * 8 + 5) * 65 + nl]); o.w = pk2(tile[(kc * 8 + 6) * 65 + nl], tile[(kc * 8 + 7) * 65 + nl]);
        *(uint4*)(Bt + (size_t)(n0 + nl) * K + k0 + kc * 8) = o;
    }
}
constexpr int WT_IN = (15104 / 64) * (2048 / 64), WT_BR = 3 * (2048 / 64) * (1024 / 64), WT_OUT = (2048 / 64) * (2048 / 64), WT_UP = (11264 / 64) * (2048 / 64), WT_DN = (2048 / 64) * (5632 / 64);
constexpr int WT_LAYER = WT_IN + WT_BR + WT_OUT + WT_UP + WT_DN, WT_TOTAL = 4 * WT_LAYER;
struct WTile { const float* W; bf16* Bt; int K, N, n0, k0; };
__device__ __forceinline__ WTile wT_tile(const P& p, int id) {
    WTile w; const int l = id / WT_LAYER; int r = id % WT_LAYER;
    if (r < WT_IN) { w.W = p.in[8] + (size_t)l * 2048 * 14880; w.Bt = p.Win + (size_t)l * 15104 * 2048; w.K = 2048; w.N = 14880; w.n0 = (r / 32) * 64; w.k0 = (r % 32) * 64; return w; }
    r -= WT_IN;
    if (r < WT_BR) { const int b = r / 512, q = r % 512; w.W = p.in[17] + ((size_t)l * 3 + b) * 1024 * 2048; w.Bt = p.Wbr + ((size_t)l * 3 + b) * 2048 * 1024; w.K = 1024; w.N = 2048; w.n0 = (q / 16) * 64; w.k0 = (q % 16) * 64; return w; }
    r -= WT_BR;
    if (r < WT_OUT) { w.W = p.in[18] + (size_t)l * 2048 * 2048; w.Bt = p.Wout + (size_t)l * 2048 * 2048; w.K = 2048; w.N = 2048; w.n0 = (r / 32) * 64; w.k0 = (r % 32) * 64; return w; }
    r -= WT_OUT;
    if (r < WT_UP) { w.W = p.in[21] + (size_t)l * 2048 * 11264; w.Bt = p.Wup + (size_t)l * 11264 * 2048; w.K = 2048; w.N = 11264; w.n0 = (r / 32) * 64; w.k0 = (r % 32) * 64; return w; }
    r -= WT_UP;
    w.W = p.in[23] + (size_t)l * 5632 * 2048; w.Bt = p.Wdn + (size_t)l * 2048 * 5632; w.K = 5632; w.N = 2048; w.n0 = (r / 88) * 64; w.k0 = (r % 88) * 64; return w;
}
__device__ __forceinline__ void wT_wave_task(const P& p, int id, int lane) {
    const WTile w = wT_tile(p, id);
    const int n = w.n0 + lane; const bool ok = n < w.N;
    const float* q = w.W + (size_t)w.k0 * w.N + (ok ? n : 0);
    float v[64];
#pragma unroll
    for (int kk = 0; kk < 64; ++kk) { v[kk] = *q; q += w.N; }
    bf16* o = w.Bt + (size_t)n * w.K + w.k0;
#pragma unroll
    for (int j = 0; j < 8; ++j) { u32x4v x; x.x = pk2(v[8 * j], v[8 * j + 1]); x.y = pk2(v[8 * j + 2], v[8 * j + 3]); x.z = pk2(v[8 * j + 4], v[8 * j + 5]); x.w = pk2(v[8 * j + 6], v[8 * j + 7]);
        if (!ok) x = (u32x4v){0u, 0u, 0u, 0u};
        *(u32x4v*)(o + 8 * j) = x; }
}
__device__ __forceinline__ void xinit_phase(const P& p, size_t i0, size_t stride) {
    const size_t n = (size_t)MROWS * D / 4;
    for (size_t i = i0; i < n; i += stride) {
        const size_t e = i * 4;
        const float4 v = e < (size_t)NPROMPT * D ? *(const float4*)(p.in[0] + e) : *(const float4*)(p.in[1] + (e - (size_t)NPROMPT * D));
        *(float4*)(p.X + e) = v;
        *(uint2*)(p.Xb + e) = make_uint2(pk2(v.x, v.y), pk2(v.z, v.w));
    }
}

__device__ __forceinline__ float sin_rev(float x) {
    x -= floorf(x);
    float y = x > 0.5f ? x - 1.0f : x;
    y = y > 0.25f ? 0.5f - y : (y < -0.25f ? -0.5f - y : y);
    const float a = y * 6.283185307179586f, a2 = a * a;
    float p = -2.5052108385441718e-08f;
    p = fmaf(p, a2, 2.7557319223985893e-06f);
    p = fmaf(p, a2, -1.984126984126984e-04f);
    p = fmaf(p, a2, 8.333333333333333e-03f);
    p = fmaf(p, a2, -1.6666666666666666e-01f);
    return fmaf(a * a2, p, a);
}
__device__ __forceinline__ double rot_inv_rev(int i) {
    const double t[8] = {0.15915494309189535, 0.03086376340470123, 0.005985185712713705, 0.001160663641240061,
                         0.00022507907903927653, 4.364795279280289e-05, 8.464330808241401e-06, 1.6414262627950345e-06};
    double r = t[0];
#pragma unroll
    for (int k = 1; k < 8; ++k) r = (i == k) ? t[k] : r;
    return r;
}
__device__ __forceinline__ void prep_task(const P& p, int l, int r, int part, int lane) {
    const bf16* pr = p.PROJ + (size_t)r * PP;
    const int s = row_seq(r), t = row_t(r);
    const float* cw = p.in[13] + (size_t)l * 4 * 3072;
    const int r0 = seq_row0(s);
    {
        const int hh = part - 1;
        float v2[2];
#pragma unroll
        for (int i = 0; i < 2; ++i) {
            const int c = hh * 128 + lane + 64 * i;
            float y = 0.f;
#pragma unroll
            for (int j = 0; j < 4; ++j) {
                const int tt = t - 3 + j;
                float xv;
                if (tt >= 0) xv = ldbf(p.PROJ + (size_t)(r0 + tt) * PP + C_CQKV + c);
                else xv = s < 2 ? 0.f : p.in[6][(((size_t)l * 32 + (s - 2)) * 3 + (3 + tt)) * 3072 + c];
                y = fmaf(cw[j * 3072 + c], xv, y);
            }
            v2[i] = siluf_(y);
        }
        if (hh < 16) {
            const float ss = wave_sum(v2[0] * v2[0] + v2[1] * v2[1]);
            float sc = __builtin_amdgcn_rsqf(ss + 1e-6f);
            if (hh < 8) sc *= 0.08838834764831845f;
            v2[0] *= sc; v2[1] *= sc;
        }
        p.DQKV[(size_t)r * 3072 + hh * 128 + lane] = v2[0];
        p.DQKV[(size_t)r * 3072 + hh * 128 + lane + 64] = v2[1];
    }
}

constexpr int PREP_ROWS = 5;
__device__ __forceinline__ void prep_rows_task(const P& p, int l, int rb, int lane) {
    float blr[PREP_ROWS][16];
#pragma unroll
    for (int rr = 0; rr < PREP_ROWS; ++rr)
#pragma unroll
        for (int j = 0; j < 16; ++j) blr[rr][j] = p.SMALL[(size_t)(rb + rr) * 32 + j];
    const float* Wg = p.in[10] + (size_t)l * 16 * 512; const float* bg = p.in[11] + (size_t)l * 512;
#pragma unroll 4
    for (int c = lane; c < 512; c += 64) {
        float wg[16]; const float b = bg[c];
#pragma unroll
        for (int j = 0; j < 16; ++j) wg[j] = Wg[j * 512 + c];
#pragma unroll
        for (int rr = 0; rr < PREP_ROWS; ++rr) {
            float z = b;
#pragma unroll
            for (int j = 0; j < 16; ++j) z = fmaf(blr[rr][j], wg[j], z);
            const float ls = fminf(z, 0.f) - __logf(1.f + __expf(-fabsf(z)));
            p.AG[(size_t)(rb + rr) * 512 + c] = ls * (1.f / 16.f);
        }
    }
    if (lane < 8 * PREP_ROWS) {
        const int rr = lane >> 3, hd = lane & 7, r = rb + rr;
        const float a_log = p.in[14][l * 8 + hd], dtb = p.in[15][l * 8 + hd];
        p.G[(size_t)r * 8 + hd] = -__expf(a_log) * softplusf_(p.SMALL[(size_t)r * 32 + 16 + hd] + dtb);
        p.BETA[(size_t)r * 8 + hd] = sigmoidf_(p.SMALL[(size_t)r * 32 + 24 + hd]);
    }
#pragma unroll 1
    for (int rr = 0; rr < PREP_ROWS; ++rr) {
        const int r = rb + rr, s = row_seq(r), t = row_t(r);
        int oi = -1; size_t ob = 0;
        if (s < 2) { if (t >= TP - 3) { oi = t - (TP - 3); ob = O_PDCONV + ((size_t)l * 2 + s) * 3 * 3072; } }
        else if (t >= 1) { oi = t - 1; ob = O_SDCONV + ((size_t)l * 32 + (s - 2)) * 3 * 3072; }
        if (oi >= 0) {
            const bf16* pr = p.PROJ + (size_t)r * PP;
#pragma unroll 1
            for (int c = lane * 4; c < 3072; c += 256) *(f32x4v*)(p.out + ob + (size_t)oi * 3072 + c) = ldbf4(pr + C_CQKV + c);
        }
    }
}
constexpr int CONV_ROWS = 16;
__device__ __forceinline__ void prep_conv_task(const P& p, int l, int task, int lane) {
    const int rg = task / 12, sl = task - rg * 12, c = sl * 256 + lane * 4, ra = rg * CONV_ROWS, t0 = ra & 4095;
    const float* cw = p.in[13] + (size_t)l * 4 * 3072;
    f32x4v x[CONV_ROWS + 3], w[4];
#pragma unroll
    for (int i = 0; i < CONV_ROWS + 3; ++i) {
        if (i < 3 && t0 == 0) x[i] = (f32x4v){0.f, 0.f, 0.f, 0.f};
        else x[i] = ldbf4(p.PROJ + (size_t)(ra - 3 + i) * PP + C_CQKV + c);
    }
#pragma unroll
    for (int j = 0; j < 4; ++j) w[j] = *(const f32x4v*)(cw + j * 3072 + c);
#pragma unroll
    for (int i = 0; i < CONV_ROWS; ++i) {
        f32x4v y = w[0] * x[i] + w[1] * x[i + 1] + w[2] * x[i + 2] + w[3] * x[i + 3];
        y.x = siluf_(y.x); y.y = siluf_(y.y); y.z = siluf_(y.z); y.w = siluf_(y.w);
        if (sl < 8) {
            float ss = y.x * y.x + y.y * y.y + y.z * y.z + y.w * y.w;
            ss = row16_sum(ss); ss += __shfl_xor(ss, 16);
            float sc = __builtin_amdgcn_rsqf(ss + 1e-6f);
            if (sl < 4) sc *= 0.08838834764831845f;
            y = y * sc;
        }
        *(f32x4v*)(p.DQKV + (size_t)(ra + i) * 3072 + c) = y;
    }
}
__device__ __forceinline__ bool kv_ptrs(const P& p, int l, int s, int t, int g, int j, const float*& kp, const float*& vp) {
    kp = nullptr; vp = nullptr;
    if (j > 128) return false;
    if (s < 2) {
        const int tk = t - 128 + j;
        if (tk < 0) return false;
        const size_t rr = (size_t)(s * TP + tk);
        kp = p.KR + rr * 256 + g * 64; vp = nullptr; return true;
    }
    const int jj = t + j;
    if (jj < 128) { const size_t o = ((((size_t)l * 32 + (s - 2)) * 128 + jj) * 4 + g) * 64; kp = p.in[2] + o; vp = p.in[3] + o; }
    else { const size_t rr = (size_t)(NPROMPT + (s - 2) * TD + (jj - 128)); kp = p.KR + rr * 256 + g * 64; vp = p.VD + (rr - NPROMPT) * 256 + g * 64; }
    return true;
}
__device__ __forceinline__ void attn_task(const P& p, int l, int r, int g, int lane) {
    const int s = row_seq(r), t = row_t(r);
    const float *k0, *k1, *k2, *vdummy;
    const bool ok0 = kv_ptrs(p, l, s, t, g, lane, k0, vdummy);
    const bool ok1 = kv_ptrs(p, l, s, t, g, lane + 64, k1, vdummy);
    const bool ok2 = kv_ptrs(p, l, s, t, g, lane + 128, k2, vdummy);
    float sc0[4] = {0, 0, 0, 0}, sc1[4] = {0, 0, 0, 0}, sc2[4] = {0, 0, 0, 0};
    const float* qp = p.QR + (size_t)r * 1024 + g * 256;
    for (int d4 = 0; d4 < 16; ++d4) {
        const float4 z4 = make_float4(0, 0, 0, 0);
        const float4 a = ok0 ? *(const float4*)(k0 + d4 * 4) : z4;
        const float4 b = ok1 ? *(const float4*)(k1 + d4 * 4) : z4;
        const float4 c = ok2 ? *(const float4*)(k2 + d4 * 4) : z4;
#pragma unroll
        for (int h = 0; h < 4; ++h) {
            const float4 qv = *(const float4*)(qp + h * 64 + d4 * 4);
            sc0[h] += qv.x * a.x + qv.y * a.y + qv.z * a.z + qv.w * a.w;
            sc1[h] += qv.x * b.x + qv.y * b.y + qv.z * b.z + qv.w * b.w;
            sc2[h] += qv.x * c.x + qv.y * c.y + qv.z * c.z + qv.w * c.w;
        }
    }
    float p0[4], p1[4], p2[4], den[4];
#pragma unroll
    for (int h = 0; h < 4; ++h) {
        const float sink = p.in[9][l * 16 + g * 4 + h];
        float m = sink;
        sc0[h] *= 0.125f; sc1[h] *= 0.125f; sc2[h] *= 0.125f;
        if (ok0) m = fmaxf(m, sc0[h]);
        if (ok1) m = fmaxf(m, sc1[h]);
        if (ok2) m = fmaxf(m, sc2[h]);
        m = wave_max(m);
        p0[h] = ok0 ? __expf(sc0[h] - m) : 0.f; p1[h] = ok1 ? __expf(sc1[h] - m) : 0.f; p2[h] = ok2 ? __expf(sc2[h] - m) : 0.f;
        den[h] = wave_sum(p0[h] + p1[h] + p2[h]) + __expf(sink - m);
    }
    float o[4] = {0.f, 0.f, 0.f, 0.f};
    {
        const float* cvb = p.in[3] + ((((size_t)l * 32 + (s - 2)) * 128) * 4 + g) * 64 + lane;
        const float* vdb = p.VD + (size_t)((s - 2) * TD) * 256 + g * 64 + lane;
        const int ncache = 128 - t;
#pragma unroll 1
        for (int j0 = 0; j0 < 128; j0 += 8) {
            float vv[8];
#pragma unroll
            for (int e = 0; e < 8; ++e) { const int j = j0 + e; vv[e] = j < ncache ? cvb[(size_t)(t + j) * 256] : vdb[(size_t)(t + j - 128) * 256]; }
#pragma unroll
            for (int e = 0; e < 8; ++e) { const int j = j0 + e, jl = j & 63;
#pragma unroll
                for (int h = 0; h < 4; ++h) { const float pj = j0 < 64 ? __shfl(p0[h], jl) : __shfl(p1[h], jl); o[h] = fmaf(pj, vv[e], o[h]); } }
        }
        { const float vv = vdb[(size_t)t * 256];
#pragma unroll
          for (int h = 0; h < 4; ++h) o[h] = fmaf(__shfl(p2[h], 0), vv, o[h]); }
    }
#pragma unroll
    for (int h = 0; h < 4; ++h) p.OAb[(size_t)r * 1024 + (g * 4 + h) * 64 + lane] = (bf16)f2bf(o[h] / den[h]);
    if (s >= 2 && t == 0) {
        const size_t b0 = ((((size_t)l * 32 + (s - 2)) * 128) * 4 + g) * 64 + lane;
#pragma unroll 1
        for (int i0 = 0; i0 < 124; i0 += 4) {
            float kk[4], vv[4];
#pragma unroll
            for (int e = 0; e < 4; ++e) { kk[e] = p.in[2][b0 + (size_t)(i0 + e + 4) * 256]; vv[e] = p.in[3][b0 + (size_t)(i0 + e + 4) * 256]; }
#pragma unroll
            for (int e = 0; e < 4; ++e) { p.out[O_SK + b0 + (size_t)(i0 + e) * 256] = kk[e]; p.out[O_SV + b0 + (size_t)(i0 + e) * 256] = vv[e]; }
        }
    }
}
__device__ __forceinline__ void gla_task(const P& p, int l, int s, int h, int sl, int lane) {
    const int dkg = lane >> 3, c = lane & 7, col = sl * 8 + c;
    const float* st = p.in[4] + ((((size_t)l * 32 + (s - 2)) * 4 + h) * 128) * 256;
    float S[16];
#pragma unroll
    for (int i = 0; i < 16; ++i) S[i] = st[(size_t)(dkg * 16 + i) * 256 + col];
    const size_t r0 = (size_t)seq_row0(s);
    f32x4v a[TD][4], k[TD][4], q[TD][4]; float v[TD], o[TD];
#pragma unroll
    for (int t = 0; t < TD; ++t) {
        const bf16* pr = p.PROJ + (r0 + t) * PP;
        v[t] = ldbf(pr + C_BV + h * 256 + col);
#pragma unroll
        for (int i4 = 0; i4 < 4; ++i4) {
            a[t][i4] = *(const f32x4v*)(p.AG + (r0 + t) * 512 + h * 128 + dkg * 16 + 4 * i4);
            k[t][i4] = ldbf4(pr + C_BK + h * 128 + dkg * 16 + 4 * i4); q[t][i4] = ldbf4(pr + C_BQ + h * 128 + dkg * 16 + 4 * i4);
        }
    }
#pragma unroll
    for (int t = 0; t < TD; ++t) {
        float ot = 0.f;
#pragma unroll
        for (int i4 = 0; i4 < 4; ++i4) {
            S[4 * i4 + 0] = fmaf(S[4 * i4 + 0], __expf(a[t][i4].x), k[t][i4].x * v[t]); ot = fmaf(q[t][i4].x, S[4 * i4 + 0], ot);
            S[4 * i4 + 1] = fmaf(S[4 * i4 + 1], __expf(a[t][i4].y), k[t][i4].y * v[t]); ot = fmaf(q[t][i4].y, S[4 * i4 + 1], ot);
            S[4 * i4 + 2] = fmaf(S[4 * i4 + 2], __expf(a[t][i4].z), k[t][i4].z * v[t]); ot = fmaf(q[t][i4].z, S[4 * i4 + 2], ot);
            S[4 * i4 + 3] = fmaf(S[4 * i4 + 3], __expf(a[t][i4].w), k[t][i4].w * v[t]); ot = fmaf(q[t][i4].w, S[4 * i4 + 3], ot);
        }
        ot += __shfl_xor(ot, 8); ot += __shfl_xor(ot, 16); ot += __shfl_xor(ot, 32);
        o[t] = ot * 0.08838834764831845f;
    }
    if (dkg == 0) {
#pragma unroll
        for (int t = 0; t < TD; ++t) p.OBRAW[(r0 + t) * 1024 + h * 256 + col] = o[t];
    }
    float* so = p.out + O_SGLA + ((((size_t)l * 32 + (s - 2)) * 4 + h) * 128) * 256;
#pragma unroll
    for (int i = 0; i < 16; ++i) so[(size_t)(dkg * 16 + i) * 256 + col] = S[i];
}
__device__ __forceinline__ void delta_task(const P& p, int l, int s, int h, int sl, int lane) {
    const int dkg = lane >> 3, c = lane & 7, col = sl * 8 + c;
    const float* st = p.in[5] + ((((size_t)l * 32 + (s - 2)) * 8 + h) * 128) * 128;
    float S[16];
#pragma unroll
    for (int i = 0; i < 16; ++i) S[i] = st[(size_t)(dkg * 16 + i) * 128 + col];
    const size_t r0 = (size_t)seq_row0(s);
    f32x4v k[TD][4], q[TD][4]; float v[TD], g[TD], be[TD], o[TD];
#pragma unroll
    for (int t = 0; t < TD; ++t) {
        const float* dq = p.DQKV + (r0 + t) * 3072 + h * 128 + dkg * 16;
        v[t] = dq[2048 - dkg * 16 + col]; g[t] = p.G[(r0 + t) * 8 + h]; be[t] = p.BETA[(r0 + t) * 8 + h];
#pragma unroll
        for (int i4 = 0; i4 < 4; ++i4) { q[t][i4] = *(const f32x4v*)(dq + 4 * i4); k[t][i4] = *(const f32x4v*)(dq + 1024 + 4 * i4); }
    }
#pragma unroll
    for (int t = 0; t < TD; ++t) {
        const float a = __expf(g[t]);
        float kS = 0.f, qS = 0.f, qk = 0.f;
#pragma unroll
        for (int i4 = 0; i4 < 4; ++i4)
#pragma unroll
            for (int e = 0; e < 4; ++e) { kS = fmaf(k[t][i4][e], S[4 * i4 + e], kS); qS = fmaf(q[t][i4][e], S[4 * i4 + e], qS); qk = fmaf(q[t][i4][e], k[t][i4][e], qk); }
        kS += __shfl_xor(kS, 8); kS += __shfl_xor(kS, 16); kS += __shfl_xor(kS, 32);
        qS += __shfl_xor(qS, 8); qS += __shfl_xor(qS, 16); qS += __shfl_xor(qS, 32);
        qk += __shfl_xor(qk, 8); qk += __shfl_xor(qk, 16); qk += __shfl_xor(qk, 32);
        const float u = be[t] * (v[t] - a * kS);
#pragma unroll
        for (int i4 = 0; i4 < 4; ++i4)
#pragma unroll
            for (int e = 0; e < 4; ++e) S[4 * i4 + e] = fmaf(a, S[4 * i4 + e], k[t][i4][e] * u);
        o[t] = a * qS + qk * u;
    }
    if (dkg == 0) {
#pragma unroll
        for (int t = 0; t < TD; ++t) p.OCRAW[(r0 + t) * 1024 + h * 128 + col] = o[t];
    }
    float* so = p.out + O_SDELTA + ((((size_t)l * 32 + (s - 2)) * 8 + h) * 128) * 128;
#pragma unroll
    for (int i = 0; i < 16; ++i) so[(size_t)(dkg * 16 + i) * 128 + col] = S[i];
}
__device__ __forceinline__ void scan_task(const P& p, int l, int task, int lane) {
    if (task < 256) { gla_task(p, l, task >> 7, (task >> 5) & 3, task & 31, lane); return; }
    task -= 256;
    if (task < 256) { delta_task(p, l, task >> 7, (task >> 4) & 7, task & 15, lane); return; }
    task -= 256;
    if (task < 4096) { gla_task(p, l, 2 + (task >> 7), (task >> 5) & 3, task & 31, lane); return; }
    task -= 4096;
    delta_task(p, l, 2 + (task >> 7), (task >> 4) & 7, task & 15, lane);
}
constexpr int N_SCAN_TASKS = 512 + 8192;

constexpr int CH = 64, NCH = TP / CH;
__device__ __forceinline__ f32x16 mma32(bf16x8 a, bf16x8 b, f32x16 c) { return __builtin_amdgcn_mfma_f32_32x32x16_bf16(a, b, c, 0, 0, 0); }
__device__ __forceinline__ int acc_row(int reg, int hh) { return (reg & 3) + 8 * (reg >> 2) + 4 * hh; }
__device__ __forceinline__ f32x16 zero16() { f32x16 z;
#pragma unroll
    for (int i = 0; i < 16; ++i) z[i] = 0.f;
    return z; }
__device__ __forceinline__ float bf2f(unsigned b) { return __builtin_bit_cast(float, b << 16); }
#define LDS_WAIT() asm volatile("s_waitcnt lgkmcnt(0)" ::: "memory")


__device__ __forceinline__ void attn_prompt_task(const P& p, int l, int s, int qb, int h, LAS unsigned char* ldsw, int lane) {
    LAS bf16* PT = (LAS bf16*)ldsw;
    const int r = lane & 31, hh = lane >> 5, g = h >> 2, q0 = 32 * qb;
    bf16x8 qf[4];
#pragma unroll
    for (int ks = 0; ks < 4; ++ks) qf[ks] = *(const bf16x8*)(p.QB16 + (size_t)(s * TP + q0 + r) * 1024 + h * 64 + 16 * ks + 8 * hh);
    f32x16 st[5];
#pragma unroll
    for (int kt = 0; kt < 5; ++kt) {
        int pk = q0 - 128 + 32 * kt + r; pk = pk < 0 ? 0 : pk;
        st[kt] = zero16();
#pragma unroll
        for (int ks = 0; ks < 4; ++ks) { const bf16x8 kf = *(const bf16x8*)(p.KB16 + (size_t)(s * TP + pk) * 256 + g * 64 + 16 * ks + 8 * hh); st[kt] = mma32(kf, qf[ks], st[kt]); }
    }
    const float sink = p.in[9][l * 16 + h];
    float m = sink;
#pragma unroll
    for (int kt = 0; kt < 5; ++kt)
#pragma unroll
        for (int reg = 0; reg < 16; ++reg) {
            const int kk = 32 * kt + acc_row(reg, hh);
            const bool valid = (kk >= r) && (kk <= r + 128) && (q0 - 128 + kk >= 0);
            const float v = valid ? st[kt][reg] * 0.125f : -3.0e38f;
            st[kt][reg] = v; m = fmaxf(m, v);
        }
    m = fmaxf(m, __shfl_xor(m, 32));
    float sum = 0.f;
#pragma unroll
    for (int kt = 0; kt < 5; ++kt)
#pragma unroll
        for (int reg = 0; reg < 16; ++reg) { const float e = st[kt][reg] > -1.0e38f ? __expf(st[kt][reg] - m) : 0.f; st[kt][reg] = e; sum += e; }
    sum += __shfl_xor(sum, 32);
    const float inv = 1.f / (sum + __expf(sink - m));
    f32x16 o[2]; o[0] = zero16(); o[1] = zero16();
#pragma unroll
    for (int kt = 0; kt < 5; ++kt) {
#pragma unroll
        for (int gq = 0; gq < 4; ++gq) { u32x2v w; w.x = pk2(st[kt][4 * gq], st[kt][4 * gq + 1]); w.y = pk2(st[kt][4 * gq + 2], st[kt][4 * gq + 3]); *(LAS u32x2v*)(PT + r * 40 + 8 * gq + 4 * hh) = w; }
        LDS_WAIT();
#pragma unroll
        for (int ks = 0; ks < 2; ++ks) {
            const bf16x8 pf = *(const LAS bf16x8*)(PT + r * 40 + 16 * ks + 8 * hh);
            int p0 = q0 - 128 + 32 * kt + 16 * ks + 8 * hh; p0 = p0 < 0 ? 0 : p0;
#pragma unroll
            for (int dt = 0; dt < 2; ++dt) { const bf16x8 vf = *(const bf16x8*)(p.VT16 + ((size_t)(s * 4 + g) * 64 + 32 * dt + r) * TP + p0); o[dt] = mma32(vf, pf, o[dt]); }
        }
        LDS_WAIT();
    }
#pragma unroll
    for (int dt = 0; dt < 2; ++dt)
#pragma unroll
        for (int gq = 0; gq < 4; ++gq) { u32x2v w; w.x = pk2(o[dt][4 * gq] * inv, o[dt][4 * gq + 1] * inv); w.y = pk2(o[dt][4 * gq + 2] * inv, o[dt][4 * gq + 3] * inv);
            *(u32x2v*)(p.OAb + (size_t)(s * TP + q0 + r) * 1024 + h * 64 + 32 * dt + 8 * gq + 4 * hh) = w; }
}
__device__ __forceinline__ void vt_task(const P& p, int task, LAS unsigned char* ldsw, int lane) {
    const int s = task >> 8, n = (task >> 2) & 63, g = task & 3, r0 = s * TP + n * CH;
    LAS bf16* tile = (LAS bf16*)ldsw;
    { bf16 vv[64];
#pragma unroll
      for (int t = 0; t < 64; ++t) vv[t] = p.PROJ[(size_t)(r0 + t) * PP + C_AV + g * 64 + lane];
#pragma unroll
      for (int t = 0; t < 64; ++t) tile[t * 66 + lane] = vv[t]; }
    LDS_WAIT();
#pragma unroll
    for (int tg = 0; tg < 8; ++tg) { u32x4v w;
        w.x = (unsigned)tile[(8 * tg + 0) * 66 + lane] | ((unsigned)tile[(8 * tg + 1) * 66 + lane] << 16); w.y = (unsigned)tile[(8 * tg + 2) * 66 + lane] | ((unsigned)tile[(8 * tg + 3) * 66 + lane] << 16);
        w.z = (unsigned)tile[(8 * tg + 4) * 66 + lane] | ((unsigned)tile[(8 * tg + 5) * 66 + lane] << 16); w.w = (unsigned)tile[(8 * tg + 6) * 66 + lane] | ((unsigned)tile[(8 * tg + 7) * 66 + lane] << 16);
        *(u32x4v*)(p.VT16 + ((size_t)(s * 4 + g) * 64 + lane) * TP + n * CH + 8 * tg) = w; }
    LDS_WAIT();
}

__device__ __forceinline__ void gla_prepass(const P& p, int ch, LAS unsigned char* lds, int tid) {
    const int s = ch >> 8, n = (ch >> 2) & 63, h = ch & 3, r0 = s * TP + n * CH;
    LAS bf16* QTs = (LAS bf16*)lds;
    LAS bf16* KTs = (LAS bf16*)(lds + 17408);
    LAS bf16* VTs = (LAS bf16*)(lds + 34816);
    LAS bf16* As = (LAS bf16*)(lds + 71680);
    LAS float* PART = (LAS float*)(lds + 80896);
    const int lane = tid & 63, wave = tid >> 6;
    {
        const int dk = tid & 127, part = tid >> 7;
        float gl[16]; bf16 qr[16], kr[16], vr[32]; float sum = 0.f;
#pragma unroll
        for (int i = 0; i < 16; ++i) gl[i] = p.AG[(size_t)(r0 + part * 16 + i) * 512 + h * 128 + dk];
#pragma unroll
        for (int i = 0; i < 16; ++i) { const bf16* pr = p.PROJ + (size_t)(r0 + part * 16 + i) * PP; qr[i] = pr[C_BQ + h * 128 + dk]; kr[i] = pr[C_BK + h * 128 + dk]; }
#pragma unroll
        for (int i = 0; i < 32; ++i) { const int e = tid + 512 * i, t = e >> 8, dv = e & 255; vr[i] = p.PROJ[(size_t)(r0 + t) * PP + C_BV + h * 256 + dv]; }
#pragma unroll
        for (int i = 0; i < 16; ++i) sum += gl[i];
        PART[part * 128 + dk] = sum;
        __syncthreads();
        float pre = 0.f, tot = 0.f;
#pragma unroll
        for (int pp = 0; pp < 4; ++pp) { const float v = PART[pp * 128 + dk]; tot += v; pre += pp < part ? v : 0.f; }
        float b = pre;
#pragma unroll
        for (int i = 0; i < 16; ++i) {
            const int t = part * 16 + i; b += gl[i];
            const float q = bf2f(qr[i]), k = bf2f(kr[i]);
            QTs[t * 136 + dk] = (bf16)f2bf(q * 0.08838834764831845f * __expf(b));
            KTs[t * 136 + dk] = (bf16)f2bf(k * __expf(-b));
        }
        if (part == 0) p.GDEC[(size_t)ch * 128 + dk] = __expf(tot);
#pragma unroll
        for (int i = 0; i < 32; ++i) { const int e = tid + 512 * i, t = e >> 8, dv = e & 255; VTs[dv * 72 + t] = vr[i]; }
    }
    __syncthreads();
#pragma unroll
    for (int i = 0; i < 2; ++i) { const int c = tid + 512 * i, t = c >> 4, c8 = (c & 15) * 8; *(u32x4v*)(p.GQT + ((size_t)ch * 64 + t) * 128 + c8) = *(const LAS u32x4v*)(QTs + t * 136 + c8); }
#pragma unroll
    for (int i = 0; i < 2; ++i) { const int c = tid + 512 * i, dk = c & 127, tg = c >> 7; uint4 w;
        w.x = (unsigned)KTs[(8 * tg + 0) * 136 + dk] | ((unsigned)KTs[(8 * tg + 1) * 136 + dk] << 16); w.y = (unsigned)KTs[(8 * tg + 2) * 136 + dk] | ((unsigned)KTs[(8 * tg + 3) * 136 + dk] << 16);
        w.z = (unsigned)KTs[(8 * tg + 4) * 136 + dk] | ((unsigned)KTs[(8 * tg + 5) * 136 + dk] << 16); w.w = (unsigned)KTs[(8 * tg + 6) * 136 + dk] | ((unsigned)KTs[(8 * tg + 7) * 136 + dk] << 16);
        *(uint4*)(p.GKT + ((size_t)ch * 128 + dk) * 64 + 8 * tg) = w; }
#pragma unroll
    for (int i = 0; i < 4; ++i) { const int c = tid + 512 * i, dv = c >> 3, tg = c & 7; *(u32x4v*)(p.GVT + ((size_t)ch * 256 + dv) * 64 + 8 * tg) = *(const LAS u32x4v*)(VTs + dv * 72 + 8 * tg); }
    if (wave < 4) {
        const int ti = wave >> 1, tj = wave & 1, r = lane & 31, hh = lane >> 5;
        f32x16 acc = zero16();
        if (!(ti == 0 && tj == 1)) {
#pragma unroll
            for (int ks = 0; ks < 8; ++ks) {
                const bf16x8 a = *(const LAS bf16x8*)(QTs + (32 * ti + r) * 136 + 16 * ks + 8 * hh);
                const bf16x8 b = *(const LAS bf16x8*)(KTs + (32 * tj + r) * 136 + 16 * ks + 8 * hh);
                acc = mma32(a, b, acc);
            }
        }
#pragma unroll
        for (int reg = 0; reg < 16; ++reg) { const int tr = 32 * ti + acc_row(reg, hh), sc = 32 * tj + r; As[tr * 72 + sc] = (bf16)f2bf(tr >= sc ? acc[reg] : 0.f); }
    }
    __syncthreads();
    { const int t = tid >> 3, c8 = (tid & 7) * 8; *(u32x4v*)(p.GA + ((size_t)ch * 64 + t) * 64 + c8) = *(const LAS u32x4v*)(As + t * 72 + c8); }
    __syncthreads();
}

#define DMA16(gptr, lptr) __builtin_amdgcn_global_load_lds((const unsigned*)(gptr), (LAS unsigned*)(lptr), 16, 0, 0)
#define VM_WAIT_N(n) asm volatile("s_waitcnt vmcnt(" #n ")" ::: "memory")
#define FRAG16(buf, f, lane) (*(const LAS bf16x8*)((buf) + (f) * 1024 + (lane) * 16))
#define FRAGF4(buf, f, lane) (*(const LAS f32x4v*)((buf) + (f) * 1024 + (lane) * 16))
#ifndef SCAN_LOADERS
#define SCAN_LOADERS 1
#endif
constexpr int SCAN_FLAGS_OFF = 13312;
template <bool SLEEP = false> __device__ __forceinline__ bool lds_wait_ge(volatile LAS unsigned* w, unsigned need, volatile LAS unsigned* abortw) {
    unsigned sp = 0; bool ok = true;
    while (*w < need) { if (SLEEP) __builtin_amdgcn_s_sleep(1); if ((++sp & 1023u) == 0u) { if (*abortw != 0u) { ok = false; break; } if (sp > (1u << 22)) { *abortw = 1u; ok = false; break; } } }
    __builtin_amdgcn_fence(__ATOMIC_ACQUIRE, "workgroup");
    asm volatile("" ::: "memory");
    return ok;
}
__device__ __forceinline__ void gla_issue_A_half(const P& p, int ch, int sl, LAS unsigned char* bufA, int r, int hh, int ti) {
    if (ti == 0) {
#pragma unroll
        for (int ks = 0; ks < 4; ++ks) DMA16(p.GVT + ((size_t)ch * 256 + 32 * sl + r) * 64 + 16 * ks + 8 * hh, bufA + ks * 1024);
    }
#pragma unroll
    for (int ks = 0; ks < 8; ++ks) DMA16(p.GQT + ((size_t)ch * 64 + 32 * ti + r) * 128 + 16 * ks + 8 * hh, bufA + (4 + ti * 8 + ks) * 1024);
#pragma unroll
    for (int ks = 0; ks < 4; ++ks) DMA16(p.GA + ((size_t)ch * 64 + 32 * ti + r) * 64 + 16 * ks + 8 * hh, bufA + (20 + ti * 4 + ks) * 1024);
}
__device__ __forceinline__ void delta_issue_A_half(const P& p, int ch, int sl, LAS unsigned char* bufA, int r, int hh, int ti) {
#pragma unroll
    for (int ks = 0; ks < 8; ++ks) {
        DMA16(p.DNW + ((size_t)ch * 64 + 32 * ti + r) * 128 + 16 * ks + 8 * hh, bufA + (ti * 8 + ks) * 1024);
        DMA16(p.DQD + ((size_t)ch * 64 + 32 * ti + r) * 128 + 16 * ks + 8 * hh, bufA + (16 + ti * 8 + ks) * 1024);
    }
#pragma unroll
    for (int g = 0; g < 4; ++g) DMA16(p.DUB + ((size_t)ch * 128 + 32 * sl + r) * 64 + 32 * ti + 8 * g + 4 * hh, bufA + (32 + ti * 4 + g) * 1024);
}
__device__ __forceinline__ void gla_issue_A(const P& p, int ch, int sl, LAS unsigned char* bufA, int r, int hh) {
#pragma unroll
    for (int ks = 0; ks < 4; ++ks) DMA16(p.GVT + ((size_t)ch * 256 + 32 * sl + r) * 64 + 16 * ks + 8 * hh, bufA + ks * 1024);
#pragma unroll
    for (int ti = 0; ti < 2; ++ti)
#pragma unroll
        for (int ks = 0; ks < 8; ++ks) DMA16(p.GQT + ((size_t)ch * 64 + 32 * ti + r) * 128 + 16 * ks + 8 * hh, bufA + (4 + ti * 8 + ks) * 1024);
#pragma unroll
    for (int ti = 0; ti < 2; ++ti)
#pragma unroll
        for (int ks = 0; ks < 4; ++ks) DMA16(p.GA + ((size_t)ch * 64 + 32 * ti + r) * 64 + 16 * ks + 8 * hh, bufA + (20 + ti * 4 + ks) * 1024);
}
__device__ __forceinline__ void gla_issue_B(const P& p, int ch, LAS unsigned char* bufB, int r, int hh) {
#pragma unroll
    for (int d = 0; d < 4; ++d)
#pragma unroll
        for (int ks = 0; ks < 4; ++ks) DMA16(p.GKT + ((size_t)ch * 128 + 32 * d + r) * 64 + 16 * ks + 8 * hh, bufB + (d * 4 + ks) * 1024);
#pragma unroll
    for (int d = 0; d < 4; ++d)
#pragma unroll
        for (int g = 0; g < 4; ++g) DMA16(p.GDEC + (size_t)ch * 128 + 32 * d + 8 * g + 4 * hh, bufB + (16 + d * 4 + g) * 1024);
}
__device__ __forceinline__ void gla_scan_task(const P& p, int l, int s, int h, int sl, LAS unsigned char* ldsw, int lane) {
    LAS bf16* ST = (LAS bf16*)ldsw;
    LAS unsigned char* bufA = ldsw + 16384; LAS unsigned char* bufB = ldsw + 16384 + 28 * 1024;
    const int r = lane & 31, hh = lane >> 5;
    f32x16 S[4];
#pragma unroll
    for (int d = 0; d < 4; ++d) S[d] = zero16();
    volatile LAS unsigned* FL = (volatile LAS unsigned*)(ldsw + SCAN_FLAGS_OFF);
    if (!SCAN_LOADERS) { const int ch0 = (s * 64 + 0) * 4 + h; gla_issue_A(p, ch0, sl, bufA, r, hh); gla_issue_B(p, ch0, bufB, r, hh); }
#pragma unroll 1
    for (int n = 0; n < NCH; ++n) {
        const int r0 = s * TP + n * CH;
        const int chn = (s * 64 + (n + 1 < NCH ? n + 1 : n)) * 4 + h;
#pragma unroll
        for (int d = 0; d < 4; ++d)
#pragma unroll
            for (int g = 0; g < 4; ++g) { u32x2v w; w.x = pk2(S[d][4 * g], S[d][4 * g + 1]); w.y = pk2(S[d][4 * g + 2], S[d][4 * g + 3]); *(LAS u32x2v*)(ST + r * 136 + 32 * d + 8 * g + 4 * hh) = w; }
        if (SCAN_LOADERS) { LDS_WAIT(); lds_wait_ge(FL + 0, (unsigned)n + 1u, FL + 5); lds_wait_ge(FL + 1, (unsigned)n + 1u, FL + 5); }
        else { VM_WAIT_N(32); LDS_WAIT(); }
        bf16x8 vb[4];
#pragma unroll
        for (int ks = 0; ks < 4; ++ks) vb[ks] = FRAG16(bufA, ks, lane);
#pragma unroll
        for (int ti = 0; ti < 2; ++ti) {
            f32x16 o = zero16();
#pragma unroll
            for (int ks = 0; ks < 8; ++ks) { const bf16x8 b = *(const LAS bf16x8*)(ST + r * 136 + 16 * ks + 8 * hh); o = mma32(FRAG16(bufA, 4 + ti * 8 + ks, lane), b, o); }
#pragma unroll
            for (int ks = 0; ks < 4; ++ks) o = mma32(FRAG16(bufA, 20 + ti * 4 + ks, lane), vb[ks], o);
#pragma unroll
            for (int reg = 0; reg < 16; ++reg) p.OBRAW[(size_t)(r0 + 32 * ti + acc_row(reg, hh)) * 1024 + h * 256 + 32 * sl + r] = o[reg];
        }
        LDS_WAIT();
        if (SCAN_LOADERS) { if (lane == 0) FL[3] = (unsigned)n + 1u; lds_wait_ge(FL + 2, (unsigned)n + 1u, FL + 5); }
        else { gla_issue_A(p, chn, sl, bufA, r, hh); VM_WAIT_N(28); }
#pragma unroll
        for (int d = 0; d < 4; ++d) {
#pragma unroll
            for (int ks = 0; ks < 4; ++ks) S[d] = mma32(FRAG16(bufB, d * 4 + ks, lane), vb[ks], S[d]);
#pragma unroll
            for (int g = 0; g < 4; ++g) { const f32x4v dc = FRAGF4(bufB, 16 + d * 4 + g, lane); S[d][4 * g] *= dc.x; S[d][4 * g + 1] *= dc.y; S[d][4 * g + 2] *= dc.z; S[d][4 * g + 3] *= dc.w; }
        }
        LDS_WAIT();
        if (SCAN_LOADERS) { if (lane == 0) FL[4] = (unsigned)n + 1u; } else gla_issue_B(p, chn, bufB, r, hh);
    }
    VM_WAIT_N(0);
    float* so = p.out + O_PGLA + ((((size_t)l * 2 + s) * 4 + h) * 128) * 256;
#pragma unroll
    for (int d = 0; d < 4; ++d)
#pragma unroll
        for (int reg = 0; reg < 16; ++reg) so[(size_t)(32 * d + acc_row(reg, hh)) * 256 + 32 * sl + r] = S[d][reg];
}

__device__ __forceinline__ void delta_prepass(const P& p, int ch, bool active, LAS unsigned char* ldsh, int t256) {
    const int s = ch >> 9, n = (ch >> 3) & 63, h = ch & 7, r0 = s * TP + n * CH;
    LAS bf16* Kh = (LAS bf16*)ldsh;
    LAS bf16* Kl = (LAS bf16*)(ldsh + 17408);
    LAS float* Lm = (LAS float*)(ldsh + 34816);
    LAS float* GH = (LAS float*)(ldsh + 51200);
    LAS float* BE = GH + 64;
    const int lane = t256 & 63, w4 = t256 >> 6, r = lane & 31, hh = lane >> 5;
    const int ti = w4 >> 1, tj = w4 & 1;
    const int j = t256;
    const bool isw = j >= 128;
    float x[64];
    if (active) {
        const float* src = p.DQKV + (size_t)r0 * 3072 + (isw ? 1024 + h * 128 + (j - 128) : 2048 + h * 128 + j);
#pragma unroll
        for (int c = 0; c < 64; ++c) x[c] = src[(size_t)c * 3072];
        if (w4 == 0) {
            float g = p.G[(size_t)(r0 + lane) * 8 + h];
#pragma unroll
            for (int o = 1; o < 64; o <<= 1) { const float y = __shfl_up(g, o); g += lane >= o ? y : 0.f; }
            GH[lane] = g; BE[lane] = p.BETA[(size_t)(r0 + lane) * 8 + h];
            if (lane >= 60) p.DDEC[(size_t)ch * 4 + (lane - 60)] = __expf(__shfl(g, 63));
        }
#pragma unroll
        for (int i = 0; i < 8; ++i) { const int e = t256 + 256 * i, t = e >> 5, dk = (e & 31) * 4;
            const f32x4v kf = *(const f32x4v*)(p.DQKV + (size_t)(r0 + t) * 3072 + 1024 + h * 128 + dk);
            const unsigned h0 = f2bf(kf.x), h1 = f2bf(kf.y), h2 = f2bf(kf.z), h3 = f2bf(kf.w);
            u32x2v wh, wl; wh.x = h0 | (h1 << 16); wh.y = h2 | (h3 << 16);
            wl.x = f2bf(kf.x - bf2f(h0)) | (f2bf(kf.y - bf2f(h1)) << 16); wl.y = f2bf(kf.z - bf2f(h2)) | (f2bf(kf.w - bf2f(h3)) << 16);
            *(LAS u32x2v*)(Kh + t * 136 + dk) = wh; *(LAS u32x2v*)(Kl + t * 136 + dk) = wl; }
    }
    __syncthreads();
    if (active) {
        f32x16 acc = zero16();
        if (!(ti == 0 && tj == 1)) {
#pragma unroll
            for (int ks = 0; ks < 8; ++ks) {
                const bf16x8 ah = *(const LAS bf16x8*)(Kh + (32 * ti + r) * 136 + 16 * ks + 8 * hh), al = *(const LAS bf16x8*)(Kl + (32 * ti + r) * 136 + 16 * ks + 8 * hh);
                const bf16x8 bh = *(const LAS bf16x8*)(Kh + (32 * tj + r) * 136 + 16 * ks + 8 * hh), bl = *(const LAS bf16x8*)(Kl + (32 * tj + r) * 136 + 16 * ks + 8 * hh);
                acc = mma32(ah, bh, acc); acc = mma32(ah, bl, acc); acc = mma32(al, bh, acc);
            }
        }
#pragma unroll
        for (int reg = 0; reg < 16; ++reg) { const int c = 32 * ti + acc_row(reg, hh), sc = 32 * tj + r;
            Lm[c * 64 + sc] = c > sc ? BE[c] * acc[reg] * __expf(GH[c] - GH[sc]) : 0.f; }
    }
    __syncthreads();
    if (active) {
#pragma unroll
        for (int i = 0; i < 8; ++i) { const int e = t256 + 256 * i, t = e >> 5, dk = (e & 31) * 4;
            const f32x4v qv = *(const f32x4v*)(p.DQKV + (size_t)(r0 + t) * 3072 + h * 128 + dk); const float eg = __expf(GH[t]);
            u32x2v wq, wd; wq.x = f2bf(qv.x) | (f2bf(qv.y) << 16); wq.y = f2bf(qv.z) | (f2bf(qv.w) << 16);
            wd.x = f2bf(qv.x * eg) | (f2bf(qv.y * eg) << 16); wd.y = f2bf(qv.z * eg) | (f2bf(qv.w * eg) << 16);
            *(LAS u32x2v*)(Kl + t * 136 + dk) = wq; *(u32x2v*)(p.DQD + ((size_t)ch * 64 + t) * 128 + dk) = wd; }
#pragma unroll
        for (int c = 0; c < 64; ++c) { float m = BE[c]; if (isw) m *= __expf(GH[c]); x[c] *= m; }
#pragma unroll
        for (int c = 1; c < 64; ++c) {
            asm volatile("" ::: "memory");
            float acc = x[c];
#pragma unroll
            for (int s4 = 0; s4 < (c + 3) / 4; ++s4) { const f32x4v L4 = *(const LAS f32x4v*)(Lm + c * 64 + 4 * s4);
                acc = fmaf(-L4.x, x[4 * s4], acc);
                if (4 * s4 + 1 < c) acc = fmaf(-L4.y, x[4 * s4 + 1], acc);
                if (4 * s4 + 2 < c) acc = fmaf(-L4.z, x[4 * s4 + 2], acc);
                if (4 * s4 + 3 < c) acc = fmaf(-L4.w, x[4 * s4 + 3], acc); }
            x[c] = acc;
        }
        if (j < 128) {
#pragma unroll
            for (int c4 = 0; c4 < 16; ++c4) { f32x4v w; w.x = x[4 * c4]; w.y = x[4 * c4 + 1]; w.z = x[4 * c4 + 2]; w.w = x[4 * c4 + 3]; *(f32x4v*)(p.DUB + ((size_t)ch * 128 + j) * 64 + 4 * c4) = w; }
        } else {
#pragma unroll
            for (int c = 0; c < 64; ++c) p.DNW[((size_t)ch * 64 + c) * 128 + (j - 128)] = (bf16)f2bf(-x[c]);
        }
    }
    __syncthreads();
    if (active) {
        f32x16 acc = zero16();
        if (!(ti == 0 && tj == 1)) {
#pragma unroll
            for (int ks = 0; ks < 8; ++ks) {
                const bf16x8 a = *(const LAS bf16x8*)(Kl + (32 * ti + r) * 136 + 16 * ks + 8 * hh);
                const bf16x8 b = *(const LAS bf16x8*)(Kh + (32 * tj + r) * 136 + 16 * ks + 8 * hh);
                acc = mma32(a, b, acc);
            }
        }
#pragma unroll
        for (int reg = 0; reg < 16; ++reg) { const int c = 32 * ti + acc_row(reg, hh), sc = 32 * tj + r;
            p.DAQK[((size_t)ch * 64 + c) * 64 + sc] = (bf16)f2bf(c >= sc ? acc[reg] * __expf(GH[c] - GH[sc]) : 0.f); }
        const float glast = GH[63];
#pragma unroll
        for (int i = 0; i < 4; ++i) { const int c = t256 + 256 * i, dk = c & 127, tg = c >> 7; float v[8];
#pragma unroll
            for (int e = 0; e < 8; ++e) v[e] = p.DQKV[(size_t)(r0 + 8 * tg + e) * 3072 + 1024 + h * 128 + dk] * __expf(glast - GH[8 * tg + e]);
            uint4 w; w.x = pk2(v[0], v[1]); w.y = pk2(v[2], v[3]); w.z = pk2(v[4], v[5]); w.w = pk2(v[6], v[7]);
            *(uint4*)(p.DKE + ((size_t)ch * 128 + dk) * 64 + 8 * tg) = w; }
    }
    __syncthreads();
}

__device__ __forceinline__ void delta_issue_A(const P& p, int ch, int sl, LAS unsigned char* bufA, int r, int hh) {
#pragma unroll
    for (int ti = 0; ti < 2; ++ti)
#pragma unroll
        for (int ks = 0; ks < 8; ++ks) {
            DMA16(p.DNW + ((size_t)ch * 64 + 32 * ti + r) * 128 + 16 * ks + 8 * hh, bufA + (ti * 8 + ks) * 1024);
            DMA16(p.DQD + ((size_t)ch * 64 + 32 * ti + r) * 128 + 16 * ks + 8 * hh, bufA + (16 + ti * 8 + ks) * 1024);
        }
#pragma unroll
    for (int ti = 0; ti < 2; ++ti)
#pragma unroll
        for (int g = 0; g < 4; ++g) DMA16(p.DUB + ((size_t)ch * 128 + 32 * sl + r) * 64 + 32 * ti + 8 * g + 4 * hh, bufA + (32 + ti * 4 + g) * 1024);
}
__device__ __forceinline__ void delta_issue_B(const P& p, int ch, LAS unsigned char* bufB, int r, int hh) {
#pragma unroll
    for (int ti = 0; ti < 2; ++ti)
#pragma unroll
        for (int ks = 0; ks < 4; ++ks) DMA16(p.DAQK + ((size_t)ch * 64 + 32 * ti + r) * 64 + 16 * ks + 8 * hh, bufB + (ti * 4 + ks) * 1024);
#pragma unroll
    for (int d = 0; d < 4; ++d)
#pragma unroll
        for (int ks = 0; ks < 4; ++ks) DMA16(p.DKE + ((size_t)ch * 128 + 32 * d + r) * 64 + 16 * ks + 8 * hh, bufB + (8 + d * 4 + ks) * 1024);
}
__device__ __forceinline__ void delta_scan_task(const P& p, int l, int s, int h, int sl, LAS unsigned char* ldsw, int lane) {
    LAS bf16* ST = (LAS bf16*)ldsw; LAS bf16* UT = (LAS bf16*)(ldsw + 8704);
    LAS unsigned char* bufA = ldsw + 16384; LAS unsigned char* bufB = ldsw + 16384 + 40 * 1024;
    const int r = lane & 31, hh = lane >> 5;
    f32x16 S[4];
#pragma unroll
    for (int d = 0; d < 4; ++d) S[d] = zero16();
    const float dec_all = p.DDEC[(size_t)((s * 64 + lane) * 8 + h) * 4];
    volatile LAS unsigned* FL = (volatile LAS unsigned*)(ldsw + SCAN_FLAGS_OFF);
    if (!SCAN_LOADERS) { const int ch0 = (s * 64 + 0) * 8 + h; delta_issue_A(p, ch0, sl, bufA, r, hh); delta_issue_B(p, ch0, bufB, r, hh); }
#pragma unroll 1
    for (int n = 0; n < NCH; ++n) {
        const int r0 = s * TP + n * CH;
        const int chn = (s * 64 + (n + 1 < NCH ? n + 1 : n)) * 8 + h;
#pragma unroll
        for (int d = 0; d < 4; ++d)
#pragma unroll
            for (int g = 0; g < 4; ++g) { u32x2v w; w.x = pk2(S[d][4 * g], S[d][4 * g + 1]); w.y = pk2(S[d][4 * g + 2], S[d][4 * g + 3]); *(LAS u32x2v*)(ST + r * 136 + 32 * d + 8 * g + 4 * hh) = w; }
        const float dec = __builtin_bit_cast(float, __builtin_amdgcn_readlane(__builtin_bit_cast(int, dec_all), n));
        if (SCAN_LOADERS) { LDS_WAIT(); lds_wait_ge(FL + 0, (unsigned)n + 1u, FL + 5); lds_wait_ge(FL + 1, (unsigned)n + 1u, FL + 5); }
        else { VM_WAIT_N(24); LDS_WAIT(); }
        f32x16 u[2], o[2];
#pragma unroll
        for (int ti = 0; ti < 2; ++ti) {
#pragma unroll
            for (int g = 0; g < 4; ++g) { const f32x4v ub4 = FRAGF4(bufA, 32 + ti * 4 + g, lane); u[ti][4 * g] = ub4.x; u[ti][4 * g + 1] = ub4.y; u[ti][4 * g + 2] = ub4.z; u[ti][4 * g + 3] = ub4.w; }
            o[ti] = zero16();
#pragma unroll
            for (int ks = 0; ks < 8; ++ks) {
                const bf16x8 b = *(const LAS bf16x8*)(ST + r * 136 + 16 * ks + 8 * hh);
                u[ti] = mma32(FRAG16(bufA, ti * 8 + ks, lane), b, u[ti]); o[ti] = mma32(FRAG16(bufA, 16 + ti * 8 + ks, lane), b, o[ti]);
            }
        }
#pragma unroll
        for (int ti = 0; ti < 2; ++ti)
#pragma unroll
            for (int g = 0; g < 4; ++g) { u32x2v w; w.x = pk2(u[ti][4 * g], u[ti][4 * g + 1]); w.y = pk2(u[ti][4 * g + 2], u[ti][4 * g + 3]); *(LAS u32x2v*)(UT + r * 72 + 32 * ti + 8 * g + 4 * hh) = w; }
        LDS_WAIT();
        if (SCAN_LOADERS) { if (lane == 0) FL[3] = (unsigned)n + 1u; lds_wait_ge(FL + 2, (unsigned)n + 1u, FL + 5); }
        else { delta_issue_A(p, chn, sl, bufA, r, hh); VM_WAIT_N(40); }
        bf16x8 ub[4];
#pragma unroll
        for (int ks = 0; ks < 4; ++ks) ub[ks] = *(const LAS bf16x8*)(UT + r * 72 + 16 * ks + 8 * hh);
#pragma unroll
        for (int ti = 0; ti < 2; ++ti) {
#pragma unroll
            for (int ks = 0; ks < 4; ++ks) o[ti] = mma32(FRAG16(bufB, ti * 4 + ks, lane), ub[ks], o[ti]);
#pragma unroll
            for (int reg = 0; reg < 16; ++reg) p.OCRAW[(size_t)(r0 + 32 * ti + acc_row(reg, hh)) * 1024 + h * 128 + 32 * sl + r] = o[ti][reg];
        }
#pragma unroll
        for (int d = 0; d < 4; ++d) {
#pragma unroll
            for (int reg = 0; reg < 16; ++reg) S[d][reg] *= dec;
#pragma unroll
            for (int ks = 0; ks < 4; ++ks) S[d] = mma32(FRAG16(bufB, 8 + d * 4 + ks, lane), ub[ks], S[d]);
        }
        LDS_WAIT();
        if (SCAN_LOADERS) { if (lane == 0) FL[4] = (unsigned)n + 1u; } else delta_issue_B(p, chn, bufB, r, hh);
    }
    VM_WAIT_N(0);
    float* so = p.out + O_PDELTA + ((((size_t)l * 2 + s) * 8 + h) * 128) * 128;
#pragma unroll
    for (int d = 0; d < 4; ++d)
#pragma unroll
        for (int reg = 0; reg < 16; ++reg) so[(size_t)(32 * d + acc_row(reg, hh)) * 128 + 32 * sl + r] = S[d][reg];
}

__device__ __forceinline__ void scan_loader(const P& p, int id, int role, LAS unsigned char* ldsw, int lane) {
    volatile LAS unsigned* FL = (volatile LAS unsigned*)(ldsw + SCAN_FLAGS_OFF);
    const int r = lane & 31, hh = lane >> 5;
    const bool gla = id < 64; const int q = gla ? id : id - 64;
    const int s = q >> 5, h = gla ? (q >> 3) & 3 : (q >> 2) & 7, sl = gla ? q & 7 : q & 3;
    LAS unsigned char* bufA = ldsw + 16384; LAS unsigned char* bufB = ldsw + 16384 + (gla ? 28 : 40) * 1024;
#pragma unroll 1
    for (int n = 0; n < NCH; ++n) {
        const int ch = gla ? (s * 64 + n) * 4 + h : (s * 64 + n) * 8 + h;
        if (!lds_wait_ge<true>(FL + (role < 2 ? 3 : 4), (unsigned)n, FL + 5)) break;
        if (role < 2) { if (gla) gla_issue_A_half(p, ch, sl, bufA, r, hh, role); else delta_issue_A_half(p, ch, sl, bufA, r, hh, role); }
        else { if (gla) gla_issue_B(p, ch, bufB, r, hh); else delta_issue_B(p, ch, bufB, r, hh); }
        VM_WAIT_N(0);
        if (lane == 0) FL[role] = (unsigned)n + 1u;
    }
    VM_WAIT_N(0);
}

__device__ __forceinline__ void norm_task(const P& p, int l, int r, int part, int lane) {
    const bf16* pr = p.PROJ + (size_t)r * PP;
    if (part == 0) {
        const float* gn = p.in[12] + (size_t)l * 256;
        f32x4v x[4], z[4]; const f32x4v g = *(const f32x4v*)(gn + lane * 4);
#pragma unroll
        for (int h = 0; h < 4; ++h) { x[h] = *(const f32x4v*)(p.OBRAW + (size_t)r * 1024 + h * 256 + lane * 4); z[h] = ldbf4(pr + C_BG + h * 256 + lane * 4); }
#pragma unroll
        for (int h = 0; h < 4; ++h) {
            const float ss = wave_sum(x[h].x * x[h].x + x[h].y * x[h].y + x[h].z * x[h].z + x[h].w * x[h].w);
            const float rs = __builtin_amdgcn_rsqf(ss * (1.f / 256.f) + 1e-6f);
            *(u32x2v*)(p.OBb + (size_t)r * 1024 + h * 256 + lane * 4) = (u32x2v){pk2(x[h].x * rs * g.x * siluf_(z[h].x), x[h].y * rs * g.y * siluf_(z[h].y)), pk2(x[h].z * rs * g.z * siluf_(z[h].z), x[h].w * rs * g.w * siluf_(z[h].w))};
        }
    } else {
        const float* dn = p.in[16] + (size_t)l * 128;
        float2 x[8], z[8]; const float2 g = *(const float2*)(dn + lane * 2);
#pragma unroll
        for (int h = 0; h < 8; ++h) { x[h] = *(const float2*)(p.OCRAW + (size_t)r * 1024 + h * 128 + lane * 2); z[h] = ldbf2(pr + C_CZ + h * 128 + lane * 2); }
#pragma unroll
        for (int h = 0; h < 8; ++h) {
            const float ss = wave_sum(x[h].x * x[h].x + x[h].y * x[h].y);
            const float rs = __builtin_amdgcn_rsqf(ss * (1.f / 128.f) + 1e-6f);
            *(unsigned*)(p.OCb + (size_t)r * 1024 + h * 128 + lane * 2) = pk2(x[h].x * rs * g.x * siluf_(z[h].x), x[h].y * rs * g.y * siluf_(z[h].y));
        }
    }
}

__device__ __forceinline__ void norm_row_task(const P& p, int l, int r, int lane) {
    const bf16* pr = p.PROJ + (size_t)r * PP;
    const float* gn = p.in[12] + (size_t)l * 256; const float* dn = p.in[16] + (size_t)l * 128;
    f32x4v x[4], z[4]; float2 y[8], w[8];
    const f32x4v g = *(const f32x4v*)(gn + lane * 4); const float2 g2 = *(const float2*)(dn + lane * 2);
#pragma unroll
    for (int h = 0; h < 4; ++h) { x[h] = *(const f32x4v*)(p.OBRAW + (size_t)r * 1024 + h * 256 + lane * 4); z[h] = ldbf4(pr + C_BG + h * 256 + lane * 4); }
#pragma unroll
    for (int h = 0; h < 8; ++h) { y[h] = *(const float2*)(p.OCRAW + (size_t)r * 1024 + h * 128 + lane * 2); w[h] = ldbf2(pr + C_CZ + h * 128 + lane * 2); }
#pragma unroll
    for (int h = 0; h < 4; ++h) {
        const float ss = wave_sum(x[h].x * x[h].x + x[h].y * x[h].y + x[h].z * x[h].z + x[h].w * x[h].w);
        const float rs = __builtin_amdgcn_rsqf(ss * (1.f / 256.f) + 1e-6f);
        *(u32x2v*)(p.OBb + (size_t)r * 1024 + h * 256 + lane * 4) = (u32x2v){pk2(x[h].x * rs * g.x * siluf_(z[h].x), x[h].y * rs * g.y * siluf_(z[h].y)), pk2(x[h].z * rs * g.z * siluf_(z[h].z), x[h].w * rs * g.w * siluf_(z[h].w))};
    }
#pragma unroll
    for (int h = 0; h < 8; ++h) {
        const float ss = wave_sum(y[h].x * y[h].x + y[h].y * y[h].y);
        const float rs = __builtin_amdgcn_rsqf(ss * (1.f / 128.f) + 1e-6f);
        *(unsigned*)(p.OCb + (size_t)r * 1024 + h * 128 + lane * 2) = pk2(y[h].x * rs * g2.x * siluf_(w[h].x), y[h].y * rs * g2.y * siluf_(w[h].y));
    }
}

__device__ __forceinline__ void mix_phase(const P& p, int l, size_t i0, size_t stride) {
    const size_t n = (size_t)NDEC * D / 4;
    for (size_t i = i0; i < n; i += stride) {
        const size_t r = NPROMPT + i / (D / 4); const int c = (int)(i % (D / 4)) * 4;
        float4 acc = make_float4(0, 0, 0, 0);
#pragma unroll
        for (int b = 0; b < 3; ++b) {
            const f32x4v g = ldbf4(p.PROJ + r * PP + C_MG + b * D + c);
            float4 y;
            if (r < NPROMPT) y = *(const float4*)(p.T3 + ((size_t)b * MPAD + r) * D + c);
            else { y = make_float4(0, 0, 0, 0);
#pragma unroll
                for (int ks = 0; ks < 4; ++ks) { const float4 q = *(const float4*)(p.T3d + ((size_t)(b * 4 + ks) * NDEC + (r - NPROMPT)) * D + c); y.x += q.x; y.y += q.y; y.z += q.z; y.w += q.w; } }
            acc.x += sigmoidf_(g.x) * y.x; acc.y += sigmoidf_(g.y) * y.y; acc.z += sigmoidf_(g.z) * y.z; acc.w += sigmoidf_(g.w) * y.w;
        }
        *(uint2*)(p.MIXb + r * D + c) = make_uint2(pk2(acc.x, acc.y), pk2(acc.z, acc.w));
    }
}

template <int NS> __device__ __forceinline__ void ln_dec_block(const float* res, const float* zs, const float* g, const float* b, float* out, float* out2, bf16* outb, bool active,
                                                               LAS float* red, int tid) {
    const int c = tid * 4, wave = tid >> 6;
    f32x4v v = (f32x4v){0.f, 0.f, 0.f, 0.f};
    if (active) {
        f32x4v q[NS];
#pragma unroll
        for (int sb = 0; sb < NS; ++sb) q[sb] = *(const f32x4v*)(zs + (size_t)sb * NDEC * D + c);
        const f32x4v a = *(const f32x4v*)(res + c);
        v = q[0];
#pragma unroll
        for (int sb = 1; sb < NS; ++sb) v += q[sb];
        v += a * ALPHA;
    }
    float s = wave_sum((v.x + v.y) + (v.z + v.w));
    if ((tid & 63) == 0) red[wave] = s;
    __syncthreads();
    float mu = 0.f;
#pragma unroll
    for (int w = 0; w < 8; ++w) mu += red[w];
    mu *= (1.f / D);
    v = v - mu;
    float qq = wave_sum((v.x * v.x + v.y * v.y) + (v.z * v.z + v.w * v.w));
    if ((tid & 63) == 0) red[8 + wave] = qq;
    __syncthreads();
    float var = 0.f;
#pragma unroll
    for (int w = 0; w < 8; ++w) var += red[8 + w];
    const float rs = __builtin_amdgcn_rsqf(var * (1.f / D) + 1e-5f);
    if (active) {
        const f32x4v gg = *(const f32x4v*)(g + c), bb = *(const f32x4v*)(b + c);
        const f32x4v o = v * rs * gg + bb;
        *(f32x4v*)(out + c) = o;
        if (out2) *(f32x4v*)(out2 + c) = o;
        *(u32x2v*)(outb + c) = (u32x2v){pk2(o.x, o.y), pk2(o.z, o.w)};
    }
}
__device__ __forceinline__ void ln_rows2(const float* z, const float* g, const float* b, float* stats, float* out2, bf16* outb, int lane) {
    float v[2][32]; float s[2] = {0.f, 0.f};
#pragma unroll
    for (int rr = 0; rr < 2; ++rr)
#pragma unroll
        for (int j = 0; j < 8; ++j) { const float4 c = *(const float4*)(z + (size_t)rr * D + j * 256 + lane * 4); v[rr][4 * j] = c.x; v[rr][4 * j + 1] = c.y; v[rr][4 * j + 2] = c.z; v[rr][4 * j + 3] = c.w; }
#pragma unroll
    for (int rr = 0; rr < 2; ++rr)
#pragma unroll
        for (int j = 0; j < 32; ++j) s[rr] += v[rr][j];
    float mu[2], q[2] = {0.f, 0.f}, rs[2];
    s[0] = wave_sum(s[0]); s[1] = wave_sum(s[1]);
    mu[0] = s[0] * (1.f / D); mu[1] = s[1] * (1.f / D);
#pragma unroll
    for (int rr = 0; rr < 2; ++rr)
#pragma unroll
        for (int j = 0; j < 32; ++j) { v[rr][j] -= mu[rr]; q[rr] += v[rr][j] * v[rr][j]; }
    q[0] = wave_sum(q[0]); q[1] = wave_sum(q[1]);
    rs[0] = __builtin_amdgcn_rsqf(q[0] * (1.f / D) + 1e-5f); rs[1] = __builtin_amdgcn_rsqf(q[1] * (1.f / D) + 1e-5f);
    if (lane == 0) { stats[0] = mu[0]; stats[1] = rs[0]; stats[2] = mu[1]; stats[3] = rs[1]; }
#pragma unroll
    for (int j = 0; j < 8; ++j) {
        const float4 gg = *(const float4*)(g + j * 256 + lane * 4), bb = *(const float4*)(b + j * 256 + lane * 4);
#pragma unroll
        for (int rr = 0; rr < 2; ++rr) {
            float4 o; o.x = v[rr][4 * j] * rs[rr] * gg.x + bb.x; o.y = v[rr][4 * j + 1] * rs[rr] * gg.y + bb.y; o.z = v[rr][4 * j + 2] * rs[rr] * gg.z + bb.z; o.w = v[rr][4 * j + 3] * rs[rr] * gg.w + bb.w;
            if (out2) *(float4*)(out2 + (size_t)rr * D + j * 256 + lane * 4) = o;
            *(uint2*)(outb + (size_t)rr * D + j * 256 + lane * 4) = make_uint2(pk2(o.x, o.y), pk2(o.z, o.w));
        }
    }
}
__device__ __forceinline__ void ln_row(const float* res, const float* z, int nslab, const float* g, const float* b, float* out, float* out2, bf16* outb, int lane) {
    float v[32]; float s = 0.f;
#pragma unroll
    for (int j = 0; j < 8; ++j) {
        const float4 a = res ? *(const float4*)(res + j * 256 + lane * 4) : make_float4(0, 0, 0, 0); float4 c = *(const float4*)(z + j * 256 + lane * 4);
#pragma unroll 1
        for (int sb = 1; sb < nslab; ++sb) { const float4 q = *(const float4*)(z + (size_t)sb * NDEC * D + j * 256 + lane * 4); c.x += q.x; c.y += q.y; c.z += q.z; c.w += q.w; }
        v[4 * j] = ALPHA * a.x + c.x; v[4 * j + 1] = ALPHA * a.y + c.y; v[4 * j + 2] = ALPHA * a.z + c.z; v[4 * j + 3] = ALPHA * a.w + c.w;
        s += (v[4 * j] + v[4 * j + 1]) + (v[4 * j + 2] + v[4 * j + 3]);
    }
    const float mu = wave_sum(s) * (1.f / D);
    float q = 0.f;
#pragma unroll
    for (int j = 0; j < 32; ++j) { v[j] -= mu; q += v[j] * v[j]; }
    const float rs = __builtin_amdgcn_rsqf(wave_sum(q) * (1.f / D) + 1e-5f);
#pragma unroll
    for (int j = 0; j < 8; ++j) {
        const float4 gg = *(const float4*)(g + j * 256 + lane * 4), bb = *(const float4*)(b + j * 256 + lane * 4);
        float4 o; o.x = v[4 * j] * rs * gg.x + bb.x; o.y = v[4 * j + 1] * rs * gg.y + bb.y; o.z = v[4 * j + 2] * rs * gg.z + bb.z; o.w = v[4 * j + 3] * rs * gg.w + bb.w;
        *(float4*)(out + j * 256 + lane * 4) = o;
        if (out2) *(float4*)(out2 + j * 256 + lane * 4) = o;
        *(uint2*)(outb + j * 256 + lane * 4) = make_uint2(pk2(o.x, o.y), pk2(o.z, o.w));
    }
}
__device__ __forceinline__ void bf8_to_f(const u32x4v w, float (&f)[8]) {
    f[0] = bf2f(w.x & 0xffffu); f[1] = __builtin_bit_cast(float, w.x & 0xffff0000u); f[2] = bf2f(w.y & 0xffffu); f[3] = __builtin_bit_cast(float, w.y & 0xffff0000u);
    f[4] = bf2f(w.z & 0xffffu); f[5] = __builtin_bit_cast(float, w.z & 0xffff0000u); f[6] = bf2f(w.w & 0xffffu); f[7] = __builtin_bit_cast(float, w.w & 0xffff0000u);
}
constexpr int FFN_PTASKS = (NPROMPT / 8) * 11, FFN_DTASKS = NDEC * 11, FFN_TASKS = FFN_PTASKS + FFN_DTASKS;
__device__ __forceinline__ void ffnconv_task(const P& p, int l, int task, int lane) {
    const float* cw = p.in[22] + (size_t)l * 3 * DFF2;
    if (task < FFN_PTASKS) {
        const int rg = task / 11, sl = task - rg * 11, c = sl * 512 + lane * 8;
        const int ra = rg * 8, t0 = ra & 4095;
        u32x4v x[2][10];
#pragma unroll
        for (int half = 0; half < 2; ++half)
#pragma unroll
            for (int i = 0; i < 10; ++i) {
                if (i < 2 && t0 == 0) x[half][i] = (u32x4v){0u, 0u, 0u, 0u};
                else x[half][i] = *(const u32x4v*)(p.U16 + (size_t)(ra - 2 + i) * DFF2 + c + half * DFF);
            }
        float w[2][3][8];
#pragma unroll
        for (int half = 0; half < 2; ++half)
#pragma unroll
            for (int j = 0; j < 3; ++j) {
                const f32x4v a = *(const f32x4v*)(cw + j * DFF2 + c + half * DFF), b = *(const f32x4v*)(cw + j * DFF2 + c + half * DFF + 4);
                w[half][j][0] = a.x; w[half][j][1] = a.y; w[half][j][2] = a.z; w[half][j][3] = a.w; w[half][j][4] = b.x; w[half][j][5] = b.y; w[half][j][6] = b.z; w[half][j][7] = b.w;
            }
#pragma unroll
        for (int i = 0; i < 8; ++i) {
            float y[2][8];
#pragma unroll
            for (int half = 0; half < 2; ++half) {
                float a[8], b[8], cc[8];
                bf8_to_f(x[half][i], a); bf8_to_f(x[half][i + 1], b); bf8_to_f(x[half][i + 2], cc);
#pragma unroll
                for (int e = 0; e < 8; ++e) y[half][e] = w[half][0][e] * a[e] + w[half][1][e] * b[e] + w[half][2][e] * cc[e];
            }
            u32x4v o;
            o.x = pk2(siluf_(y[0][0]) * y[1][0], siluf_(y[0][1]) * y[1][1]); o.y = pk2(siluf_(y[0][2]) * y[1][2], siluf_(y[0][3]) * y[1][3]);
            o.z = pk2(siluf_(y[0][4]) * y[1][4], siluf_(y[0][5]) * y[1][5]); o.w = pk2(siluf_(y[0][6]) * y[1][6], siluf_(y[0][7]) * y[1][7]);
            *(u32x4v*)(p.Fb + (size_t)(ra + i) * DFF + c) = o;
        }
        return;
    }
    const int dt = task - FFN_PTASKS, rr = dt / 11, sl = dt - rr * 11, c = sl * 512 + lane * 8;
    const int r = NPROMPT + rr, sq = rr >> 2, t = rr & 3;
    float y[2][8];
#pragma unroll
    for (int half = 0; half < 2; ++half) {
#pragma unroll
        for (int e = 0; e < 8; ++e) y[half][e] = 0.f;
#pragma unroll
        for (int j = 0; j < 3; ++j) {
            const int tt = t - 2 + j; float xv[8];
            if (tt >= 0) bf8_to_f(*(const u32x4v*)(p.U16 + (size_t)(NPROMPT + sq * 4 + tt) * DFF2 + c + half * DFF), xv);
            else { const float* sp = p.in[7] + (((size_t)l * 32 + sq) * 2 + (2 + tt)) * DFF2 + c + half * DFF; const f32x4v a = *(const f32x4v*)sp, b = *(const f32x4v*)(sp + 4);
                xv[0] = a.x; xv[1] = a.y; xv[2] = a.z; xv[3] = a.w; xv[4] = b.x; xv[5] = b.y; xv[6] = b.z; xv[7] = b.w; }
            const f32x4v wa = *(const f32x4v*)(cw + j * DFF2 + c + half * DFF), wb = *(const f32x4v*)(cw + j * DFF2 + c + half * DFF + 4);
            y[half][0] += wa.x * xv[0]; y[half][1] += wa.y * xv[1]; y[half][2] += wa.z * xv[2]; y[half][3] += wa.w * xv[3];
            y[half][4] += wb.x * xv[4]; y[half][5] += wb.y * xv[5]; y[half][6] += wb.z * xv[6]; y[half][7] += wb.w * xv[7];
        }
    }
    u32x4v o;
    o.x = pk2(siluf_(y[0][0]) * y[1][0], siluf_(y[0][1]) * y[1][1]); o.y = pk2(siluf_(y[0][2]) * y[1][2], siluf_(y[0][3]) * y[1][3]);
    o.z = pk2(siluf_(y[0][4]) * y[1][4], siluf_(y[0][5]) * y[1][5]); o.w = pk2(siluf_(y[0][6]) * y[1][6], siluf_(y[0][7]) * y[1][7]);
    *(u32x4v*)(p.Fb + (size_t)r * DFF + c) = o;
}

#ifndef PROBE_MASK
#define PROBE_MASK 0
#endif
#define REP(k) for (int rep_ = 0; rep_ < 1 + ((PROBE_MASK >> (k)) & 1); ++rep_)
constexpr int PH_PER_LAYER = 13, N_PHASES = 1 + PH_PER_LAYER * DEPTH;
constexpr int LDS_MISC = pg8::STAGE_BYTES, LDS_BYTES = pg8::STAGE_BYTES + 1024;
struct Args { P p; unsigned* bar; int ph_lo, ph_hi; };
__global__ void __launch_bounds__(512, 2) mega(Args a) {
    extern __shared__ __attribute__((aligned(16))) unsigned char lds_raw[];
    LAS unsigned char* lds = (LAS unsigned char*)lds_raw;
    const P& p = a.p;
    const int tid = threadIdx.x;
    const int G = gridDim.x, bx = blockIdx.x;
    volatile LAS unsigned* misc = (volatile LAS unsigned*)(lds + LDS_MISC);
    if (tid < 64) misc[tid] = 0u;
    __syncthreads();
    const int lo = a.ph_lo, hi = a.ph_hi;
    const bool one_launch = (hi - lo) > 1;
    XcdBarrier bar; bar.bar = a.bar; bar.x = 0; bar.st = misc + 8;
    if (one_launch) bar = xcd_barrier_post(a.bar, misc + 8);
#define IN(k) (lo <= (k) && (k) < hi)
#define SEAM(k) do { if (IN(k) && IN((k) + 1)) { xcd_barrier(bar); if ((PROBE_MASK >> 17) & 1) xcd_barrier(bar); } } while (0)
    const int ngw = G * 8; const size_t ngt = (size_t)G * 512;
#define PHASE_IDS() int tid_p = threadIdx.x; asm volatile("" : "+v"(tid_p)); const int lane = tid_p & 63, wave = __builtin_amdgcn_readfirstlane(tid_p >> 6), gw = bx * 8 + wave; const size_t gt = (size_t)bx * 512 + tid_p; (void)lane; (void)wave; (void)gw; (void)gt

    if (IN(0)) REP(18) {
        PHASE_IDS();
        LAS float* tile = (LAS float*)(lds + (tid_p >> 8) * 32768);
        const int half = tid_p >> 8, t256 = tid_p & 255;
        for (int it = 0; it < (WT_LAYER + 2 * G - 1) / (2 * G); ++it) {
            const int id = (it * G + bx) * 2 + half;
            WTile w = wT_tile(p, id < WT_LAYER ? id : 0);
            if (id < WT_LAYER) wT_load(w.W, w.K, w.N, w.n0, w.k0, tile, t256);
            __syncthreads();
            if (id < WT_LAYER) wT_store(w.Bt, w.K, w.n0, w.k0, tile, t256);
            __syncthreads();
        }
        xinit_phase(p, gt, ngt);
        for (size_t i = gt; i < (size_t)4100 * 8; i += ngt) {
            const int pi = (int)(i >> 3), fi = (int)(i & 7), pos = pi < 4096 ? pi : PAST + (pi - 4096);
            const double rev = (double)pos * rot_inv_rev(fi); const float fr = (float)(rev - floor(rev));
            p.ROT[2 * i] = sin_rev(fr + 0.25f); p.ROT[2 * i + 1] = sin_rev(fr);
        }
    }
    SEAM(0);
    for (int l = 0; l < DEPTH; ++l) {
        const int pb = 1 + PH_PER_LAYER * l;
        if (IN(pb + 0)) REP(0) {
            pg8::Gemm g{p.Xb, p.Win + (size_t)l * PP * D, MPAD, PP, D, D, D, 1, 0, 0, 0, 0}; EpiIn E{p.PROJ, p.SMALL, p.ROT, p.QB16, p.KB16, p.QR, p.KR, p.VD, p.out, l, 0};
            pg8::StaticOrder S; S.init(MPAD, PP, G, bx);
            pg8::gemm_phase<EpiIn, pg8::StaticOrder, true, true>(lds, g, S, E);
        }
        SEAM(pb + 0);
        if (IN(pb + 1)) REP(1) {
            PHASE_IDS();
            REP(19) for (int task = gw; task < MROWS / PREP_ROWS; task += ngw) prep_rows_task(p, l, task * PREP_ROWS, lane);
            REP(20) for (int task = gw; task < (NPROMPT / CONV_ROWS) * 12; task += ngw) prep_conv_task(p, l, task, lane);
            for (int task = gw; task < NDEC * 24; task += ngw) prep_task(p, l, NPROMPT + task / 24, 1 + task % 24, lane);
        }
        SEAM(pb + 1);
        if (IN(pb + 2)) REP(2) {
            PHASE_IDS();
            for (int it = 0; it < (512 + G - 1) / G; ++it) { const int ch = it * G + bx; if (ch < 512) gla_prepass(p, ch, lds, tid_p); }
            for (int it = 0; it < (1024 + 2 * G - 1) / (2 * G); ++it) { const int ch = (it * G + bx) * 2 + (tid_p >> 8); delta_prepass(p, ch < 1024 ? ch : 0, ch < 1024, lds + (tid_p >> 8) * 65536, tid_p & 255); }
            for (int task = gw; task < 512; task += ngw) vt_task(p, task, lds + wave * 8448, lane);
        }
        SEAM(pb + 2);
        if (IN(pb + 3)) REP(3) {
            PHASE_IDS();
            if (tid_p < 16) ((volatile LAS unsigned*)(lds + SCAN_FLAGS_OFF))[tid_p] = 0u;
            __syncthreads();
            const int nsb = G < 128 ? G : 128;
            const int nrole = SCAN_LOADERS ? 4 : 1;
            const bool scan_block = bx < nsb;
            if (scan_block && wave < nrole) {
                REP(13) for (int id = bx; id < 128; id += G) {
                    if (tid_p < 16) {}
                    if (wave == 0) {
                        if (id < 64) gla_scan_task(p, l, id >> 5, (id >> 3) & 3, id & 7, lds, lane);
                        else delta_scan_task(p, l, (id - 64) >> 5, ((id - 64) >> 2) & 7, (id - 64) & 3, lds, lane);
                    } else scan_loader(p, id, wave - 1, lds, lane);
                }
            } else {
                const int wpb = 8 - nrole;
                const int widx = scan_block ? bx * wpb + (wave - nrole) : nsb * wpb + (bx - nsb) * 8 + wave, nwork = nsb * wpb + (G - nsb) * 8;
                REP(14) for (int task = widx; task < 8192; task += nwork) scan_task(p, l, 512 + task, lane);
                REP(15) for (int task = widx; task < NDEC * 4; task += nwork) attn_task(p, l, NPROMPT + (task >> 2), task & 3, lane);
                REP(16) for (int task = widx; task < 4096; task += nwork) attn_prompt_task(p, l, task >> 11, (task >> 4) & 127, task & 15, lds + 106496 + wave * 2560, lane);
                if (l + 1 < DEPTH && widx >= NDEC * 4) for (int task = widx - NDEC * 4; task < WT_LAYER; task += nwork - NDEC * 4) wT_wave_task(p, (l + 1) * WT_LAYER + task, lane);
            }
        }
        SEAM(pb + 3);
        if (IN(pb + 4)) REP(4) { PHASE_IDS(); for (int task = gw; task < NPROMPT; task += ngw) norm_row_task(p, l, task, lane);
            for (int task = gw; task < NDEC * 2; task += ngw) norm_task(p, l, NPROMPT + (task >> 1), task & 1, lane); }
        SEAM(pb + 4);
        if (IN(pb + 5)) REP(5) {
            {
                pg8::Gemm g{p.OAb, p.Wbr + (size_t)l * 3 * D * 1024, NPROMPT, D, 1024, 1024, 1024, 1, (size_t)MPAD * 1024, (size_t)D * 1024, 0, 0}; EpiMix E{p.PROJ + C_MG, p.T3, p.MIXb};
                pg8::TileZ3Order S; S.init(NPROMPT, D, G, bx);
                pg8::gemm_phase<EpiMix, pg8::TileZ3Order, true, true>(lds, g, S, E);
            }
            {
                pg8::Gemm g{p.OAb + (size_t)NPROMPT * 1024, p.Wbr + (size_t)l * 3 * D * 1024, 256, D, 256, 1024, 1024, 4, (size_t)MPAD * 1024, (size_t)D * 1024, 256, 256}; pg8::EpiSlabF32 E{p.T3d, D, 0, (size_t)NDEC * D};
                pg8::ZOrder S; S.init(256, D, 12, G, bx);
                pg8::gemm_phase<pg8::EpiSlabF32, pg8::ZOrder, true, true>(lds, g, S, E);
            }
        }
        SEAM(pb + 5);
        if (IN(pb + 6)) REP(6) { PHASE_IDS(); mix_phase(p, l, gt, ngt); }
        SEAM(pb + 6);
        if (IN(pb + 7)) REP(7) {
            {
                pg8::Gemm g{p.MIXb, p.Wout + (size_t)l * D * D, NPROMPT, D, D, D, D, 1, 0, 0, 0, 0}; pg8::EpiResF32 E{p.Z, l == 0 ? p.X : nullptr, p.ST2, l == 0 ? nullptr : p.in[24] + (size_t)(l - 1) * D, l == 0 ? nullptr : p.in[25] + (size_t)(l - 1) * D, D, ALPHA};
                pg8::StaticOrder S; S.init(NPROMPT, D, G, bx);
                pg8::gemm_phase<pg8::EpiResF32, pg8::StaticOrder, true, true>(lds, g, S, E);
            }
            {
                pg8::Gemm g{p.MIXb + (size_t)NPROMPT * D, p.Wout + (size_t)l * D * D, 256, D, 256, D, D, 8, 0, 0, 256, 256}; pg8::EpiSlabF32 E{p.Zd1, D, 0, (size_t)NDEC * D};
                pg8::ZOrder S; S.init(256, D, 8, G, bx);
                pg8::gemm_phase<pg8::EpiSlabF32, pg8::ZOrder, true, true>(lds, g, S, E);
            }
        }
        SEAM(pb + 7);
        if (IN(pb + 8)) REP(8) {
            PHASE_IDS();
            for (int pr2 = gw; pr2 < NPROMPT / 2; pr2 += ngw) { const size_t r = (size_t)pr2 * 2; ln_rows2(p.Z + r * D, p.in[19] + (size_t)l * D, p.in[20] + (size_t)l * D, p.ST1 + r * 2, nullptr, p.Hb + r * D, lane); }
            for (int it = 0; it < (NDEC + G - 1) / G; ++it) { const int dr = it * G + bx; const bool act = dr < NDEC; const size_t r = NPROMPT + (act ? dr : 0);
                ln_dec_block<8>(p.X + r * D, p.Zd1 + (r - NPROMPT) * D, p.in[19] + (size_t)l * D, p.in[20] + (size_t)l * D, p.H + r * D, nullptr, p.Hb + r * D, act, (LAS float*)(lds + 64 * it), tid_p); }
        }
        SEAM(pb + 8);
        if (IN(pb + 9)) REP(9) {
            pg8::Gemm g{p.Hb, p.Wup + (size_t)l * DFF2 * D, MPAD, DFF2, D, D, D, 1, 0, 0, 0, 0}; EpiU E{p.U16, p.out, l, 0};
            pg8::StaticOrder S; S.init(MPAD, DFF2, G, bx);
            pg8::gemm_phase<EpiU, pg8::StaticOrder, true, true>(lds, g, S, E);
        }
        SEAM(pb + 9);
        if (IN(pb + 10)) REP(10) { PHASE_IDS(); for (int task = gw; task < FFN_TASKS; task += ngw) ffnconv_task(p, l, task, lane); }
        SEAM(pb + 10);
        if (IN(pb + 11)) REP(11) {
            {
                pg8::Gemm g{p.Fb, p.Wdn + (size_t)l * D * DFF, NPROMPT, D, DFF, DFF, DFF, 1, 0, 0, 0, 0}; pg8::EpiResF32 E{p.Z, nullptr, p.ST1, p.in[19] + (size_t)l * D, p.in[20] + (size_t)l * D, D, ALPHA};
                pg8::StaticOrder S; S.init(NPROMPT, D, G, bx);
                pg8::gemm_phase<pg8::EpiResF32, pg8::StaticOrder, true, true>(lds, g, S, E);
            }
            {
                pg8::Gemm g{p.Fb + (size_t)NPROMPT * DFF, p.Wdn + (size_t)l * D * DFF, 256, D, 256, DFF, DFF, 22, 0, 0, 256, 256}; pg8::EpiSlabF32 E{p.Zd2, D, 0, (size_t)NDEC * D};
                pg8::ZOrder S; S.init(256, D, 22, G, bx);
                pg8::gemm_phase<pg8::EpiSlabF32, pg8::ZOrder, true, true>(lds, g, S, E);
            }
        }
        SEAM(pb + 11);
        if (IN(pb + 12)) REP(12) {
            PHASE_IDS();
            for (int pr2 = gw; pr2 < NPROMPT / 2; pr2 += ngw) { const size_t r = (size_t)pr2 * 2;
                ln_rows2(p.Z + r * D, p.in[24] + (size_t)l * D, p.in[25] + (size_t)l * D, p.ST2 + r * 2, l == DEPTH - 1 ? p.out + O_YP + r * D : nullptr, p.Xb + r * D, lane); }
            for (int it = 0; it < (NDEC + G - 1) / G; ++it) { const int dr = it * G + bx; const bool act = dr < NDEC; const size_t r = NPROMPT + (act ? dr : 0);
                ln_dec_block<22>(p.H + r * D, p.Zd2 + (r - NPROMPT) * D, p.in[24] + (size_t)l * D, p.in[25] + (size_t)l * D, p.X + r * D, l == DEPTH - 1 ? p.out + O_YS + (r - NPROMPT) * D : nullptr, p.Xb + r * D, act, (LAS float*)(lds + 64 * it), tid_p); }
        }
        SEAM(pb + 12);
    }
#undef IN
#undef SEAM
}

#ifndef MK_ONE_LAUNCH
#define MK_ONE_LAUNCH 1
#endif
extern "C" void kernel_launch(void* const* d_in, const int* in_sizes, int n_in, void* d_out, int out_size, void* d_ws, size_t ws_size, hipStream_t stream) {
    static int grid = 0;
    if (n_in != 26 || (size_t)out_size != O_TOTAL) { fprintf(stderr, "kernel_launch: unexpected n_in %d / out_size %d\n", n_in, out_size); return; }
    if (grid == 0) {
        int dev = 0, cus = 0, per_cu = 0;
        if (hipGetDevice(&dev) != hipSuccess || hipDeviceGetAttribute(&cus, hipDeviceAttributeMultiprocessorCount, dev) != hipSuccess) { grid = -1; return; }
        if (hipFuncSetAttribute((const void*)mega, hipFuncAttributeMaxDynamicSharedMemorySize, LDS_BYTES) != hipSuccess) { fprintf(stderr, "kernel_launch: hipFuncSetAttribute failed\n"); grid = -1; return; }
        if (hipOccupancyMaxActiveBlocksPerMultiprocessor(&per_cu, (const void*)mega, 512, LDS_BYTES) != hipSuccess || per_cu < 1) { fprintf(stderr, "kernel_launch: occupancy query says %d blocks per CU\n", per_cu); grid = -1; return; }
        (void)hipGetLastError();
        grid = cus;
    }
    if (grid < 0) return;
    Args a{};
    P& p = a.p;
    for (int i = 0; i < 26; ++i) p.in[i] = (const float*)d_in[i];
    p.out = (float*)d_out;
    size_t off = 0; char* ws = (char*)d_ws;
    auto carve = [&](size_t bytes) { void* q = (void*)(ws + off); off += ((bytes + 255) / 256) * 256; return q; };
    a.bar = (unsigned*)carve((size_t)XCD_BAR_WORDS * 4);
    p.Win = (bf16*)carve((size_t)DEPTH * PP * D * 2); p.Wbr = (bf16*)carve((size_t)DEPTH * 3 * D * 1024 * 2); p.Wout = (bf16*)carve((size_t)DEPTH * D * D * 2);
    p.Wup = (bf16*)carve((size_t)DEPTH * DFF2 * D * 2); p.Wdn = (bf16*)carve((size_t)DEPTH * D * DFF * 2);
    p.X = (float*)carve((size_t)MPAD * D * 4); p.H = (float*)carve((size_t)MPAD * D * 4); p.Z = (float*)carve((size_t)MPAD * D * 4);
    p.Xb = (bf16*)carve((size_t)MPAD * D * 2); p.Hb = (bf16*)carve((size_t)MPAD * D * 2); p.MIXb = (bf16*)carve((size_t)MPAD * D * 2);
    p.OAb = (bf16*)carve((size_t)MPAD * 1024 * 2); p.OBb = (bf16*)carve((size_t)MPAD * 1024 * 2); p.OCb = (bf16*)carve((size_t)MPAD * 1024 * 2);
    p.G = (float*)carve((size_t)MPAD * 8 * 4); p.BETA = (float*)carve((size_t)MPAD * 8 * 4);
    p.ST1 = (float*)carve((size_t)NPROMPT * 2 * 4); p.ST2 = (float*)carve((size_t)NPROMPT * 2 * 4);
    p.T3d = (float*)carve((size_t)42 * NDEC * D * 4); p.Zd1 = p.T3d + (size_t)12 * NDEC * D; p.Zd2 = p.T3d + (size_t)20 * NDEC * D;
    p.PROJ = (bf16*)carve((size_t)MPAD * PP * 2); p.U16 = (bf16*)carve((size_t)MPAD * DFF2 * 2);
    p.ROT = (float*)carve((size_t)4100 * 16 * 4);
    p.SMALL = (float*)carve((size_t)MPAD * 32 * 4); p.VD = (float*)carve((size_t)NDEC * 256 * 4);
    const size_t r2 = off;
    p.QR = (float*)carve((size_t)MPAD * 1024 * 4); p.KR = (float*)carve((size_t)MPAD * 256 * 4); p.AG = (float*)carve((size_t)MPAD * 512 * 4);
    p.DQKV = (float*)carve((size_t)MPAD * 3072 * 4); p.OBRAW = (float*)carve((size_t)MPAD * 1024 * 4); p.OCRAW = (float*)carve((size_t)MPAD * 1024 * 4);
    p.QB16 = (bf16*)carve((size_t)NPROMPT * 1024 * 2); p.KB16 = (bf16*)carve((size_t)NPROMPT * 256 * 2); p.VT16 = (bf16*)carve((size_t)2 * 4 * 64 * TP * 2);
    p.GQT = (bf16*)carve((size_t)512 * 64 * 128 * 2); p.GKT = (bf16*)carve((size_t)512 * 128 * 64 * 2); p.GVT = (bf16*)carve((size_t)512 * 256 * 64 * 2);
    p.GA = (bf16*)carve((size_t)512 * 64 * 64 * 2); p.GDEC = (float*)carve((size_t)512 * 128 * 4);
    p.DUB = (float*)carve((size_t)1024 * 64 * 128 * 4); p.DNW = (bf16*)carve((size_t)1024 * 64 * 128 * 2); p.DQD = (bf16*)carve((size_t)1024 * 64 * 128 * 2);
    p.DAQK = (bf16*)carve((size_t)1024 * 64 * 64 * 2); p.DKE = (bf16*)carve((size_t)1024 * 128 * 64 * 2); p.DDEC = (float*)carve((size_t)1024 * 4 * 4);
    const size_t r2_end = off; off = r2;
    p.T3 = (float*)carve((size_t)3 * MPAD * D * 4); p.Fb = (bf16*)p.T3;
    if (off < r2_end) off = r2_end;
    if (off > ws_size) { fprintf(stderr, "kernel_launch: workspace too small: need %zu have %zu\n", off, ws_size); return; }
    if (hipMemsetAsync(a.bar, 0, (size_t)XCD_BAR_WORDS * 4, stream) != hipSuccess) return;
#if MK_ONE_LAUNCH
    a.ph_lo = 0; a.ph_hi = N_PHASES;
    hipLaunchKernelGGL(mega, dim3(grid), dim3(512), LDS_BYTES, stream, a);
#else
    for (int ph = 0; ph < N_PHASES; ++ph) { a.ph_lo = ph; a.ph_hi = ph + 1; hipLaunchKernelGGL(mega, dim3(grid), dim3(512), LDS_BYTES, stream, a); }
#endif
}
```
